# Optimizing an MI355X kernel written in HIP

```python
import math
import jax, jax.numpy as jnp
from jax import lax
import numpy as np

D_MODEL = 4096
BATCH = 1
SEQ = 8192
DEPTH = 1

HEAD_DIM = 128
D_MIX = D_MODEL
DIFF_WIDTH = D_MIX // 2
DIL_WIDTH = D_MIX - DIFF_WIDTH
DIFF_HEADS = DIFF_WIDTH // (2 * HEAD_DIM)
DIL_HEADS = DIL_WIDTH // HEAD_DIM
IN_COLS = 3 * DIFF_WIDTH + 3 * DIL_WIDTH
ROT_DIM = HEAD_DIM // 4
ROPE_THETA = 500000.0
DILATED_CONFIGS = ((128, 1), (512, 4), (2048, 16))
BLK = 128
PEER_HEADS = 8
N_KEYS = 128
N_EXPERTS = N_KEYS * N_KEYS
PEER_QDIM = 256
PEER_TOPK = 16
PEER_BLK = 32
NORM_EPS = 1e-6
NEG_INF = -1e30

kernel_name = "hymba_diffattn_longnet_peer_adaln"


def rmsnorm(x, g):
    xf = x.astype(jnp.float32)
    y = xf * lax.rsqrt(jnp.mean(xf * xf, axis=-1, keepdims=True) + NORM_EPS)
    return (y * g.astype(jnp.float32)).astype(x.dtype)


def modulate(h, shift, scale):
    return h * (1 + scale[:, None, :]) + shift[:, None, :]


def rotary_tables(positions):
    inv_freq = jnp.power(ROPE_THETA, -jnp.arange(0, ROT_DIM, 2, dtype=jnp.float32) / ROT_DIM)
    ang = positions.astype(jnp.float32)[..., None] * inv_freq
    return jnp.cos(ang)[:, :, None, :], jnp.sin(ang)[:, :, None, :]


def apply_partial_rotary(t, cos, sin):
    half = ROT_DIM // 2
    t1 = t[..., :half].astype(jnp.float32)
    t2 = t[..., half:ROT_DIM].astype(jnp.float32)
    rot = jnp.concatenate([t1 * cos - t2 * sin, t2 * cos + t1 * sin], axis=-1).astype(t.dtype)
    return jnp.concatenate([rot, t[..., ROT_DIM:]], axis=-1)


def diff_attention(q1, q2, k1, k2, v, lam, lam_init, subln_g):
    B, S, H, dh = q1.shape
    nqb = S // BLK
    scale = dh ** -0.5
    kpos = jnp.arange(S)

    def qblock(args):
        b, qb1, qb2 = args
        qpos = b * BLK + jnp.arange(BLK)
        mask = kpos[None, :] <= qpos[:, None]

        def probs(qb, k):
            s = jnp.einsum('bqhd,bkhd->bhqk', qb, k, preferred_element_type=jnp.float32) * scale
            return jax.nn.softmax(jnp.where(mask, s, NEG_INF), axis=-1)

        a = probs(qb1, k1) - lam * probs(qb2, k2)
        return jnp.einsum('bhqk,bkhe->bqhe', a.astype(v.dtype), v)

    blocks = lambda t: t.reshape(B, nqb, BLK, H, t.shape[-1]).transpose(1, 0, 2, 3, 4)
    out = lax.map(qblock, (jnp.arange(nqb), blocks(q1), blocks(q2)))
    out = out.transpose(1, 0, 2, 3, 4).reshape(B, S, H, 2 * dh)
    return rmsnorm(out, subln_g) * (1 - lam_init)


def dilated_branch(q, k, v, window, dilation):
    B, S, H, dh = q.shape
    reach = window // dilation
    L = S // dilation
    nb = -(-L // BLK)
    Lp = nb * BLK

    def to_sub(t):
        t = t.reshape(B, L, dilation, H, dh).transpose(0, 2, 1, 3, 4)
        return jnp.pad(t, ((0, 0), (0, 0), (0, Lp - L), (0, 0), (0, 0)))

    blk = lambda u: u.reshape(B, dilation, nb, BLK, H, dh)

    def with_prev(t):
        prev = jnp.pad(t, ((0, 0), (0, 0), (BLK, 0), (0, 0), (0, 0)))[:, :, :Lp]
        return jnp.concatenate([blk(prev), blk(t)], axis=3)

    qs, ks, vs = to_sub(q), to_sub(k), to_sub(v)
    qb, kb, vb = blk(qs), with_prev(ks), with_prev(vs)
    qi = jnp.arange(BLK)[:, None]
    kj = jnp.arange(2 * BLK)[None, :]
    dist = qi + BLK - kj
    band = (dist >= 0) & (dist <= reach)
    has_prev = (jnp.arange(nb) > 0)[:, None, None]
    mask = band[None] & (has_prev | (kj >= BLK)[None])
    s = jnp.einsum('brnqhd,brnkhd->brnhqk', qb, kb, preferred_element_type=jnp.float32) * (dh ** -0.5)
    s = jnp.where(mask[:, None], s, NEG_INF)
    m = jnp.max(s, axis=-1, keepdims=True)
    p = jnp.exp(s - m)
    l = jnp.sum(p, axis=-1, keepdims=True)
    o = jnp.einsum('brnhqk,brnkhd->brnqhd', (p / l).astype(v.dtype), vb)
    lse = (m + jnp.log(l))[..., 0]
    o = o.reshape(B, dilation, Lp, H, dh)[:, :, :L].transpose(0, 2, 1, 3, 4).reshape(B, S, H, dh)
    lse = lse.transpose(0, 1, 2, 4, 3).reshape(B, dilation, Lp, H)[:, :, :L]
    lse = lse.transpose(0, 2, 1, 3).reshape(B, S, H)
    return o, lse


def dilated_attention(q, k, v):
    outs, lses = zip(*[dilated_branch(q, k, v, w, d) for (w, d) in DILATED_CONFIGS])
    wts = jax.nn.softmax(jnp.stack(lses, axis=0), axis=0)
    return jnp.einsum('gbsh,gbshd->bshd', wts.astype(q.dtype), jnp.stack(outs, axis=0))


def hybrid_mixer(h, cos, sin, w_in, w_out, lam_q1, lam_k1, lam_q2, lam_k2,
                 diff_subln_g, dil_out_g, lam_init):
    B, S, _ = h.shape
    proj = jnp.einsum('bsd,de->bse', h, w_in)
    cuts = [DIFF_WIDTH, 2 * DIFF_WIDTH, 3 * DIFF_WIDTH,
            3 * DIFF_WIDTH + DIL_WIDTH, 3 * DIFF_WIDTH + 2 * DIL_WIDTH]
    dq, dk, dv, sq, sk, sv = jnp.split(proj, cuts, axis=-1)
    rope = lambda t: apply_partial_rotary(t, cos, sin)
    dq = dq.reshape(B, S, DIFF_HEADS, 2, HEAD_DIM)
    dk = dk.reshape(B, S, DIFF_HEADS, 2, HEAD_DIM)
    q1, q2 = rope(dq[..., 0, :]), rope(dq[..., 1, :])
    k1, k2 = rope(dk[..., 0, :]), rope(dk[..., 1, :])
    dv = dv.reshape(B, S, DIFF_HEADS, 2 * HEAD_DIM)
    f32 = jnp.float32
    lam = (jnp.exp(jnp.sum(lam_q1.astype(f32) * lam_k1.astype(f32)))
           - jnp.exp(jnp.sum(lam_q2.astype(f32) * lam_k2.astype(f32))) + lam_init)
    y_diff = diff_attention(q1, q2, k1, k2, dv, lam, lam_init, diff_subln_g).reshape(B, S, DIFF_WIDTH)
    sq = rope(sq.reshape(B, S, DIL_HEADS, HEAD_DIM))
    sk = rope(sk.reshape(B, S, DIL_HEADS, HEAD_DIM))
    sv = sv.reshape(B, S, DIL_HEADS, HEAD_DIM)
    y_dil = rmsnorm(dilated_attention(sq, sk, sv), dil_out_g.reshape(DIL_HEADS, HEAD_DIM))
    y_dil = y_dil.reshape(B, S, DIL_WIDTH)
    return jnp.einsum('bse,ed->bsd', jnp.concatenate([y_diff, y_dil], axis=-1), w_out)


def peer_ffn(h, w_q, subkeys, u, v):
    B, S, D = h.shape
    q = jnp.einsum('bsd,de->bse', h, w_q).reshape(B, S, PEER_HEADS, 2, PEER_QDIM // 2)
    sc = jnp.einsum('bshpk,hpnk->bshpn', q, subkeys, preferred_element_type=jnp.float32)
    top_v, top_i = lax.top_k(sc, PEER_TOPK)
    cand = (top_v[..., 0, :, None] + top_v[..., 1, None, :]).reshape(B, S, PEER_HEADS, PEER_TOPK ** 2)
    cand_id = (top_i[..., 0, :, None] * N_KEYS + top_i[..., 1, None, :]).reshape(B, S, PEER_HEADS, PEER_TOPK ** 2)
    fin_v, fin_pos = lax.top_k(cand, PEER_TOPK)
    expert_id = jnp.take_along_axis(cand_id, fin_pos, axis=-1)
    gate = jax.nn.softmax(fin_v, axis=-1)
    T = B * S
    nblk = T // PEER_BLK
    E = PEER_HEADS * PEER_TOPK
    hb = h.reshape(nblk, PEER_BLK, D)
    ib = expert_id.reshape(nblk, PEER_BLK, E)
    gb = gate.reshape(nblk, PEER_BLK, E)

    def block(args):
        ht, it, gt = args
        ue = jnp.take(u, it, axis=0)
        act = jax.nn.gelu(jnp.einsum('td,ted->te', ht, ue, preferred_element_type=jnp.float32),
                          approximate=False)
        ve = jnp.take(v, it, axis=0)
        return jnp.einsum('te,ted->td', (gt * act).astype(v.dtype), ve)

    return lax.map(block, (hb, ib, gb)).reshape(B, S, D)


def setup_inputs(seed: int = 0) -> dict:
    key = jax.random.key(seed)
    ks = jax.random.split(key, 20)
    nrm = lambda k, shape, s: jax.random.normal(k, shape, jnp.float32) * s
    return {
        "x": nrm(ks[0], (BATCH, SEQ, D_MODEL), 1.0),
        "c": nrm(ks[1], (BATCH, D_MODEL), 1.0),
        "positions": jnp.broadcast_to(jnp.arange(SEQ, dtype=jnp.int32), (BATCH, SEQ)),
        "norm1_g": 1.0 + nrm(ks[2], (DEPTH, D_MODEL), 0.02),
        "norm2_g": 1.0 + nrm(ks[3], (DEPTH, D_MODEL), 0.02),
        "w_ada": nrm(ks[4], (DEPTH, D_MODEL, 6 * D_MODEL), 0.5 * D_MODEL ** -0.5),
        "b_ada": nrm(ks[5], (DEPTH, 6 * D_MODEL), 0.01),
        "w_in": nrm(ks[6], (DEPTH, D_MODEL, IN_COLS), D_MODEL ** -0.5),
        "lam_q1": nrm(ks[7], (DEPTH, HEAD_DIM), 0.1),
        "lam_k1": nrm(ks[8], (DEPTH, HEAD_DIM), 0.1),
        "lam_q2": nrm(ks[9], (DEPTH, HEAD_DIM), 0.1),
        "lam_k2": nrm(ks[10], (DEPTH, HEAD_DIM), 0.1),
        "diff_subln_g": 1.0 + nrm(ks[11], (DEPTH, 2 * HEAD_DIM), 0.02),
        "dil_out_g": 1.0 + nrm(ks[12], (DEPTH, DIL_WIDTH), 0.02),
        "w_out": nrm(ks[13], (DEPTH, D_MIX, D_MODEL), D_MIX ** -0.5),
        "peer_wq": nrm(ks[14], (DEPTH, D_MODEL, PEER_HEADS * PEER_QDIM), D_MODEL ** -0.5),
        "peer_subkeys": nrm(ks[15], (DEPTH, PEER_HEADS, 2, N_KEYS, PEER_QDIM // 2), (PEER_QDIM // 2) ** -0.5),
        "peer_u": nrm(ks[16], (DEPTH, N_EXPERTS, D_MODEL), D_MODEL ** -0.5),
        "peer_v": nrm(ks[17], (DEPTH, N_EXPERTS, D_MODEL), 0.5),
        "final_g": 1.0 + nrm(ks[18], (D_MODEL,), 0.02),
    }


def reference(x, c, positions, norm1_g, norm2_g, w_ada, b_ada, w_in, lam_q1, lam_k1,
              lam_q2, lam_k2, diff_subln_g, dil_out_g, w_out, peer_wq, peer_subkeys,
              peer_u, peer_v, final_g):
    cos, sin = rotary_tables(positions)
    c_act = jax.nn.silu(c)
    for l in range(DEPTH):
        lam_init = 0.8 - 0.6 * math.exp(-0.3 * l)
        mod = jnp.einsum('bd,de->be', c_act, w_ada[l]) + b_ada[l]
        sh1, sc1, g1, sh2, sc2, g2 = jnp.split(mod, 6, axis=-1)
        h = modulate(rmsnorm(x, norm1_g[l]), sh1, sc1)
        x = x + g1[:, None, :] * hybrid_mixer(h, cos, sin, w_in[l], w_out[l], lam_q1[l], lam_k1[l],
                                              lam_q2[l], lam_k2[l], diff_subln_g[l], dil_out_g[l], lam_init)
        h = modulate(rmsnorm(x, norm2_g[l]), sh2, sc2)
        x = x + g2[:, None, :] * peer_ffn(h, peer_wq[l], peer_subkeys[l], peer_u[l], peer_v[l])
    return rmsnorm(x, final_g)
```

```cpp
#include <hip/hip_runtime.h>
#include <cstdint>
#include <cstdio>

#ifndef MK_N_LAUNCHES
#define MK_N_LAUNCHES 1
#endif
constexpr int NPHASE = 10;

constexpr int S = 8192, DM = 4096, NIN = 12288, NADA = 24576, NEXP = 16384;
constexpr float NORM_EPS = 1e-6f;
constexpr float LAM_INIT = 0.2f;

constexpr size_t MiB = 1u << 20;
constexpr size_t WS_CTL = 0, CTL_ZERO_BYTES = 1 * MiB;
constexpr size_t WS_MOD = 1 * MiB;
constexpr size_t WS_LAM = 1 * MiB + 128 * 1024;
constexpr size_t WS_ROPE = 2 * MiB;
constexpr size_t WS_WIN = 4 * MiB;
constexpr size_t WS_WOUT = 100 * MiB;
constexpr size_t WS_WSC = 132 * MiB;
constexpr size_t WS_UB = 148 * MiB;
constexpr size_t WS_VB = 276 * MiB;
constexpr size_t WS_H1 = 404 * MiB;
constexpr size_t WS_Y = 468 * MiB;
constexpr size_t WS_H2 = 532 * MiB;
constexpr size_t WS_QKV = 596 * MiB;
constexpr size_t QKV_T = (size_t)16 * S * 128;
constexpr size_t WS_OD = 788 * MiB;
constexpr size_t WS_OS = 916 * MiB;
constexpr size_t WS_LSE = 1108 * MiB;
constexpr size_t WS_X1 = 1110 * MiB;
constexpr size_t WS_SC = 1238 * MiB;
constexpr size_t WS_IDX = 1302 * MiB;
constexpr size_t WS_GATE = 1306 * MiB;
constexpr size_t WS_QKV2 = 1310 * MiB;
constexpr size_t WS_END = 1502 * MiB;
constexpr int CW_BAR = 4096;

constexpr int RING_BYTES = 131072;
constexpr int MISC_OFF = RING_BYTES + 320;
constexpr int LDS_BYTES = 147456;

namespace pg8 {
#define PG8_LAS __attribute__((address_space(3)))
typedef unsigned short bf16_t;
typedef short bf16x8 __attribute__((ext_vector_type(8)));
typedef float f32x4 __attribute__((ext_vector_type(4)));
typedef unsigned u32x4 __attribute__((ext_vector_type(4)));
constexpr int BM = 256, BK = 64, HALF = 128, HTB = HALF * BK * 2  , STAGE_BYTES = 8 * HTB, NXCD = 8, WGM = 8;

__host__ __device__ __forceinline__ int lds_byte(int r, int c) { const int st = (r >> 4) * 2 + (c >> 5), rr = r & 15, cc = c & 31, ob = rr * 64 + cc * 2; return st * 1024 + (ob ^ (((ob >> 9) & 1) << 5)); }
__host__ __device__ __forceinline__ void stage_rc(int b, int& R, int& C) { const int st = b / 1024, sb = b % 1024, swz = sb ^ (((sb >> 9) & 1) << 5); R = (st >> 1) * 16 + swz / 64; C = (st & 1) * 32 + (swz % 64) / 2; }
__host__ __device__ __forceinline__ int perm32(int rho) { const int n = rho >> 4, i = rho & 15; return 8 * (i >> 2) + 4 * n + (i & 3); }

struct Unit { int pm, pn; };
struct Gemm { const bf16_t* A; const bf16_t* Bt; int M, N, K; };

struct StaticOrder {
    int nM, nN, nwg, G, c;
    __host__ __device__ void init(int M, int N, int G_, int c_) { nM = M / BM; nN = N / BM; nwg = nM * nN; G = G_; c = c_; }
    __host__ __device__ bool next(int i, Unit& u) const {
        const long L = (long)i * G + c; if (L >= nwg) return false;
        int wgid = (int)L; { const int q = nwg / NXCD, r = nwg % NXCD, xcd = wgid % NXCD, off = wgid / NXCD; wgid = (xcd < r ? xcd * (q + 1) : r * (q + 1) + (xcd - r) * q) + off; }
        const int nig = WGM * nN, gid = wgid / nig, fm = gid * WGM, gsz = (nM - fm) < WGM ? (nM - fm) : WGM;
        u.pm = fm + ((wgid % nig) % gsz); u.pn = (wgid % nig) / gsz; return true;
    }
    __device__ __forceinline__ void a_ready(const Unit&) const {}
    __device__ __forceinline__ void done(const Unit&) const {}
};
struct CountedOrder : StaticOrder {
    const unsigned* ready; unsigned need; unsigned* tmo;
    __device__ __forceinline__ void a_ready(const Unit& u) const {
        if (threadIdx.x < 64) {
            const unsigned long long t0 = __builtin_amdgcn_s_memrealtime(); unsigned polls = 0;
            while ((unsigned)__builtin_amdgcn_readfirstlane(__hip_atomic_load(ready + 64 * u.pm, __ATOMIC_RELAXED, __HIP_MEMORY_SCOPE_AGENT)) < need) {
                if ((++polls & 255u) == 0u && __builtin_amdgcn_readfirstlane(__hip_atomic_load(tmo, __ATOMIC_RELAXED, __HIP_MEMORY_SCOPE_AGENT)) != 0u) break;
                if (__builtin_amdgcn_s_memrealtime() - t0 > 2000000ull) {
                    if (threadIdx.x == 0) { unsigned expect = 0u; __hip_atomic_compare_exchange_strong(tmo + 1, &expect, 0x600u | (unsigned)(u.pm & 0xff), __ATOMIC_RELAXED, __ATOMIC_RELAXED, __HIP_MEMORY_SCOPE_AGENT); __hip_atomic_store(tmo, 1u, __ATOMIC_RELAXED, __HIP_MEMORY_SCOPE_AGENT); }
                    break; }
                __builtin_amdgcn_s_sleep(2); }
            __builtin_amdgcn_fence(__ATOMIC_ACQUIRE, "agent");
            asm volatile("s_waitcnt vmcnt(0)" ::: "memory");
        }
#if !defined(BROKEN_HOOK_NO_BARRIER)
        asm volatile("" ::: "memory"); __builtin_amdgcn_s_barrier(); asm volatile("" ::: "memory");
#endif
    }
};

__device__ __forceinline__ unsigned cvt_pk_bf16(float lo, float hi) { unsigned r; asm volatile("v_cvt_pk_bf16_f32 %0, %1, %2" : "=v"(r) : "v"(lo), "v"(hi)); return r; }
typedef float f32x2 __attribute__((ext_vector_type(2)));
__device__ __forceinline__ f32x2 gelu_pk(f32x2 v) {
    const f32x2 av = __builtin_elementwise_abs(v), d = av * 0.2316418882f + 1.0f;
    f32x2 t; t.x = __builtin_amdgcn_rcpf(d.x); t.y = __builtin_amdgcn_rcpf(d.y);
    f32x2 q = t * 0.5307027145f + (-0.7265760135f); q = q * t + 0.7107068705f; q = q * t + (-0.142248368f); q = q * t + 0.127414796f; q = q * t;
    const f32x2 s = (v * v) * (-0.72134752044f);
    f32x2 e; e.x = __builtin_amdgcn_exp2f(s.x); e.y = __builtin_amdgcn_exp2f(s.y);
    const f32x2 m = v * (q * e), r = v - m;
    f32x2 o; o.x = v.x < 0.f ? m.x : r.x; o.y = v.y < 0.f ? m.y : r.y; return o;
}

struct EpiF32 {
    static constexpr bool PERM = false, AFTER_DRAIN = false;
    float* C; int ldc; const float* bias;
    __device__ __forceinline__ void operator()(const f32x4 (&acc)[2][2][4][2], const Unit& u, int wr, int wc, int fr, int fq) const {
        const int row0 = u.pm * BM + wr * 64 + fr, col0 = u.pn * BM + wc * 32 + 4 * fq;
        f32x4 bv[2][2];
#pragma unroll
        for (int bj = 0; bj < 2; ++bj)
#pragma unroll
            for (int n = 0; n < 2; ++n) bv[bj][n] = bias ? *(const f32x4*)(bias + col0 + bj * HALF + n * 16) : (f32x4){0.f, 0.f, 0.f, 0.f};
#pragma unroll
        for (int ai = 0; ai < 2; ++ai)
#pragma unroll
            for (int m = 0; m < 4; ++m) { float* rowp = C + (size_t)(row0 + ai * HALF + m * 16) * ldc + col0;
#pragma unroll
                for (int bj = 0; bj < 2; ++bj)
#pragma unroll
                    for (int n = 0; n < 2; ++n) *(f32x4*)(rowp + bj * HALF + n * 16) = acc[ai][bj][m][n] + bv[bj][n]; }
    }
};
template <int ACT  > struct EpiBf16 {
    static constexpr bool PERM = true, AFTER_DRAIN = false;
    bf16_t* O; int ldc; const float* bias; int split_cols; size_t split_stride;
    __device__ __forceinline__ void operator()(const f32x4 (&acc)[2][2][4][2], const Unit& u, int wr, int wc, int fr, int fq) const {
        const int row0 = u.pm * BM + wr * 64 + fr; int colt = u.pn * BM; bf16_t* base = O;
        if (split_cols) { const int t = colt / split_cols; base += (size_t)t * split_stride; colt -= t * split_cols; }
        const int col0 = colt + wc * 32 + 8 * fq, bcol0 = u.pn * BM + wc * 32 + 8 * fq;
        f32x4 bv[2][2];
#pragma unroll
        for (int bj = 0; bj < 2; ++bj)
#pragma unroll
            for (int n = 0; n < 2; ++n) bv[bj][n] = bias ? *(const f32x4*)(bias + bcol0 + bj * HALF + 4 * n) : (f32x4){0.f, 0.f, 0.f, 0.f};
#pragma unroll
        for (int ai = 0; ai < 2; ++ai)
#pragma unroll
            for (int m = 0; m < 4; ++m) { bf16_t* rowp = base + (size_t)(row0 + ai * HALF + m * 16) * ldc + col0;
#pragma unroll
                for (int bj = 0; bj < 2; ++bj) { f32x4 v0 = acc[ai][bj][m][0] + bv[bj][0], v1 = acc[ai][bj][m][1] + bv[bj][1];
                    if (ACT == 1) { f32x2 a = gelu_pk((f32x2){v0[0], v0[1]}), b = gelu_pk((f32x2){v0[2], v0[3]}), c = gelu_pk((f32x2){v1[0], v1[1]}), d = gelu_pk((f32x2){v1[2], v1[3]});
                        v0 = (f32x4){a.x, a.y, b.x, b.y}; v1 = (f32x4){c.x, c.y, d.x, d.y}; }
                    if (ACT == 2) {
#pragma unroll
                        for (int j = 0; j < 4; ++j) { v0[j] = 0.5f * v0[j] * (1.0f + erff(v0[j] * 0.70710678f)); v1[j] = 0.5f * v1[j] * (1.0f + erff(v1[j] * 0.70710678f)); } }
                    u32x4 w; w.x = cvt_pk_bf16(v0[0], v0[1]); w.y = cvt_pk_bf16(v0[2], v0[3]); w.z = cvt_pk_bf16(v1[0], v1[1]); w.w = cvt_pk_bf16(v1[2], v1[3]);
                    *(u32x4*)(rowp + bj * HALF) = w; } }
    }
};
template <class Epi, class Sched, bool STAMP = false>
__device__ __forceinline__ void gemm_phase(PG8_LAS unsigned char* lds, const Gemm g, const Sched& S, const Epi& E, unsigned long long* stamps) {
    const int tid = threadIdx.x, wid = __builtin_amdgcn_readfirstlane(tid >> 6), lane = tid & 63, wr = wid >> 2, wc = wid & 3, fr = lane & 15, fq = lane >> 4;
    const int K = g.K, nt = K / BK;
    int ts_lo = 0, ts_hi = 0, nts = 0; const unsigned long long rt_entry = STAMP ? (unsigned long long)wall_clock64() : 0ull;
#define PG8_STAMP() do { if (STAMP && wid == 0 && nts < 64) { const unsigned long long _c = (unsigned long long)clock64(); \
        ts_lo = (lane == nts) ? (int)(unsigned)_c : ts_lo; ts_hi = (lane == nts) ? (int)(unsigned)(_c >> 32) : ts_hi; ++nts; } } while (0)
    PG8_STAMP();
    unsigned voffA[2], voffB[2];
#pragma unroll
    for (int i = 0; i < 2; ++i) { int R, C; stage_rc(tid * 16 + i * 8192, R, C); const int Rb = Epi::PERM ? ((R & ~31) + perm32(R & 31)) : R;
        voffA[i] = (unsigned)(R * K + C) * 2u; voffB[i] = (unsigned)(Rb * K + C) * 2u; }
    const size_t kstep = (size_t)(BK * 2);
    const size_t hstep = (size_t)HALF * K * 2;
    const size_t tstep = 2 * hstep;
    const unsigned ldsw = (unsigned)wid * 1024u;
    const int aoff = lds_byte(wr * 64 + fr, fq * 8), boff = lds_byte(wc * 32 + fr, fq * 8);
#define PG8_SA(b, h) (((b) * 2 + (h)) * HTB)
#define PG8_SB(b, h) ((4 + (b) * 2 + (h)) * HTB)
#define PG8_STAGE(bufoff, gbase, voff) do { _Pragma("unroll") for (int _i = 0; _i < 2; ++_i) \
        __builtin_amdgcn_global_load_lds((const unsigned*)((const char*)(gbase) + (voff)[_i]), (PG8_LAS unsigned*)(lds + (bufoff) + ldsw + _i * 8192), 16, 0, 0); } while (0)
#define PG8_LDA(dst, b, h) do { _Pragma("unroll") for (int m = 0; m < 4; ++m) _Pragma("unroll") for (int k = 0; k < 2; ++k) dst[m][k] = *(const PG8_LAS bf16x8*)(lds + PG8_SA(b, h) + aoff + m * 2048 + k * 1024); } while (0)
#define PG8_LDB(dst, b, h) do { _Pragma("unroll") for (int n = 0; n < 2; ++n) _Pragma("unroll") for (int k = 0; k < 2; ++k) dst[n][k] = *(const PG8_LAS bf16x8*)(lds + PG8_SB(b, h) + boff + n * 2048 + k * 1024); } while (0)
#define PG8_MMA(ai, bj, At, Bt) do { __builtin_amdgcn_s_setprio(1); _Pragma("unroll") for (int m = 0; m < 4; ++m) _Pragma("unroll") for (int n = 0; n < 2; ++n) _Pragma("unroll") for (int k = 0; k < 2; ++k) \
        acc[ai][bj][m][n] = __builtin_amdgcn_mfma_f32_16x16x32_bf16(Bt[n][k], At[m][k], acc[ai][bj][m][n], 0, 0, 0); __builtin_amdgcn_s_setprio(0); } while (0)
#define PG8_WAIT_V(n) asm volatile("s_waitcnt vmcnt(" #n ")" ::: "memory")
#define PG8_WAIT_L(n) asm volatile("s_waitcnt lgkmcnt(" #n ")" ::: "memory")
#define PG8_BAR __builtin_amdgcn_s_barrier()
#define PG8_SCHED __builtin_amdgcn_sched_barrier(0)
    Unit cur, nxt; int ui = 0;
    if (!S.next(0, cur)) return;
    f32x4 acc[2][2][4][2];
#pragma unroll
    for (int a = 0; a < 2; ++a)
#pragma unroll
        for (int b = 0; b < 2; ++b)
#pragma unroll
            for (int m = 0; m < 4; ++m)
#pragma unroll
                for (int n = 0; n < 2; ++n) acc[a][b][m][n] = (f32x4){0.f, 0.f, 0.f, 0.f};
    bf16x8 At[4][2], B0[2][2], B1[2][2];
    const char* cA = (const char*)g.A + (size_t)cur.pm * tstep; const char* cB = (const char*)g.Bt + (size_t)cur.pn * tstep;
    S.a_ready(cur);
    PG8_STAGE(PG8_SB(0, 0), cB, voffB); PG8_STAGE(PG8_SA(0, 0), cA, voffA); PG8_STAGE(PG8_SB(0, 1), cB + hstep, voffB); PG8_STAGE(PG8_SA(0, 1), cA + hstep, voffA);
    if (wr == 1) PG8_BAR;
    PG8_WAIT_V(4); PG8_BAR;
    PG8_STAGE(PG8_SB(1, 0), cB + kstep, voffB); PG8_STAGE(PG8_SA(1, 0), cA + kstep, voffA); PG8_STAGE(PG8_SB(1, 1), cB + hstep + kstep, voffB);
    PG8_WAIT_V(6); PG8_BAR;
    PG8_STAMP();
    for (;;) {
        const bool has_next = S.next(ui + 1, nxt);
        const char* nA = has_next ? (const char*)g.A + (size_t)nxt.pm * tstep : cA; const char* nB = has_next ? (const char*)g.Bt + (size_t)nxt.pn * tstep : cB;
        for (int t = 0; t < nt; t += 2) {
            const bool last = (t == nt - 2);
            const char* a1 = cA + (size_t)(t + 1) * kstep;
            const char* a2 = last ? nA : cA + (size_t)(t + 2) * kstep; const char* b2 = last ? nB : cB + (size_t)(t + 2) * kstep;
            const char* a3 = a2 + kstep; const char* b3 = b2 + kstep;
            if (last && has_next) S.a_ready(nxt);
            PG8_LDB(B0, 0, 0); PG8_SCHED; PG8_LDA(At, 0, 0); PG8_STAGE(PG8_SA(1, 1), a1 + hstep, voffA);
            PG8_WAIT_L(8); PG8_BAR; PG8_WAIT_L(0); PG8_MMA(0, 0, At, B0); PG8_BAR; PG8_SCHED;
            PG8_LDB(B1, 0, 1); PG8_STAGE(PG8_SB(0, 0), b2, voffB);
            PG8_BAR; PG8_WAIT_L(0); PG8_MMA(0, 1, At, B1); PG8_BAR;
            PG8_LDA(At, 0, 1); PG8_STAGE(PG8_SA(0, 0), a2, voffA);
            PG8_BAR; PG8_WAIT_L(0); PG8_MMA(1, 0, At, B0); PG8_BAR; PG8_SCHED;
            PG8_STAGE(PG8_SB(0, 1), b2 + hstep, voffB);
            PG8_WAIT_V(6); PG8_BAR; PG8_MMA(1, 1, At, B1); PG8_BAR;
            PG8_LDB(B0, 1, 0); PG8_SCHED; PG8_LDA(At, 1, 0); PG8_STAGE(PG8_SA(0, 1), a2 + hstep, voffA);
            PG8_WAIT_L(8); PG8_BAR; PG8_WAIT_L(0); PG8_MMA(0, 0, At, B0); PG8_BAR; PG8_SCHED;
            PG8_LDB(B1, 1, 1); PG8_STAGE(PG8_SB(1, 0), b3, voffB);
            PG8_BAR; PG8_WAIT_L(0); PG8_MMA(0, 1, At, B1); PG8_BAR;
            PG8_LDA(At, 1, 1); PG8_STAGE(PG8_SA(1, 0), a3, voffA);
            PG8_BAR; PG8_WAIT_L(0); PG8_MMA(1, 0, At, B0); PG8_BAR; PG8_SCHED;
            PG8_STAGE(PG8_SB(1, 1), b3 + hstep, voffB);
            PG8_WAIT_V(6); PG8_BAR; PG8_MMA(1, 1, At, B1); PG8_BAR;
        }
        PG8_STAMP();
        if constexpr (!Epi::AFTER_DRAIN) { E(acc, cur, wr, wc, fr, fq); S.done(cur); }
        PG8_STAMP();
        if (!has_next) break;
#pragma unroll
        for (int a = 0; a < 2; ++a)
#pragma unroll
            for (int b = 0; b < 2; ++b)
#pragma unroll
                for (int m = 0; m < 4; ++m)
#pragma unroll
                    for (int n = 0; n < 2; ++n) acc[a][b][m][n] = (f32x4){0.f, 0.f, 0.f, 0.f};
        cur = nxt; cA = nA; cB = nB; ++ui;
    }
    PG8_WAIT_V(0);
    if (wr == 0) PG8_BAR;
    PG8_BAR;
    if constexpr (Epi::AFTER_DRAIN) { E.fused(acc, cur, wr, wc, fr, fq, lds, wid, lane); S.done(cur); }
    PG8_STAMP();
    if (STAMP && wid == 0) { stamps[lane] = lane < nts ? (((unsigned long long)(unsigned)ts_hi << 32) | (unsigned)ts_lo) : 0ull;
        if (lane == 62) stamps[62] = rt_entry; if (lane == 63) stamps[63] = (unsigned long long)wall_clock64(); }
#undef PG8_STAMP
#undef PG8_SA
#undef PG8_SB
#undef PG8_STAGE
#undef PG8_LDA
#undef PG8_LDB
#undef PG8_MMA
#undef PG8_WAIT_V
#undef PG8_WAIT_L
#undef PG8_BAR
#undef PG8_SCHED
}
}
namespace at {
constexpr int D = 128;
constexpr float THR = 8.f;
constexpr float SCALE = 0.08838834764831845f;
constexpr int NW = 8, QBLK = 32, KVBLK = 64, QB = NW * QBLK;
constexpr int SHM_V = KVBLK * D * 2, SHM_K = KVBLK * D * 2;
constexpr int LDS_BYTES = 2 * SHM_V + 2 * SHM_K + NW * 64 * 4;

typedef unsigned short bf16;
typedef short bf16x8 __attribute__((ext_vector_type(8)));
typedef short s16x4 __attribute__((ext_vector_type(4)));
typedef float f32x16 __attribute__((ext_vector_type(16)));
typedef float f32x4 __attribute__((ext_vector_type(4)));
typedef unsigned u32x4 __attribute__((ext_vector_type(4)));
template <class A, class Bt> struct same_t { static constexpr bool v = false; };
template <class A> struct same_t<A, A> { static constexpr bool v = true; };

#define KSWZ(row, colB) ((row) * 256 + ((colB) ^ (((row) & 7) << 4)))
#define SBAR() __builtin_amdgcn_sched_barrier(0)
__device__ __forceinline__ int v_st(int k, int c) { const int kk = (k & ~0xC) | ((k & 4) << 1) | ((k & 8) >> 1); return ((kk >> 3) * 4 + (c >> 5)) * 512 + ((kk & 7) * 32 + (c & 31)) * 2; }
__device__ __forceinline__ int v_rd_base(int lane) { return ((lane & 3) << 3) | (((lane >> 2) & 3) << 6) | (((lane >> 4) & 1) << 5) | (((lane >> 5) & 1) << 8); }
constexpr int v_rd_off(int d0, int ks, int half) { return d0 * 512 + ks * 4096 + half * 2048; }
__device__ __forceinline__ int crow(int r, int hi) { return (r & 3) + 8 * (r >> 2) + 4 * hi; }
__device__ __forceinline__ unsigned cvtpk(float lo, float hi) {
    unsigned r; asm volatile("v_cvt_pk_bf16_f32 %0, %1, %2" : "=v"(r) : "v"(lo), "v"(hi)); return r;
}
__device__ __forceinline__ bf16x8 pack8(f32x4 a, f32x4 b) {
    u32x4 w = {cvtpk(a[0], a[1]), cvtpk(a[2], a[3]), cvtpk(b[0], b[1]), cvtpk(b[2], b[3])};
    return *reinterpret_cast<bf16x8*>(&w);
}
template <class T> __device__ __forceinline__ bf16x8 load8(const T* p) {
    if constexpr (same_t<T, float>::v) { return pack8(*(const f32x4*)p, *(const f32x4*)(p + 4)); }
    else { return *reinterpret_cast<const bf16x8*>(p); }
}
__device__ __forceinline__ void mask_tile(f32x16& p0, f32x16& p1, int dq, unsigned W) {
    const float NEG = -__builtin_inff();
#pragma unroll
    for (int r = 0; r < 16; ++r) {
        const int c = (r & 3) + 8 * (r >> 2);
        if ((unsigned)(dq - c) >= W) p0[r] = NEG;
        if ((unsigned)(dq - c - 32) >= W) p1[r] = NEG;
    }
}
__device__ __forceinline__ void partialSM(f32x16& p0, f32x16& p1, float& m_reg, float& mn, float& alpha) {
    float pmax = p0[0]; for (int r = 1; r < 16; ++r) pmax = fmaxf(pmax, p0[r]); for (int r = 0; r < 16; ++r) pmax = fmaxf(pmax, p1[r]);
    { auto rr = __builtin_amdgcn_permlane32_swap(__float_as_uint(pmax), __float_as_uint(pmax), false, false);
      pmax = fmaxf(__uint_as_float(rr[0]), __uint_as_float(rr[1])); }
    constexpr float C2 = 1.4426950408889634f * SCALE;
    if (__builtin_expect(__all((pmax - m_reg) * SCALE <= THR), 1)) { mn = m_reg; alpha = 1.f; }
    else { mn = fmaxf(m_reg, pmax); alpha = __builtin_amdgcn_exp2f((m_reg - mn) * C2); m_reg = mn; }
    const float mnL = -mn * C2;
    for (int r = 0; r < 16; ++r) p0[r] = fmaf(p0[r], C2, mnL); for (int r = 0; r < 16; ++r) p1[r] = fmaf(p1[r], C2, mnL);
    for (int r = 0; r < 16; ++r) p0[r] = __builtin_amdgcn_exp2f(p0[r]);
}
__device__ __forceinline__ void finishSM(f32x16& p0, f32x16& p1, float alpha, float& l_reg, bf16x8& pa0, bf16x8& pa1, bf16x8& pa2, bf16x8& pa3) {
    for (int r = 0; r < 16; ++r) p1[r] = __builtin_amdgcn_exp2f(p1[r]);
    float ps = 0; for (int r = 0; r < 16; ++r) ps += p0[r]; for (int r = 0; r < 16; ++r) ps += p1[r];
    { auto rr = __builtin_amdgcn_permlane32_swap(__float_as_uint(ps), __float_as_uint(ps), false, false);
      ps = __uint_as_float(rr[0]) + __uint_as_float(rr[1]); }
    l_reg = l_reg * alpha + ps;
#define PK4(P, B_, OUT) do { unsigned a0 = cvtpk(P[B_+0], P[B_+1]), a1 = cvtpk(P[B_+2], P[B_+3]);                          \
        unsigned b0 = cvtpk(P[B_+4], P[B_+5]), b1 = cvtpk(P[B_+6], P[B_+7]);                                             \
        auto r0 = __builtin_amdgcn_permlane32_swap(a0, b0, false, false); auto r1 = __builtin_amdgcn_permlane32_swap(a1, b1, false, false); \
        u32x4 w = {r0[0], r1[0], r0[1], r1[1]}; OUT = *reinterpret_cast<bf16x8*>(&w); } while (0)
    PK4(p0, 0, pa0); PK4(p0, 8, pa1); PK4(p1, 0, pa2); PK4(p1, 8, pa3);
#undef PK4
}
template <int KB, bool SK>
__device__ __forceinline__ void qkt(f32x16& p0, f32x16& p1, const char* K_lds, int r32, int hi, const bf16x8* qr, bool act) {
    if (SK && !act) { const float NEG = -__builtin_inff();
#pragma unroll
        for (int r = 0; r < 16; ++r) { p0[r] = NEG; p1[r] = NEG; } return; }
    p0 = f32x16{}; p1 = f32x16{};
    const char* kb[4];
#pragma unroll
    for (int dd = 0; dd < 4; ++dd) kb[dd] = K_lds + KB * SHM_K + KSWZ(r32, (dd * 16 + hi * 8) * 2);
#pragma unroll
    for (int d0 = 0; d0 < 8; ++d0) { const char* a = kb[d0 & 3] + (d0 >> 2) * 128;
        bf16x8 b0 = *reinterpret_cast<const bf16x8*>(a);
        bf16x8 b1 = *reinterpret_cast<const bf16x8*>(a + 32 * 256);
        p0 = __builtin_amdgcn_mfma_f32_32x32x16_bf16(b0, qr[d0], p0, 0, 0, 0);
        p1 = __builtin_amdgcn_mfma_f32_32x32x16_bf16(b1, qr[d0], p1, 0, 0, 0); }
}
template <int VB, bool SK>
__device__ __forceinline__ void pv_tile(f32x16* o, int vb0, bf16x8 pa0, bf16x8 pa1, bf16x8 pa2, bf16x8 pa3, bool act) {
    if (SK && !act) return;
#define TRRD(dst, off) asm volatile("ds_read_b64_tr_b16 %0, %1 offset:%2" : "=&v"(dst) : "v"(vb0), "i"(off) : "memory")
#define PV_D0(d0) do { s16x4 l0, l1, l2, l3, h0, h1, h2, h3; constexpr int b_ = VB * SHM_V + v_rd_off(d0, 0, 0);     \
        TRRD(l0, b_); TRRD(h0, b_ + 2048); TRRD(l1, b_ + 4096); TRRD(h1, b_ + 6144); TRRD(l2, b_ + 8192); TRRD(h2, b_ + 10240); TRRD(l3, b_ + 12288); TRRD(h3, b_ + 14336); \
        asm volatile("s_waitcnt lgkmcnt(0)" ::: "memory"); SBAR();                 \
        o[d0] = __builtin_amdgcn_mfma_f32_32x32x16_bf16(pa0, (bf16x8){l0[0], l0[1], l0[2], l0[3], h0[0], h0[1], h0[2], h0[3]}, o[d0], 0, 0, 0);   \
        o[d0] = __builtin_amdgcn_mfma_f32_32x32x16_bf16(pa1, (bf16x8){l1[0], l1[1], l1[2], l1[3], h1[0], h1[1], h1[2], h1[3]}, o[d0], 0, 0, 0);   \
        o[d0] = __builtin_amdgcn_mfma_f32_32x32x16_bf16(pa2, (bf16x8){l2[0], l2[1], l2[2], l2[3], h2[0], h2[1], h2[2], h2[3]}, o[d0], 0, 0, 0);   \
        o[d0] = __builtin_amdgcn_mfma_f32_32x32x16_bf16(pa3, (bf16x8){l3[0], l3[1], l3[2], l3[3], h3[0], h3[1], h3[2], h3[3]}, o[d0], 0, 0, 0); } while (0)
    PV_D0(0); PV_D0(1); PV_D0(2); PV_D0(3);
#undef PV_D0
#undef TRRD
}

struct BlockRef { const bf16* Q; const bf16* K; const bf16* V; float* O; float* L; int P0, W, skv; };
struct Seam { bf16x8 qr[8]; bf16x8 st_v0, st_v1, st_k0, st_k1; };
__device__ __forceinline__ int swa_jlo(int P0, int W) { const int lowk = P0 - W + 1; return lowk > 0 ? lowk / KVBLK : 0; }
#define VMW() asm volatile("s_waitcnt vmcnt(0)" ::: "memory")
#define VMWN(n) asm volatile("s_waitcnt vmcnt(%0)" :: "i"(n) : "memory")
#define ROW(p, k0, rr) ((p) + (size_t)((k0) + (rr)) * D + sc)
#define SLOAD_H(Kp, Vp, k0) do { S.st_v0 = load8<bf16>(ROW(Vp, k0, sr)); S.st_v1 = load8<bf16>(ROW(Vp, k0, 32 + sr));              \
                         S.st_k0 = load8<bf16>(ROW(Kp, k0, sr)); S.st_k1 = load8<bf16>(ROW(Kp, k0, 32 + sr)); } while (0)
#define SWRITE_HK(bf) do { *(bf16x8*)(K_lds + (bf) * SHM_K + kws) = S.st_k0; *(bf16x8*)(K_lds + (bf) * SHM_K + kws + 32 * 256) = S.st_k1; } while (0)
#define SWRITE_HV(bf) do { *(bf16x8*)(V_lds + (bf) * SHM_V + vst0) = S.st_v0; *(bf16x8*)(V_lds + (bf) * SHM_V + vst1) = S.st_v1; } while (0)
#define SWRITE_H(bf) do { SWRITE_HV(bf); SWRITE_HK(bf); } while (0)
__device__ __forceinline__ void causal_swa_prime(const BlockRef& cur, char* lds, Seam& S) {
    const int tid = threadIdx.x, wid = __builtin_amdgcn_readfirstlane(tid >> 6), lane = tid & 63, r32 = lane & 31, hi = lane >> 5;
    const int sr = tid >> 4, sc = (tid & 15) * 8, kws = KSWZ(sr, sc * 2); char* K_lds = lds + 2 * SHM_V;
    const int kb0 = swa_jlo(cur.P0, cur.W) * KVBLK;
    for (int d0 = 0; d0 < 8; ++d0) S.qr[d0] = load8<bf16>(cur.Q + (size_t)(wid * QBLK + r32) * D + d0 * 16 + hi * 8);
    SLOAD_H(cur.K, cur.V, kb0); VMW(); SWRITE_HK(0);
    __syncthreads();
}
template <bool SK>
__device__ __forceinline__ void causal_swa_block(const BlockRef& cur, const BlockRef& nxt, char* lds, Seam& S) {
    const int tid = threadIdx.x, wid = __builtin_amdgcn_readfirstlane(tid >> 6), lane = tid & 63, r32 = lane & 31, hi = lane >> 5;
    const int W = cur.W, skv = cur.skv;
    const int j_lo = swa_jlo(cur.P0, W);
    int j_hi = (cur.P0 + QB - 1) / KVBLK + 1; if (j_hi > skv / KVBLK) j_hi = skv / KVBLK;
    const int NT = j_hi - j_lo;
    const int kbn = swa_jlo(nxt.P0, nxt.W) * KVBLK;
    const int qlo = cur.P0 + wid * QBLK, qm = qlo + r32 - 4 * hi;
    char* V_lds = lds; char* K_lds = lds + 2 * SHM_V;
    float* ws = (float*)(lds + 2 * SHM_V + 2 * SHM_K) + wid * 64; float* li_l = ws, * al_l = ws + 32;
    float m_reg = -1e30f, l_reg = 0; f32x16 o[4] = {};
    const int sr = tid >> 4, sc = (tid & 15) * 8, vst0 = v_st(sr, sc), vst1 = v_st(32 + sr, sc), kws = KSWZ(sr, sc * 2);
    const int vb0 = (int)(uintptr_t)V_lds + v_rd_base(lane);
    const bf16* Kh = cur.K; const bf16* Vh = cur.V;
#define RESC(a) do { if (__any((a) < 1.f)) { if (hi == 0) al_l[r32] = (a); asm volatile("s_waitcnt lgkmcnt(0)" ::: "memory");              \
                     for (int d_ = 0; d_ < 4; ++d_) for (int r = 0; r < 16; ++r) o[d_][r] *= al_l[crow(r, hi)]; } } while (0)
#define KBASE(t) ((j_lo + (t)) * KVBLK)
#define ACT(t) (KBASE(t) <= qlo + QBLK - 1 && KBASE(t) + KVBLK - 1 >= qlo - W + 1)
#define MASKT(P0_, P1_, t) do { const int kb_ = KBASE(t); if ((!SK || ACT(t)) && (kb_ + KVBLK - 1 > qlo || kb_ <= qlo + QBLK - 1 - W)) mask_tile(P0_, P1_, qm - kb_, (unsigned)W); } while (0)
    constexpr int NQL = 8;
#define SEAM_K0() do { VMWN(NQL); SWRITE_HK(0); SBAR(); } while (0)
    f32x16 pA0, pA1, pB0, pB1; float mnA, mnB, alA, alB; bf16x8 pa0, pa1, pa2, pa3;
    SWRITE_HV(0); SBAR();
    if (NT > 1) { SLOAD_H(Kh, Vh, KBASE(1)); }
    SBAR(); qkt<0, SK>(pA0, pA1, K_lds, r32, hi, S.qr, ACT(0));
    MASKT(pA0, pA1, 0); partialSM(pA0, pA1, m_reg, mnA, alA);
    if (NT > 1) { VMW(); SWRITE_H(1); }
    __syncthreads();
#define HALF_STEP(PX0, PX1, mnX, alX, PY0, PY1, alY, t, KB, VB, SB) do {                                                      \
        SBAR(); qkt<KB, SK>(PX0, PX1, K_lds, r32, hi, S.qr, ACT(t));                                             \
        finishSM(PY0, PY1, alY, l_reg, pa0, pa1, pa2, pa3); SBAR();                                                           \
        if ((t) + 1 < NT) { SLOAD_H(Kh, Vh, KBASE((t) + 1)); SBAR(); }                                               \
        pv_tile<VB, SK>(o, vb0, pa0, pa1, pa2, pa3, ACT((t) - 1)); MASKT(PX0, PX1, (t)); partialSM(PX0, PX1, m_reg, mnX, alX);                                        \
        __syncthreads();                                                                                                      \
        if ((t) + 1 < NT) { VMW(); SWRITE_H(SB); }                                                                          \
        RESC(alX); __syncthreads(); } while (0)
    for (int t = 1; t + 1 < NT; t += 2) {
        HALF_STEP(pB0, pB1, mnB, alB, pA0, pA1, alA, t, 1, 0, 0);
        HALF_STEP(pA0, pA1, mnA, alA, pB0, pB1, alB, t + 1, 0, 1, 1);
    }
    const bool even = (NT & 1) == 0;
    if (even) { SBAR(); qkt<1, SK>(pB0, pB1, K_lds, r32, hi, S.qr, ACT(NT - 1)); SBAR(); }
    { SLOAD_H(nxt.K, nxt.V, kbn); SBAR();
#pragma unroll
      for (int d0 = 0; d0 < 8; ++d0) S.qr[d0] = load8<bf16>(nxt.Q + (size_t)(wid * QBLK + r32) * D + d0 * 16 + hi * 8); }
    SBAR();
    finishSM(pA0, pA1, alA, l_reg, pa0, pa1, pa2, pa3); SBAR();
    pv_tile<0, SK>(o, vb0, pa0, pa1, pa2, pa3, ACT(even ? NT - 2 : NT - 1));
    if (even) { MASKT(pB0, pB1, NT - 1); partialSM(pB0, pB1, m_reg, mnB, alB); __syncthreads(); RESC(alB);
        finishSM(pB0, pB1, alB, l_reg, pa0, pa1, pa2, pa3); SBAR(); pv_tile<1, SK>(o, vb0, pa0, pa1, pa2, pa3, ACT(NT - 1)); }
    SBAR(); SEAM_K0();
    if (hi == 0) li_l[r32] = l_reg; asm volatile("s_waitcnt lgkmcnt(0)" ::: "memory");
    if (cur.L != nullptr && hi == 0) cur.L[wid * QBLK + r32] = m_reg * SCALE + __logf(l_reg);
    float rli[16];
#pragma unroll
    for (int r = 0; r < 16; ++r) rli[r] = __builtin_amdgcn_rcpf(li_l[crow(r, hi)]);
    float* Ow = cur.O + (size_t)(wid * QBLK) * D;
#pragma unroll
    for (int r = 0; r < 16; ++r) { const int orow = crow(r, hi);
#pragma unroll
        for (int d0 = 0; d0 < 4; ++d0) { const float v = o[d0][r] * rli[r]; Ow[(size_t)orow * D + d0 * 32 + r32] = v; } }
    __syncthreads();
#undef RESC
#undef KBASE
#undef ACT
#undef MASKT
#undef SEAM_K0
#undef HALF_STEP
}
#undef ROW
#undef VMW
#undef VMWN
#undef SLOAD_H
#undef SWRITE_HK
#undef SWRITE_HV
#undef SWRITE_H
#undef KSWZ
#undef SBAR
}
#define XB_TMO      128
#define XB_XCNT(j)  (256  + 64 * (j))
#define XB_XSUB(j)  (1280 + 64 * (j))
#define XB_XGEN(j)  (2304 + 64 * (j))
#define XB_TOP      3328
#define XB_TOPGEN   3392
#define XCD_BAR_WORDS 3456
#define XB_SPIN_CAP (1u << 18)
#define LAS __attribute__((address_space(3)))

__device__ __forceinline__ unsigned xb_ld(unsigned* p)              { return __hip_atomic_load(p, __ATOMIC_RELAXED, __HIP_MEMORY_SCOPE_AGENT); }
__device__ __forceinline__ unsigned xb_add(unsigned* p, unsigned v) { return __hip_atomic_fetch_add(p, v, __ATOMIC_RELAXED, __HIP_MEMORY_SCOPE_AGENT); }
__device__ __forceinline__ unsigned xb_xcc_id() { return (unsigned)__builtin_amdgcn_s_getreg((3 << 11) | 20) & 0xFu; }
#define XB_SPIN(cond, bar) do { unsigned _sp = 0; while (cond) { __builtin_amdgcn_s_sleep(1); \
    if ((++_sp & 255u) == 0u) { if (xb_ld(&(bar)[XB_TMO])) break; if (_sp > XB_SPIN_CAP) { atomicAdd(&(bar)[XB_TMO], 1u); break; } } } } while (0)

struct XcdBarrier {
    unsigned* bar; unsigned x;
    volatile LAS unsigned* st;
};

__device__ __forceinline__ XcdBarrier xcd_barrier_post(unsigned* bar, volatile LAS unsigned* st) {
    XcdBarrier b; b.bar = bar; b.x = xb_xcc_id(); b.st = st;
    if (threadIdx.x == 0) (void)xb_add(&bar[XB_XCNT(b.x)], 1u);
    return b;
}
__device__ __forceinline__ void xcd_barrier_complete(unsigned* bar, unsigned x, unsigned& nloc, unsigned& nx) {
    const unsigned G = gridDim.x * gridDim.y * gridDim.z;
    unsigned sum, cnt, mine, sp = 0u;
    for (;;) {
        sum = 0u; cnt = 0u; mine = 0u;
#pragma unroll
        for (unsigned j = 0; j < 16; ++j) { const unsigned c = xb_ld(&bar[XB_XCNT(j)]); sum += c; cnt += (c > 0u) ? 1u : 0u; mine = (j == x) ? c : mine; }
        if (sum == G) break;
        __builtin_amdgcn_s_sleep(1);
        if ((++sp & 255u) == 0u) { if (xb_ld(&bar[XB_TMO])) break; if (sp > XB_SPIN_CAP) { atomicAdd(&bar[XB_TMO], 1u); break; } }
    }
    nloc = mine > 0u ? mine : 1u; nx = cnt > 0u ? cnt : 1u;
}

__device__ __forceinline__ void xcd_barrier(const XcdBarrier& b) {
    asm volatile("s_waitcnt vmcnt(0)" ::: "memory");
    __syncthreads();
    if (threadIdx.x == 0) {
        unsigned* bar = b.bar;
        __builtin_amdgcn_s_waitcnt(0);
        unsigned nloc = b.st[0], nx = b.st[1];
        if (nloc == 0u) { xcd_barrier_complete(bar, b.x, nloc, nx); b.st[0] = nloc; b.st[1] = nx; }
        const unsigned old = xb_add(&bar[XB_XSUB(b.x)], 1u);
        const unsigned gen = old / nloc;
        if (old + 1u == (gen + 1u) * nloc) {
            __builtin_amdgcn_fence(__ATOMIC_RELEASE, "agent");
            asm volatile("s_waitcnt vmcnt(0)" ::: "memory");
            const unsigned og = xb_add(&bar[XB_TOP], 1u);
            const unsigned tg = og / nx;
            if (og + 1u == (tg + 1u) * nx) xb_add(&bar[XB_TOPGEN], 1u);
            else XB_SPIN(xb_ld(&bar[XB_TOPGEN]) == tg, bar);
            __builtin_amdgcn_fence(__ATOMIC_ACQUIRE, "agent");
            xb_add(&bar[XB_XGEN(b.x)], 1u);
            asm volatile("s_waitcnt vmcnt(0)" ::: "memory");
        } else {
            XB_SPIN(xb_ld(&bar[XB_XGEN(b.x)]) == gen, bar);
            __builtin_amdgcn_fence(__ATOMIC_ACQUIRE, "agent");
            asm volatile("s_waitcnt vmcnt(0)" ::: "memory");
        }
    }
    __syncthreads();
}
typedef unsigned short bf16_t;
typedef float f32x4 __attribute__((ext_vector_type(4)));
typedef float f32x2 __attribute__((ext_vector_type(2)));
typedef unsigned u32x4 __attribute__((ext_vector_type(4)));
typedef unsigned u32x2 __attribute__((ext_vector_type(2)));
typedef __bf16 bf16v2 __attribute__((ext_vector_type(2)));
#define LDS_WAIT() asm volatile("s_waitcnt lgkmcnt(0)" ::: "memory")

struct Args {
    const float* x; const float* c; const int* positions; const float* norm1_g; const float* norm2_g; const float* w_ada; const float* b_ada;
    const float* w_in; const float* lam_q1; const float* lam_k1; const float* lam_q2; const float* lam_k2; const float* diff_subln_g; const float* dil_out_g;
    const float* w_out; const float* peer_wq; const float* peer_subkeys; const float* peer_u; const float* peer_v; const float* final_g;
    float* out; unsigned char* ws; int ph_lo, ph_hi;
};

__device__ __forceinline__ unsigned cvt_pk(float lo, float hi) { unsigned r; asm volatile("v_cvt_pk_bf16_f32 %0, %1, %2" : "=v"(r) : "v"(lo), "v"(hi)); return r; }
__device__ __forceinline__ float bf_lo(unsigned u) { return __uint_as_float(u << 16); }
__device__ __forceinline__ float bf_hi(unsigned u) { return __uint_as_float(u & 0xffff0000u); }
__device__ __forceinline__ float dot2bf(unsigned a, unsigned b, float c) { return __builtin_amdgcn_fdot2_f32_bf16(__builtin_bit_cast(bf16v2, a), __builtin_bit_cast(bf16v2, b), c, false); }
__device__ __forceinline__ float wave_sum(float v) {
#pragma unroll
    for (int o = 1; o < 64; o <<= 1) v += __shfl_xor(v, o);
    return v;
}
__device__ __forceinline__ float half_sum(float v) {
#pragma unroll
    for (int o = 1; o < 32; o <<= 1) v += __shfl_xor(v, o);
    return v;
}

__device__ __forceinline__ void p0_gemv_unit(const Args& A, float* mod, LAS float* red, int unit, int tid) {
    const int rl = tid >> 5, c4 = tid & 31;
    const float* wp = A.w_ada + (size_t)rl * NADA + unit * 128 + c4 * 4;
    f32x4 acc = {0.f, 0.f, 0.f, 0.f};
    for (int k0 = 0; k0 < DM; k0 += 128) {
#pragma unroll
        for (int i = 0; i < 8; ++i) {
            const int kk = k0 + 16 * i;
            const float cv = A.c[kk + rl];
            const float sv = cv / (1.0f + __expf(-cv));
            const f32x4 w = *(const f32x4*)(wp + (size_t)kk * NADA);
            acc += sv * w;
        }
    }
    *(LAS f32x4*)(red + rl * 128 + c4 * 4) = acc;
    __syncthreads();
    if (tid < 128) { float s = 0.f;
#pragma unroll
        for (int r = 0; r < 16; ++r) s += red[r * 128 + tid];
        mod[unit * 128 + tid] = s + A.b_ada[unit * 128 + tid]; }
    __syncthreads();
}
__device__ __forceinline__ void p0_transpose_item(const float* W, int K, int N, bf16_t* WT, LAS float* scr, int item, int lane) {
    const int nblk = N / 32, kb = item / nblk, nb = item % nblk, k0 = 64 * kb, n0 = 32 * nb;
#pragma unroll 8
    for (int i = 0; i < 32; ++i) { const int kk = 2 * i + (lane >> 5); scr[kk * 33 + (lane & 31)] = W[(size_t)(k0 + kk) * N + n0 + (lane & 31)]; }
    LDS_WAIT(); asm volatile("" ::: "memory");
    const int c = lane & 7;
#pragma unroll
    for (int j = 0; j < 4; ++j) { const int n = (lane >> 3) + 8 * j; const LAS float* s = scr + (8 * c) * 33 + n;
        u32x4 o; o.x = cvt_pk(s[0 * 33], s[1 * 33]); o.y = cvt_pk(s[2 * 33], s[3 * 33]); o.z = cvt_pk(s[4 * 33], s[5 * 33]); o.w = cvt_pk(s[6 * 33], s[7 * 33]);
        *(u32x4*)(WT + (size_t)(n0 + n) * K + k0 + 8 * c) = o; }
    LDS_WAIT(); asm volatile("" ::: "memory");
}
__device__ __forceinline__ void p0_fold_item(const Args& A, bf16_t* wsc, LAS float* lds, int item, int tid) {
    const int g = item >> 6, d0 = (item & 63) * 64;
    LAS float* SK = lds;
    LAS float* WQ = lds + 128 * 132;
    const float* skp = A.peer_subkeys + (size_t)g * 16384;
    for (int i = tid; i < 128 * 32; i += 512) { const int n = i >> 5, k4 = i & 31; *(LAS f32x4*)(SK + n * 132 + 4 * k4) = *(const f32x4*)(skp + n * 128 + 4 * k4); }
    for (int i = tid; i < 64 * 32; i += 512) { const int d = i >> 5, k4 = i & 31; *(LAS f32x4*)(WQ + d * 132 + 4 * k4) = *(const f32x4*)(A.peer_wq + (size_t)(d0 + d) * 2048 + g * 128 + 4 * k4); }
    __syncthreads();
    const int n = tid & 127, dg = tid >> 7;
    float acc[16];
#pragma unroll
    for (int j = 0; j < 16; ++j) acc[j] = 0.f;
    for (int k4 = 0; k4 < 32; ++k4) {
        const f32x4 a = *(const LAS f32x4*)(SK + n * 132 + 4 * k4);
#pragma unroll
        for (int j = 0; j < 16; ++j) { const f32x4 b = *(const LAS f32x4*)(WQ + (dg * 16 + j) * 132 + 4 * k4); acc[j] += a.x * b.x + a.y * b.y + a.z * b.z + a.w * b.w; }
    }
    u32x4 o0, o1;
    o0.x = cvt_pk(acc[0], acc[1]); o0.y = cvt_pk(acc[2], acc[3]); o0.z = cvt_pk(acc[4], acc[5]); o0.w = cvt_pk(acc[6], acc[7]);
    o1.x = cvt_pk(acc[8], acc[9]); o1.y = cvt_pk(acc[10], acc[11]); o1.z = cvt_pk(acc[12], acc[13]); o1.w = cvt_pk(acc[14], acc[15]);
    bf16_t* op = wsc + (size_t)(g * 128 + n) * DM + d0 + dg * 16;
    *(u32x4*)op = o0; *(u32x4*)(op + 8) = o1;
    __syncthreads();
}
__device__ __forceinline__ void p0_prologue(const Args& A, LAS unsigned char* lds, int G, int bid, int tid) {
    const int lane = tid & 63, wave = __builtin_amdgcn_readfirstlane(tid >> 6);
    unsigned char* ws = A.ws;
    float* mod = (float*)(ws + WS_MOD);
    for (int u = bid; u < NADA / 128; u += G) p0_gemv_unit(A, mod, (LAS float*)lds, u, tid);
    if (bid == G - 1 && wave == 0) {
        float a = 0.f, b = 0.f;
        for (int i = lane; i < 128; i += 64) { a += A.lam_q1[i] * A.lam_k1[i]; b += A.lam_q2[i] * A.lam_k2[i]; }
        a = wave_sum(a); b = wave_sum(b);
        if (lane == 0) *(float*)(ws + WS_LAM) = expf(a) - expf(b) + LAM_INIT;
    }
    {
        float* rope = (float*)(ws + WS_ROPE);
        for (int i = bid * 512 + tid; i < S * 16; i += G * 512) {
            const int s = i >> 4, f = i & 15;
            const float inv = powf(500000.0f, -(float)(2 * f) / 32.0f);
            const float ang = (float)A.positions[s] * inv;
            double rev = (double)ang * 0.15915494309189535; rev -= rint(rev);
            const float fr = (float)rev;
            rope[s * 32 + f] = __builtin_amdgcn_cosf(fr);
            rope[s * 32 + 16 + f] = __builtin_amdgcn_sinf(fr);
        }
    }
    {
        LAS float* scr = (LAS float*)(lds + wave * 16384);
        const int gw = bid * 8 + wave, NGW = G * 8;
        constexpr int I_IN = (DM / 64) * (NIN / 32), I_OUT = (DM / 64) * (DM / 32);
        bf16_t* win = (bf16_t*)(ws + WS_WIN); bf16_t* wout = (bf16_t*)(ws + WS_WOUT);
        for (int it = gw; it < I_IN + I_OUT; it += NGW) {
            if (it < I_IN) p0_transpose_item(A.w_in, DM, NIN, win, scr, it, lane);
            else p0_transpose_item(A.w_out, DM, DM, wout, scr, it - I_IN, lane);
        }
    }
    __syncthreads();
    for (int it = bid; it < 16 * 64; it += G) p0_fold_item(A, (bf16_t*)(ws + WS_WSC), (LAS float*)lds, it, tid);
    {
        const size_t n8 = (size_t)NEXP * DM / 8;
        u32x4* ub = (u32x4*)(ws + WS_UB); u32x4* vb = (u32x4*)(ws + WS_VB);
        for (size_t i = (size_t)bid * 512 + tid; i < n8; i += (size_t)G * 512) {
            const f32x4 a0 = ((const f32x4*)A.peer_u)[2 * i], a1 = ((const f32x4*)A.peer_u)[2 * i + 1];
            const f32x4 b0 = ((const f32x4*)A.peer_v)[2 * i], b1 = ((const f32x4*)A.peer_v)[2 * i + 1];
            u32x4 o; o.x = cvt_pk(a0.x, a0.y); o.y = cvt_pk(a0.z, a0.w); o.z = cvt_pk(a1.x, a1.y); o.w = cvt_pk(a1.z, a1.w); ub[i] = o;
            u32x4 p; p.x = cvt_pk(b0.x, b0.y); p.y = cvt_pk(b0.z, b0.w); p.z = cvt_pk(b1.x, b1.y); p.w = cvt_pk(b1.z, b1.w); vb[i] = p;
        }
    }
}

__device__ __forceinline__ void row_modulate(const float* xin, const float* g, const float* sh, const float* sc, bf16_t* out, int gw, int ngw, int lane) {
    for (int r = gw; r < S; r += ngw) {
        const f32x4* xr = (const f32x4*)(xin + (size_t)r * DM) + lane;
        f32x4 v[16]; float ss = 0.f;
#pragma unroll
        for (int j = 0; j < 16; ++j) { v[j] = xr[64 * j]; ss += (v[j].x * v[j].x + v[j].y * v[j].y) + (v[j].z * v[j].z + v[j].w * v[j].w); }
        ss = wave_sum(ss);
        const float rstd = 1.0f / sqrtf(ss * (1.0f / DM) + NORM_EPS);
        u32x2* o8 = (u32x2*)(out + (size_t)r * DM) + lane;
#pragma unroll
        for (int j = 0; j < 16; ++j) { const int c = 4 * lane + 256 * j;
            const f32x4 gv = *(const f32x4*)(g + c), sv = *(const f32x4*)(sc + c), hv = *(const f32x4*)(sh + c);
            const f32x4 y = v[j] * rstd * gv * (1.0f + sv) + hv;
            u32x2 w; w.x = cvt_pk(y.x, y.y); w.y = cvt_pk(y.z, y.w); o8[64 * j] = w; }
    }
}

struct EpiQKV {
    static constexpr bool PERM = true, AFTER_DRAIN = false;
    bf16_t* qkv; bf16_t* qkv2; const float* rope;
    __device__ __forceinline__ void operator()(const pg8::f32x4 (&acc)[2][2][4][2], const pg8::Unit& u, int wr, int wc, int fr, int fq) const {
        const int T = u.pn >> 3, hh0 = 2 * (u.pn & 7);
        const bool rot = (wc == 0) && (T != 2) && (T != 5);
        const int d0 = wc * 32 + 8 * fq;
        const float sgn = (fq < 2) ? -1.0f : 1.0f;
        bf16_t* base = qkv + (size_t)T * QKV_T + d0;
#pragma unroll
        for (int ai = 0; ai < 2; ++ai)
#pragma unroll
            for (int m = 0; m < 4; ++m) {
                const int row = u.pm * 256 + ai * 128 + wr * 64 + m * 16 + fr;
                f32x4 cs0 = {1.f, 1.f, 1.f, 1.f}, cs1 = cs0, sn0 = {0.f, 0.f, 0.f, 0.f}, sn1 = sn0;
                if (rot) { const float* rp = rope + (size_t)row * 32 + 8 * (fq & 1);
                    cs0 = *(const f32x4*)rp; cs1 = *(const f32x4*)(rp + 4); sn0 = *(const f32x4*)(rp + 16); sn1 = *(const f32x4*)(rp + 20); }
#pragma unroll
                for (int bj = 0; bj < 2; ++bj) {
                    f32x4 v0 = acc[ai][bj][m][0], v1 = acc[ai][bj][m][1];
                    if (rot) {
                        f32x4 o0, o1;
#pragma unroll
                        for (int j = 0; j < 4; ++j) { o0[j] = __shfl_xor(v0[j], 32); o1[j] = __shfl_xor(v1[j], 32); }
                        v0 = v0 * cs0 + sgn * o0 * sn0; v1 = v1 * cs1 + sgn * o1 * sn1;
                    }
                    u32x4 w; w.x = cvt_pk(v0[0], v0[1]); w.y = cvt_pk(v0[2], v0[3]); w.z = cvt_pk(v1[0], v1[1]); w.w = cvt_pk(v1[2], v1[3]);
                    *(u32x4*)(base + ((size_t)(hh0 + bj) * S + row) * 128) = w;
                    if (T >= 3) {
                        const int r4 = (row & 3) * (S / 4) + (row >> 2), r16 = (row & 15) * (S / 16) + (row >> 4);
                        *(u32x4*)(qkv2 + (size_t)(T - 3) * QKV_T + d0 + ((size_t)(hh0 + bj) * S + r4) * 128) = w;
                        *(u32x4*)(qkv2 + (size_t)(T) * QKV_T + d0 + ((size_t)(hh0 + bj) * S + r16) * 128) = w;
                    }
                }
            }
    }
};
struct EpiResid {
    static constexpr bool PERM = false, AFTER_DRAIN = false;
    const float* x; const float* gate; float* out;
    __device__ __forceinline__ void operator()(const pg8::f32x4 (&acc)[2][2][4][2], const pg8::Unit& u, int wr, int wc, int fr, int fq) const {
        const int row0 = u.pm * 256 + wr * 64 + fr, col0 = u.pn * 256 + wc * 32 + 4 * fq;
        f32x4 gv[2][2];
#pragma unroll
        for (int bj = 0; bj < 2; ++bj)
#pragma unroll
            for (int n = 0; n < 2; ++n) gv[bj][n] = *(const f32x4*)(gate + col0 + bj * 128 + n * 16);
#pragma unroll
        for (int ai = 0; ai < 2; ++ai)
#pragma unroll
            for (int m = 0; m < 4; ++m) { const size_t off = (size_t)(row0 + ai * 128 + m * 16) * DM + col0;
#pragma unroll
                for (int bj = 0; bj < 2; ++bj)
#pragma unroll
                    for (int n = 0; n < 2; ++n) { const f32x4 xv = *(const f32x4*)(x + off + bj * 128 + n * 16);
#ifdef DBG_NO_MIXER
                        *(f32x4*)(out + off + bj * 128 + n * 16) = xv;
#else
                        *(f32x4*)(out + off + bj * 128 + n * 16) = xv + gv[bj][n] * acc[ai][bj][m][n];
#endif
                    } }
    }
};

struct AttIt { int kind, L, pass; };
__device__ __forceinline__ at::BlockRef att_ref(const AttIt& it, unsigned char* ws) {
    const bf16_t* qkv = (const bf16_t*)(ws + WS_QKV);
    at::BlockRef r;
    if (it.kind == 0) {
        const int vp = it.L >> 4, x = it.L & 15, qb = it.pass ? 31 - x : x;
        const int h = vp >> 2, s = (vp >> 1) & 1, hf = vp & 1;
        const size_t hq = (size_t)(2 * h + s) * S * 128, hv = (size_t)(2 * h + hf) * S * 128;
        r.Q = qkv + 0 * QKV_T + hq + (size_t)qb * 256 * 128; r.K = qkv + 1 * QKV_T + hq; r.V = qkv + 2 * QKV_T + hv;
        r.O = (float*)(ws + WS_OD) + ((size_t)vp * S + (size_t)qb * 256) * 128; r.L = nullptr;
        r.P0 = qb * 256; r.W = S; r.skv = S;
    } else {
        const int g = it.L >> 9, rem = it.L & 511, h = rem >> 5, blk = rem & 31;
        const int dil = (g == 0) ? 1 : (g == 1 ? 4 : 16), bpr = 32 / dil, res = blk / bpr, qb = blk % bpr;
        const bf16_t* tb = (g == 0) ? qkv + 3 * QKV_T : (const bf16_t*)(ws + WS_QKV2) + (size_t)(g - 1) * 3 * QKV_T;
        const size_t hb = ((size_t)h * S + (size_t)res * (S / dil)) * 128;
        r.skv = S / dil; r.P0 = qb * 256; r.W = 129;
        r.Q = tb + 0 * QKV_T + hb + (size_t)qb * 256 * 128; r.K = tb + 1 * QKV_T + hb; r.V = tb + 2 * QKV_T + hb;
        r.O = (float*)(ws + WS_OS) + ((size_t)(g * 16 + h) * S + (size_t)res * (S / dil) + (size_t)qb * 256) * 128;
        r.L = (float*)(ws + WS_LSE) + (size_t)(g * 16 + h) * S + (size_t)res * (S / dil) + (size_t)qb * 256;
    }
    return r;
}
__device__ __forceinline__ AttIt att_next(const AttIt& it, int G, int bid) {
    AttIt n = it;
    if (it.kind == 0) {
        if (it.pass == 0) { n.pass = 1; return n; }
        n.pass = 0; n.L = it.L + G;
        if (n.L < 512) return n;
        n.kind = 1; n.L = bid; if (n.L >= 1536) n.kind = 2;
        return n;
    }
    n.L = it.L + G; if (n.L >= 1536) n.kind = 2;
    return n;
}
__device__ __forceinline__ void attn_phase(const Args& A, char* lds, int G, int bid) {
    AttIt it; it.kind = 0; it.L = bid; it.pass = 0;
    if (it.L >= 512) { it.kind = 1; it.L = bid; if (it.L >= 1536) return; }
    at::BlockRef cur = att_ref(it, A.ws);
    at::Seam Sm;
    at::causal_swa_prime(cur, lds, Sm);
    while (it.kind != 2) {
        const AttIt itn = att_next(it, G, bid);
        const at::BlockRef nxt = (itn.kind == 2) ? cur : att_ref(itn, A.ws);
        at::causal_swa_block<false>(cur, nxt, lds, Sm);
        cur = nxt; it = itn;
    }
}

__device__ __forceinline__ void combine_phase(const Args& A, int gw, int ngw, int lane) {
    unsigned char* ws = A.ws;
    const float lam = *(const float*)(ws + WS_LAM);
    const float* OD = (const float*)(ws + WS_OD); const float* OS = (const float*)(ws + WS_OS); const float* LSE = (const float*)(ws + WS_LSE);
    bf16_t* Y = (bf16_t*)(ws + WS_Y);
    const int hf = lane >> 5, d4 = 4 * (lane & 31);
    for (int t = gw; t < S; t += ngw) {
#pragma unroll 2
        for (int h = 0; h < 8; ++h) {
            const f32x4 a = *(const f32x4*)(OD + ((size_t)(h * 4 + 0 + hf) * S + t) * 128 + d4);
            const f32x4 b = *(const f32x4*)(OD + ((size_t)(h * 4 + 2 + hf) * S + t) * 128 + d4);
            const f32x4 v = a - lam * b;
            const float ss = wave_sum((v.x * v.x + v.y * v.y) + (v.z * v.z + v.w * v.w));
            const float rstd = (1.0f - LAM_INIT) / sqrtf(ss * (1.0f / 256.0f) + NORM_EPS);
            const f32x4 gv = *(const f32x4*)(A.diff_subln_g + 4 * lane);
            const f32x4 y = v * rstd * gv;
            u32x2 w; w.x = cvt_pk(y.x, y.y); w.y = cvt_pk(y.z, y.w);
            *(u32x2*)(Y + (size_t)t * DM + h * 256 + 4 * lane) = w;
        }
#pragma unroll 2
        for (int hp = 0; hp < 8; ++hp) {
            const int h = 2 * hp + hf;
            const int r1 = (t & 3) * (S / 4) + (t >> 2), r2 = (t & 15) * (S / 16) + (t >> 4);
            const float l0 = LSE[(size_t)(0 * 16 + h) * S + t], l1 = LSE[(size_t)(1 * 16 + h) * S + r1], l2 = LSE[(size_t)(2 * 16 + h) * S + r2];
            const float mx = fmaxf(l0, fmaxf(l1, l2));
            const float e0 = __expf(l0 - mx), e1 = __expf(l1 - mx), e2 = __expf(l2 - mx), inv = 1.0f / (e0 + e1 + e2);
            const f32x4 o0 = *(const f32x4*)(OS + ((size_t)(0 * 16 + h) * S + t) * 128 + d4);
            const f32x4 o1 = *(const f32x4*)(OS + ((size_t)(1 * 16 + h) * S + r1) * 128 + d4);
            const f32x4 o2 = *(const f32x4*)(OS + ((size_t)(2 * 16 + h) * S + r2) * 128 + d4);
            const f32x4 v = (e0 * inv) * o0 + (e1 * inv) * o1 + (e2 * inv) * o2;
            const float ss = half_sum((v.x * v.x + v.y * v.y) + (v.z * v.z + v.w * v.w));
            const float rstd = 1.0f / sqrtf(ss * (1.0f / 128.0f) + NORM_EPS);
            const f32x4 gv = *(const f32x4*)(A.dil_out_g + h * 128 + d4);
            const f32x4 y = v * rstd * gv;
            u32x2 w; w.x = cvt_pk(y.x, y.y); w.y = cvt_pk(y.z, y.w);
            *(u32x2*)(Y + (size_t)t * DM + 2048 + h * 128 + d4) = w;
        }
    }
}

__device__ __forceinline__ unsigned fkey(float f) { const unsigned b = __float_as_uint(f); return b ^ ((b >> 31) ? 0xFFFFFFFFu : 0x80000000u); }
__device__ __forceinline__ int mbcnt64(unsigned long long m) { return (int)__builtin_amdgcn_mbcnt_hi((unsigned)(m >> 32), __builtin_amdgcn_mbcnt_lo((unsigned)m, 0u)); }
template <int NR> __device__ __forceinline__ unsigned kth16_key(const unsigned (&key)[NR]) {
    unsigned T = 0u;
    for (int bit = 31; bit >= 0; --bit) {
        const unsigned cand = T | (1u << bit); int cnt = 0;
#pragma unroll
        for (int r = 0; r < NR; ++r) cnt += __builtin_popcountll(__ballot(key[r] >= cand));
        if (cnt >= 16) T = cand;
    }
    return T;
}
template <int NR> __device__ __forceinline__ void select16(const unsigned (&key)[NR], bool (&sel)[NR], int (&pos)[NR]) {
    const unsigned T = kth16_key<NR>(key);
    int cgt = 0;
#pragma unroll
    for (int r = 0; r < NR; ++r) cgt += __builtin_popcountll(__ballot(key[r] > T));
    const int need = 16 - cgt; int eqb = 0, selb = 0;
#pragma unroll
    for (int r = 0; r < NR; ++r) {
        const bool gt = key[r] > T, eq = key[r] == T;
        const unsigned long long beq = __ballot(eq);
        const bool s = gt || (eq && (eqb + mbcnt64(beq)) < need);
        const unsigned long long bs = __ballot(s);
        sel[r] = s; pos[r] = selb + mbcnt64(bs);
        selb += __builtin_popcountll(bs); eqb += __builtin_popcountll(beq);
    }
}
__device__ __forceinline__ void topk_phase(const Args& A, LAS unsigned char* lds, int gw, int ngw, int wave, int lane) {
    unsigned char* ws = A.ws;
    const float* SC = (const float*)(ws + WS_SC); int* IDX = (int*)(ws + WS_IDX); float* GATE = (float*)(ws + WS_GATE);
    LAS float* lv = (LAS float*)(lds + wave * 512);
    LAS int* li = (LAS int*)(lds + wave * 512 + 256);
    for (int task = gw; task < S * 8; task += ngw) {
        const int t = task >> 3, h = task & 7;
        const float* sp = SC + (size_t)t * 2048 + h * 256;
#pragma unroll
        for (int p = 0; p < 2; ++p) {
            float v[2]; unsigned key[2]; bool sel[2]; int pos[2];
            v[0] = sp[p * 128 + lane]; v[1] = sp[p * 128 + 64 + lane];
            key[0] = fkey(v[0]); key[1] = fkey(v[1]);
            select16<2>(key, sel, pos);
#pragma unroll
            for (int r = 0; r < 2; ++r) if (sel[r]) { lv[p * 16 + pos[r]] = v[r]; li[p * 16 + pos[r]] = lane + 64 * r; }
        }
        LDS_WAIT(); __builtin_amdgcn_wave_barrier();
        {
            float cv[4]; unsigned key[4]; bool sel[4]; int pos[4];
            const float vb = lv[16 + (lane & 15)];
#pragma unroll
            for (int k = 0; k < 4; ++k) { cv[k] = lv[(lane >> 4) + 4 * k] + vb; key[k] = fkey(cv[k]); }
            select16<4>(key, sel, pos);
            const int ib = li[16 + (lane & 15)];
#pragma unroll
            for (int k = 0; k < 4; ++k) if (sel[k]) { lv[32 + pos[k]] = cv[k]; li[32 + pos[k]] = li[(lane >> 4) + 4 * k] * 128 + ib; }
        }
        LDS_WAIT(); __builtin_amdgcn_wave_barrier();
        {
            const float fv = lv[32 + (lane & 15)]; const int fi = li[32 + (lane & 15)];
            float mx = fv;
#pragma unroll
            for (int o = 1; o < 16; o <<= 1) mx = fmaxf(mx, __shfl_xor(mx, o));
            const float e = __expf(fv - mx); float sm = e;
#pragma unroll
            for (int o = 1; o < 16; o <<= 1) sm += __shfl_xor(sm, o);
            if (lane < 16) { IDX[(size_t)t * 128 + h * 16 + lane] = fi; GATE[(size_t)t * 128 + h * 16 + lane] = e / sm; }
        }
        LDS_WAIT(); __builtin_amdgcn_wave_barrier();
    }
}

__device__ __forceinline__ float gelu_erf(float x) { return 0.5f * x * (1.0f + erff(x * 0.70710678118654752f)); }
__device__ __forceinline__ void peer_phase(const Args& A, int gw, int ngw, int lane) {
    unsigned char* ws = A.ws;
    const bf16_t* H2 = (const bf16_t*)(ws + WS_H2); const bf16_t* UB = (const bf16_t*)(ws + WS_UB); const bf16_t* VB = (const bf16_t*)(ws + WS_VB);
    const int* IDX = (const int*)(ws + WS_IDX); const float* GATE = (const float*)(ws + WS_GATE);
    const float* X1 = (const float*)(ws + WS_X1); const float* mod = (const float*)(ws + WS_MOD);
    const float* g2 = mod + 5 * DM;
    for (int t = gw; t < S; t += ngw) {
        const int tu = __builtin_amdgcn_readfirstlane(t);
        const int* ip = IDX + (size_t)tu * 128;
        u32x4 hq[8];
#pragma unroll
        for (int c = 0; c < 8; ++c) hq[c] = *(const u32x4*)(H2 + (size_t)tu * DM + c * 512 + lane * 8);
        float areg[2] = {0.f, 0.f};
#pragma unroll
        for (int k = 0; k < 2; ++k) {
            for (int jj = 0; jj < 64; jj += 2) {
                float p[2];
#pragma unroll
                for (int i = 0; i < 2; ++i) {
                    const int e = __builtin_amdgcn_readfirstlane(ip[64 * k + jj + i]);
                    const bf16_t* up = UB + (size_t)e * DM + lane * 8;
                    float s = 0.f;
#pragma unroll
                    for (int c = 0; c < 8; ++c) { const u32x4 uv = *(const u32x4*)(up + c * 512);
                        s = dot2bf(hq[c].x, uv.x, s); s = dot2bf(hq[c].y, uv.y, s); s = dot2bf(hq[c].z, uv.z, s); s = dot2bf(hq[c].w, uv.w, s); }
                    p[i] = s;
                }
#pragma unroll
                for (int i = 0; i < 2; ++i) { const float tot = wave_sum(p[i]); if (lane == jj + i) areg[k] = tot; }
            }
        }
#pragma unroll
        for (int k = 0; k < 2; ++k) areg[k] = GATE[(size_t)tu * 128 + 64 * k + lane] * gelu_erf(areg[k]);
        float acc[64];
#pragma unroll
        for (int i = 0; i < 64; ++i) acc[i] = 0.f;
#pragma unroll
        for (int k = 0; k < 2; ++k) {
            for (int jj = 0; jj < 64; ++jj) {
                const int e = __builtin_amdgcn_readfirstlane(ip[64 * k + jj]);
                const float a = __shfl(areg[k], jj);
                const bf16_t* vp = VB + (size_t)e * DM + lane * 8;
#pragma unroll
                for (int c = 0; c < 8; ++c) { const u32x4 vv = *(const u32x4*)(vp + c * 512);
                    acc[c * 8 + 0] += a * bf_lo(vv.x); acc[c * 8 + 1] += a * bf_hi(vv.x); acc[c * 8 + 2] += a * bf_lo(vv.y); acc[c * 8 + 3] += a * bf_hi(vv.y);
                    acc[c * 8 + 4] += a * bf_lo(vv.z); acc[c * 8 + 5] += a * bf_hi(vv.z); acc[c * 8 + 6] += a * bf_lo(vv.w); acc[c * 8 + 7] += a * bf_hi(vv.w); }
            }
        }
#ifdef DBG_NO_PEER
#pragma unroll
        for (int i = 0; i < 64; ++i) acc[i] = 0.f;
#endif
        float ss = 0.f;
#pragma unroll
        for (int c = 0; c < 8; ++c) {
            const int col = c * 512 + lane * 8;
            const f32x4 x0 = *(const f32x4*)(X1 + (size_t)tu * DM + col), x1v = *(const f32x4*)(X1 + (size_t)tu * DM + col + 4);
            const f32x4 ga = *(const f32x4*)(g2 + col), gb = *(const f32x4*)(g2 + col + 4);
#pragma unroll
            for (int q = 0; q < 4; ++q) { acc[c * 8 + q] = x0[q] + ga[q] * acc[c * 8 + q]; acc[c * 8 + 4 + q] = x1v[q] + gb[q] * acc[c * 8 + 4 + q]; }
#pragma unroll
            for (int q = 0; q < 8; ++q) ss += acc[c * 8 + q] * acc[c * 8 + q];
        }
        ss = wave_sum(ss);
        const float rstd = 1.0f / sqrtf(ss * (1.0f / DM) + NORM_EPS);
#pragma unroll
        for (int c = 0; c < 8; ++c) {
            const int col = c * 512 + lane * 8;
            const f32x4 fa = *(const f32x4*)(A.final_g + col), fb = *(const f32x4*)(A.final_g + col + 4);
            f32x4 o0, o1;
#pragma unroll
            for (int q = 0; q < 4; ++q) { o0[q] = acc[c * 8 + q] * rstd * fa[q]; o1[q] = acc[c * 8 + 4 + q] * rstd * fb[q]; }
            *(f32x4*)(A.out + (size_t)tu * DM + col) = o0; *(f32x4*)(A.out + (size_t)tu * DM + col + 4) = o1;
        }
    }
}


#ifdef DBG_CHECK
__device__ __forceinline__ void dbg_flag(unsigned char* ws, int bit) { atomicOr((unsigned*)(ws + WS_CTL + 65536), 1u << bit); }
__device__ __forceinline__ void dbg_phase(const Args& A, LAS unsigned char* lds, int bid, int tid) {
    unsigned char* ws = A.ws;
    const int lane = tid & 63, wave = __builtin_amdgcn_readfirstlane(tid >> 6);
    const bf16_t* H2 = (const bf16_t*)(ws + WS_H2); const float* SC = (const float*)(ws + WS_SC);
    const int* IDX = (const int*)(ws + WS_IDX); const float* GATE = (const float*)(ws + WS_GATE);
    const float* X1 = (const float*)(ws + WS_X1); const float* mod = (const float*)(ws + WS_MOD);
    if (wave != 0) return;
    if (bid < 4) {
        const int t = bid == 0 ? 5 : (bid == 1 ? 1234 : (bid == 2 ? 4097 : 8191)), g = (3 * bid + 5) & 15;
        LAS float* q = (LAS float*)lds;
        float q0 = 0.f, q1 = 0.f;
        for (int d = 0; d < DM; ++d) { const float hv = __uint_as_float(((unsigned)H2[(size_t)t * DM + d]) << 16);
            q0 += hv * A.peer_wq[(size_t)d * 2048 + g * 128 + lane]; q1 += hv * A.peer_wq[(size_t)d * 2048 + g * 128 + 64 + lane]; }
        q[lane] = q0; q[lane + 64] = q1; LDS_WAIT(); __builtin_amdgcn_wave_barrier();
        bool bad = false;
        for (int r = 0; r < 2; ++r) { const int n = lane + 64 * r; float s = 0.f;
            for (int k = 0; k < 128; ++k) s += q[k] * A.peer_subkeys[(size_t)g * 16384 + n * 128 + k];
            const float got = SC[(size_t)t * 2048 + g * 128 + n];
            if (!(fabsf(got - s) <= 0.03f * fabsf(s) + 0.03f)) bad = true; }
        if (__any(bad) && lane == 0) dbg_flag(ws, 0);
    } else if (bid < 8) {
        const int b = bid - 4, t = b == 0 ? 5 : (b == 1 ? 1234 : (b == 2 ? 4097 : 8191)), h = (2 * b + 1) & 7;
        LAS float* sv = (LAS float*)lds;
        LAS int* si = (LAS int*)(lds + 2048);
        LAS float* fv = (LAS float*)(lds + 4096);
        for (int i = lane; i < 256; i += 64) sv[i] = SC[(size_t)t * 2048 + h * 256 + i];
        LDS_WAIT(); __builtin_amdgcn_wave_barrier();
        if (lane == 0) {
            for (int p = 0; p < 2; ++p) for (int k = 0; k < 16; ++k) { float best = -3e38f; int bi = 0;
                for (int n = 0; n < 128; ++n) { const float x = sv[p * 128 + n]; if (x > best) { best = x; bi = n; } }
                sv[256 + p * 16 + k] = best; si[p * 16 + k] = bi; sv[p * 128 + bi] = -3e38f; }
            for (int a = 0; a < 16; ++a) for (int c = 0; c < 16; ++c) fv[16 + a * 16 + c] = sv[256 + a] + sv[272 + c];
            float mx = -3e38f;
            for (int k = 0; k < 16; ++k) { float best = -3e38f; int bi = 0;
                for (int c = 0; c < 256; ++c) { const float x = fv[16 + c]; if (x > best) { best = x; bi = c; } }
                fv[k] = best; si[32 + k] = si[bi >> 4] * 128 + si[16 + (bi & 15)]; fv[16 + bi] = -3e38f; if (best > mx) mx = best; }
            float sm = 0.f; for (int k = 0; k < 16; ++k) sm += __expf(fv[k] - mx);
            bool bad = false;
            for (int k = 0; k < 16; ++k) { const float gk = __expf(fv[k] - mx) / sm; bool found = false;
                for (int j = 0; j < 16; ++j) if (IDX[(size_t)t * 128 + h * 16 + j] == si[32 + k]) { found = true; if (fabsf(GATE[(size_t)t * 128 + h * 16 + j] - gk) > 2e-3f) bad = true; }
                if (!found && gk > 0.02f) bad = true; }
            if (bad) dbg_flag(ws, 1);
        }
    } else if (bid < 12) {
        const int b = bid - 8, t = b == 0 ? 5 : (b == 1 ? 1234 : (b == 2 ? 4097 : 8191));
        LAS float* av = (LAS float*)lds;
        for (int j = 0; j < 128; ++j) { const int e = IDX[(size_t)t * 128 + j]; float s = 0.f;
            for (int d = lane; d < DM; d += 64) s += __uint_as_float(((unsigned)H2[(size_t)t * DM + d]) << 16) * A.peer_u[(size_t)e * DM + d];
            s = wave_sum(s); if (lane == 0) av[j] = GATE[(size_t)t * 128 + j] * gelu_erf(s); }
        LDS_WAIT(); __builtin_amdgcn_wave_barrier();
        float ss = 0.f;
        for (int d = lane; d < DM; d += 64) { float o = 0.f;
            for (int j = 0; j < 128; ++j) o += av[j] * A.peer_v[(size_t)IDX[(size_t)t * 128 + j] * DM + d];
            const float x2 = X1[(size_t)t * DM + d] + mod[5 * DM + d] * o; ss += x2 * x2; }
        ss = wave_sum(ss); const float rstd = 1.0f / sqrtf(ss / DM + NORM_EPS);
        bool bad = false;
        for (int d = lane; d < DM; d += 64) { float o = 0.f;
            for (int j = 0; j < 128; ++j) o += av[j] * A.peer_v[(size_t)IDX[(size_t)t * 128 + j] * DM + d];
            const float ref = (X1[(size_t)t * DM + d] + mod[5 * DM + d] * o) * rstd * A.final_g[d];
            if (!(fabsf(A.out[(size_t)t * DM + d] - ref) <= 0.02f * fabsf(ref) + 0.02f)) bad = true; }
        if (__any(bad) && lane == 0) dbg_flag(ws, 2);
    } else if (bid < 16) {
        const int b = bid - 12, t = b == 0 ? 5 : (b == 1 ? 1234 : (b == 2 ? 4097 : 8191));
        float ss = 0.f; for (int d = lane; d < DM; d += 64) { const float x = X1[(size_t)t * DM + d]; ss += x * x; }
        ss = wave_sum(ss); const float rstd = 1.0f / sqrtf(ss / DM + NORM_EPS); bool bad = false;
        for (int d = lane; d < DM; d += 64) { const float ref = X1[(size_t)t * DM + d] * rstd * A.norm2_g[d] * (1.0f + mod[4 * DM + d]) + mod[3 * DM + d];
            const float got = __uint_as_float(((unsigned)H2[(size_t)t * DM + d]) << 16);
            if (!(fabsf(got - ref) <= 0.01f * fabsf(ref) + 0.01f)) bad = true; }
        if (__any(bad) && lane == 0) dbg_flag(ws, 3);
    } else if (bid < 20) {
        const int b = bid - 16; bool bad = false;
        for (int r = 0; r < 6; ++r) { const int n = r * DM + 37 * lane + 500 * b; float s = 0.f;
            for (int k = 0; k < DM; ++k) { const float cv = A.c[k]; s += cv / (1.0f + __expf(-cv)) * A.w_ada[(size_t)k * NADA + n]; }
            s += A.b_ada[n]; if (!(fabsf(mod[n] - s) <= 1e-3f * fabsf(s) + 1e-3f)) bad = true; }
        if (__any(bad) && lane == 0) dbg_flag(ws, 4);
    } else if (bid < 24) {
        const int b = bid - 20, g = (5 * b + 2) & 15, n = 17 * b + 3; bool bad = false;
        const bf16_t* wsc = (const bf16_t*)(ws + WS_WSC);
        for (int d = lane; d < DM; d += 64) { float s = 0.f;
            for (int k = 0; k < 128; ++k) s += A.peer_subkeys[(size_t)g * 16384 + n * 128 + k] * A.peer_wq[(size_t)d * 2048 + g * 128 + k];
            const float got = __uint_as_float(((unsigned)wsc[(size_t)(g * 128 + n) * DM + d]) << 16);
            if (!(fabsf(got - s) <= 0.01f * fabsf(s) + 2e-4f)) bad = true; }
        if (__any(bad) && lane == 0) dbg_flag(ws, 5);
    }
}
__device__ __forceinline__ void dbg_emit(const Args& A, int bid, int tid, int G) {
    const unsigned mask = *(const unsigned*)(A.ws + WS_CTL + 65536);
    const float cval = sqrtf((float)mask + 1.0f);
    for (size_t i = (size_t)bid * 512 + tid; i < (size_t)S * DM; i += (size_t)G * 512) A.out[i] = cval;
}
#endif
__global__ void __launch_bounds__(512, 2) hymba_fwd(Args A) {
    extern __shared__ __attribute__((aligned(16))) unsigned char lds_raw[];
    LAS unsigned char* lds = (LAS unsigned char*)lds_raw;
    const int tid = threadIdx.x, lane = tid & 63, wave = __builtin_amdgcn_readfirstlane(tid >> 6);
    const int G = gridDim.x, bid = blockIdx.x;
    const int gw = bid * 8 + wave, ngw = G * 8;
    unsigned char* ws = A.ws;
    for (int u = tid; u < (LDS_BYTES - RING_BYTES) / 4; u += 512) ((LAS unsigned*)(lds + RING_BYTES))[u] = 0u;
    __syncthreads();
    XcdBarrier bar; bar.bar = (unsigned*)(ws + WS_CTL) + CW_BAR; bar.x = 0; bar.st = nullptr;
    if (MK_N_LAUNCHES == 1) bar = xcd_barrier_post((unsigned*)(ws + WS_CTL) + CW_BAR, (volatile LAS unsigned*)(lds + MISC_OFF + 32));
    const int lo = A.ph_lo, hi = A.ph_hi;
#ifndef PH_MASK
#define PH_MASK 0xfff
#endif
#define IN(k) (((PH_MASK >> (k)) & 1) && lo <= (k) && (k) < hi)
#define SEAM(k) do { if (IN(k) && IN((k) + 1)) xcd_barrier(bar); } while (0)
    float* mod = (float*)(ws + WS_MOD);

    if (IN(0)) { p0_prologue(A, lds, G, bid, tid); }
    SEAM(0);
    if (IN(1)) { row_modulate(A.x, A.norm1_g, mod + 0 * DM, mod + 1 * DM, (bf16_t*)(ws + WS_H1), gw, ngw, lane); }
    SEAM(1);
    if (IN(2)) {
        pg8::Gemm g{(const bf16_t*)(ws + WS_H1), (const bf16_t*)(ws + WS_WIN), S, NIN, DM}; pg8::StaticOrder So; So.init(S, NIN, G, bid);
        EpiQKV E{(bf16_t*)(ws + WS_QKV), (bf16_t*)(ws + WS_QKV2), (const float*)(ws + WS_ROPE)};
        pg8::gemm_phase<EpiQKV, pg8::StaticOrder, false>(lds, g, So, E, nullptr);
    }
    SEAM(2);
    if (IN(3)) { attn_phase(A, (char*)lds_raw, G, bid); }
    SEAM(3);
    if (IN(4)) { combine_phase(A, gw, ngw, lane); }
    SEAM(4);
    if (IN(5)) {
        pg8::Gemm g{(const bf16_t*)(ws + WS_Y), (const bf16_t*)(ws + WS_WOUT), S, DM, DM}; pg8::StaticOrder So; So.init(S, DM, G, bid);
        EpiResid E{A.x, mod + 2 * DM, (float*)(ws + WS_X1)};
        pg8::gemm_phase<EpiResid, pg8::StaticOrder, false>(lds, g, So, E, nullptr);
    }
    SEAM(5);
    if (IN(6)) { row_modulate((const float*)(ws + WS_X1), A.norm2_g, mod + 3 * DM, mod + 4 * DM, (bf16_t*)(ws + WS_H2), gw, ngw, lane); }
    SEAM(6);
    if (IN(7)) {
        pg8::Gemm g{(const bf16_t*)(ws + WS_H2), (const bf16_t*)(ws + WS_WSC), S, 2048, DM}; pg8::StaticOrder So; So.init(S, 2048, G, bid);
        pg8::EpiF32 E{(float*)(ws + WS_SC), 2048, nullptr};
        pg8::gemm_phase<pg8::EpiF32, pg8::StaticOrder, false>(lds, g, So, E, nullptr);
    }
    SEAM(7);
    if (IN(8)) { topk_phase(A, lds, gw, ngw, wave, lane); }
    SEAM(8);
    if (IN(9)) { peer_phase(A, gw, ngw, lane); }
#undef IN
#undef SEAM
}

#ifdef DBG_CHECK
__global__ void __launch_bounds__(512) dbg_kernel(Args A, int which) {
    __shared__ __attribute__((aligned(16))) unsigned char dl[8192];
    if (which == 0) dbg_phase(A, (LAS unsigned char*)dl, blockIdx.x, threadIdx.x);
    else dbg_emit(A, blockIdx.x, threadIdx.x, gridDim.x);
}
#endif
extern "C" void kernel_launch(void* const* d_in, const int* in_sizes, int n_in, void* d_out, int out_size, void* d_ws, size_t ws_size, hipStream_t stream) {
    static int grid = 0;
    if (grid == 0) {
        if (n_in != 20 || out_size != S * DM || ws_size < WS_END) { fprintf(stderr, "kernel_launch: unexpected shapes (n_in %d out %d ws %zu)\n", n_in, out_size, ws_size); grid = -1; return; }
        int dev = 0, cus = 0, per_cu = 0;
        if (hipGetDevice(&dev) != hipSuccess || hipDeviceGetAttribute(&cus, hipDeviceAttributeMultiprocessorCount, dev) != hipSuccess) { grid = -1; return; }
        if (hipFuncSetAttribute((const void*)hymba_fwd, hipFuncAttributeMaxDynamicSharedMemorySize, LDS_BYTES) != hipSuccess) { fprintf(stderr, "kernel_launch: hipFuncSetAttribute failed\n"); grid = -1; return; }
        if (hipOccupancyMaxActiveBlocksPerMultiprocessor(&per_cu, (const void*)hymba_fwd, 512, LDS_BYTES) != hipSuccess || per_cu < 1) fprintf(stderr, "kernel_launch: occupancy query reports %d\n", per_cu);
        (void)hipGetLastError();
        grid = cus;
    }
    if (grid < 0) return;
    (void)hipMemsetAsync((char*)d_ws + WS_CTL, 0, CTL_ZERO_BYTES, stream);
    Args a{};
    a.x = (const float*)d_in[0]; a.c = (const float*)d_in[1]; a.positions = (const int*)d_in[2]; a.norm1_g = (const float*)d_in[3]; a.norm2_g = (const float*)d_in[4];
    a.w_ada = (const float*)d_in[5]; a.b_ada = (const float*)d_in[6]; a.w_in = (const float*)d_in[7]; a.lam_q1 = (const float*)d_in[8]; a.lam_k1 = (const float*)d_in[9];
    a.lam_q2 = (const float*)d_in[10]; a.lam_k2 = (const float*)d_in[11]; a.diff_subln_g = (const float*)d_in[12]; a.dil_out_g = (const float*)d_in[13];
    a.w_out = (const float*)d_in[14]; a.peer_wq = (const float*)d_in[15]; a.peer_subkeys = (const float*)d_in[16]; a.peer_u = (const float*)d_in[17]; a.peer_v = (const float*)d_in[18];
    a.final_g = (const float*)d_in[19];
    a.out = (float*)d_out; a.ws = (unsigned char*)d_ws;
    if (MK_N_LAUNCHES == 1) { a.ph_lo = 0; a.ph_hi = NPHASE; hipLaunchKernelGGL(hymba_fwd, dim3(grid), dim3(512), LDS_BYTES, stream, a); }
    else { for (int p = 0; p < NPHASE; ++p) { a.ph_lo = p; a.ph_hi = p + 1; hipLaunchKernelGGL(hymba_fwd, dim3(grid), dim3(512), LDS_BYTES, stream, a); } }
#ifdef DBG_CHECK
    hipLaunchKernelGGL(dbg_kernel, dim3(grid), dim3(512), 0, stream, a, 0);
    hipLaunchKernelGGL(dbg_kernel, dim3(grid), dim3(512), 0, stream, a, 1);
#endif
}
```

```cpp
#include <hip/hip_runtime.h>
#include <cstdint>
#include <cstdio>

#define REP_MASK 0x000
#define PROBE_FLAG_VAL 0
#ifndef MK_N_LAUNCHES
#define MK_N_LAUNCHES 1
#endif
constexpr int NPHASE = 10;

constexpr int S = 8192, DM = 4096, NIN = 12288, NADA = 24576, NEXP = 16384;
constexpr float NORM_EPS = 1e-6f;
constexpr float LAM_INIT = 0.2f;

constexpr size_t MiB = 1u << 20;
constexpr size_t WS_CTL = 0, CTL_ZERO_BYTES = 1 * MiB;
constexpr size_t WS_MOD = 1 * MiB;
constexpr size_t WS_LAM = 1 * MiB + 128 * 1024;
constexpr size_t WS_ROPE = 2 * MiB;
constexpr size_t WS_WIN = 4 * MiB;
constexpr size_t WS_WOUT = 100 * MiB;
constexpr size_t WS_WSC = 132 * MiB;
constexpr size_t WS_UB = 148 * MiB;
constexpr size_t WS_VB = 276 * MiB;
constexpr size_t WS_H1 = 404 * MiB;
constexpr size_t WS_Y = 468 * MiB;
constexpr size_t WS_H2 = 532 * MiB;
constexpr size_t WS_QKV = 596 * MiB;
constexpr size_t QKV_T = (size_t)16 * S * 128;
constexpr size_t WS_OD = 788 * MiB;
constexpr size_t WS_OS = 916 * MiB;
constexpr size_t WS_H1F8 = 1012 * MiB;
constexpr size_t WIN8_OFF = 64 * MiB;
constexpr size_t WS_LSE = 1108 * MiB;
constexpr size_t WS_X1 = 1110 * MiB;
constexpr size_t WS_SC = 1238 * MiB;
constexpr size_t WS_IDX = 1302 * MiB;
constexpr size_t WS_GATE = 1306 * MiB;
constexpr size_t WS_QKV2 = 1310 * MiB;
constexpr size_t WS_END = 1502 * MiB;
constexpr int CW_BAR = 4096;

constexpr int RING_BYTES = 131072;
constexpr int MISC_OFF = RING_BYTES + 320;
constexpr int LDS_BYTES = 147456;

namespace pg8 {
#define PG8_LAS __attribute__((address_space(3)))
typedef unsigned short bf16_t;
typedef short bf16x8 __attribute__((ext_vector_type(8)));
typedef float f32x4 __attribute__((ext_vector_type(4)));
typedef unsigned u32x4 __attribute__((ext_vector_type(4)));
constexpr int BM = 256, BK = 64, HALF = 128, HTB = HALF * BK * 2  , STAGE_BYTES = 8 * HTB, NXCD = 8, WGM = 8;

__host__ __device__ __forceinline__ int lds_byte(int r, int c) { const int st = (r >> 4) * 2 + (c >> 5), rr = r & 15, cc = c & 31, ob = rr * 64 + cc * 2; return st * 1024 + (ob ^ (((ob >> 9) & 1) << 5)); }
__host__ __device__ __forceinline__ void stage_rc(int b, int& R, int& C) { const int st = b / 1024, sb = b % 1024, swz = sb ^ (((sb >> 9) & 1) << 5); R = (st >> 1) * 16 + swz / 64; C = (st & 1) * 32 + (swz % 64) / 2; }
__host__ __device__ __forceinline__ int perm32(int rho) { const int n = rho >> 4, i = rho & 15; return 8 * (i >> 2) + 4 * n + (i & 3); }

struct Unit { int pm, pn; };
struct Gemm { const bf16_t* A; const bf16_t* Bt; int M, N, K; };

struct StaticOrder {
    int nM, nN, nwg, G, c;
    __host__ __device__ void init(int M, int N, int G_, int c_) { nM = M / BM; nN = N / BM; nwg = nM * nN; G = G_; c = c_; }
    __host__ __device__ bool next(int i, Unit& u) const {
        const long L = (long)i * G + c; if (L >= nwg) return false;
        int wgid = (int)L; { const int q = nwg / NXCD, r = nwg % NXCD, xcd = wgid % NXCD, off = wgid / NXCD; wgid = (xcd < r ? xcd * (q + 1) : r * (q + 1) + (xcd - r) * q) + off; }
        const int nig = WGM * nN, gid = wgid / nig, fm = gid * WGM, gsz = (nM - fm) < WGM ? (nM - fm) : WGM;
        u.pm = fm + ((wgid % nig) % gsz); u.pn = (wgid % nig) / gsz; return true;
    }
    __device__ __forceinline__ void a_ready(const Unit&) const {}
    __device__ __forceinline__ void done(const Unit&) const {}
};
struct CountedOrder : StaticOrder {
    const unsigned* ready; unsigned need; unsigned* tmo;
    __device__ __forceinline__ void a_ready(const Unit& u) const {
        if (threadIdx.x < 64) {
            const unsigned long long t0 = __builtin_amdgcn_s_memrealtime(); unsigned polls = 0;
            while ((unsigned)__builtin_amdgcn_readfirstlane(__hip_atomic_load(ready + 64 * u.pm, __ATOMIC_RELAXED, __HIP_MEMORY_SCOPE_AGENT)) < need) {
                if ((++polls & 255u) == 0u && __builtin_amdgcn_readfirstlane(__hip_atomic_load(tmo, __ATOMIC_RELAXED, __HIP_MEMORY_SCOPE_AGENT)) != 0u) break;
                if (__builtin_amdgcn_s_memrealtime() - t0 > 2000000ull) {
                    if (threadIdx.x == 0) { unsigned expect = 0u; __hip_atomic_compare_exchange_strong(tmo + 1, &expect, 0x600u | (unsigned)(u.pm & 0xff), __ATOMIC_RELAXED, __ATOMIC_RELAXED, __HIP_MEMORY_SCOPE_AGENT); __hip_atomic_store(tmo, 1u, __ATOMIC_RELAXED, __HIP_MEMORY_SCOPE_AGENT); }
                    break; }
                __builtin_amdgcn_s_sleep(2); }
            __builtin_amdgcn_fence(__ATOMIC_ACQUIRE, "agent");
            asm volatile("s_waitcnt vmcnt(0)" ::: "memory");
        }
#if !defined(BROKEN_HOOK_NO_BARRIER)
        asm volatile("" ::: "memory"); __builtin_amdgcn_s_barrier(); asm volatile("" ::: "memory");
#endif
    }
};

__device__ __forceinline__ unsigned cvt_pk_bf16(float lo, float hi) { unsigned r; asm volatile("v_cvt_pk_bf16_f32 %0, %1, %2" : "=v"(r) : "v"(lo), "v"(hi)); return r; }
typedef float f32x2 __attribute__((ext_vector_type(2)));
__device__ __forceinline__ f32x2 gelu_pk(f32x2 v) {
    const f32x2 av = __builtin_elementwise_abs(v), d = av * 0.2316418882f + 1.0f;
    f32x2 t; t.x = __builtin_amdgcn_rcpf(d.x); t.y = __builtin_amdgcn_rcpf(d.y);
    f32x2 q = t * 0.5307027145f + (-0.7265760135f); q = q * t + 0.7107068705f; q = q * t + (-0.142248368f); q = q * t + 0.127414796f; q = q * t;
    const f32x2 s = (v * v) * (-0.72134752044f);
    f32x2 e; e.x = __builtin_amdgcn_exp2f(s.x); e.y = __builtin_amdgcn_exp2f(s.y);
    const f32x2 m = v * (q * e), r = v - m;
    f32x2 o; o.x = v.x < 0.f ? m.x : r.x; o.y = v.y < 0.f ? m.y : r.y; return o;
}

struct EpiF32 {
    static constexpr bool PERM = false, AFTER_DRAIN = false;
    float* C; int ldc; const float* bias;
    __device__ __forceinline__ void operator()(const f32x4 (&acc)[2][2][4][2], const Unit& u, int wr, int wc, int fr, int fq) const {
        const int row0 = u.pm * BM + wr * 64 + fr, col0 = u.pn * BM + wc * 32 + 4 * fq;
        f32x4 bv[2][2];
#pragma unroll
        for (int bj = 0; bj < 2; ++bj)
#pragma unroll
            for (int n = 0; n < 2; ++n) bv[bj][n] = bias ? *(const f32x4*)(bias + col0 + bj * HALF + n * 16) : (f32x4){0.f, 0.f, 0.f, 0.f};
#pragma unroll
        for (int ai = 0; ai < 2; ++ai)
#pragma unroll
            for (int m = 0; m < 4; ++m) { float* rowp = C + (size_t)(row0 + ai * HALF + m * 16) * ldc + col0;
#pragma unroll
                for (int bj = 0; bj < 2; ++bj)
#pragma unroll
                    for (int n = 0; n < 2; ++n) *(f32x4*)(rowp + bj * HALF + n * 16) = acc[ai][bj][m][n] + bv[bj][n]; }
    }
};
template <int ACT  > struct EpiBf16 {
    static constexpr bool PERM = true, AFTER_DRAIN = false;
    bf16_t* O; int ldc; const float* bias; int split_cols; size_t split_stride;
    __device__ __forceinline__ void operator()(const f32x4 (&acc)[2][2][4][2], const Unit& u, int wr, int wc, int fr, int fq) const {
        const int row0 = u.pm * BM + wr * 64 + fr; int colt = u.pn * BM; bf16_t* base = O;
        if (split_cols) { const int t = colt / split_cols; base += (size_t)t * split_stride; colt -= t * split_cols; }
        const int col0 = colt + wc * 32 + 8 * fq, bcol0 = u.pn * BM + wc * 32 + 8 * fq;
        f32x4 bv[2][2];
#pragma unroll
        for (int bj = 0; bj < 2; ++bj)
#pragma unroll
            for (int n = 0; n < 2; ++n) bv[bj][n] = bias ? *(const f32x4*)(bias + bcol0 + bj * HALF + 4 * n) : (f32x4){0.f, 0.f, 0.f, 0.f};
#pragma unroll
        for (int ai = 0; ai < 2; ++ai)
#pragma unroll
            for (int m = 0; m < 4; ++m) { bf16_t* rowp = base + (size_t)(row0 + ai * HALF + m * 16) * ldc + col0;
#pragma unroll
                for (int bj = 0; bj < 2; ++bj) { f32x4 v0 = acc[ai][bj][m][0] + bv[bj][0], v1 = acc[ai][bj][m][1] + bv[bj][1];
                    if (ACT == 1) { f32x2 a = gelu_pk((f32x2){v0[0], v0[1]}), b = gelu_pk((f32x2){v0[2], v0[3]}), c = gelu_pk((f32x2){v1[0], v1[1]}), d = gelu_pk((f32x2){v1[2], v1[3]});
                        v0 = (f32x4){a.x, a.y, b.x, b.y}; v1 = (f32x4){c.x, c.y, d.x, d.y}; }
                    if (ACT == 2) {
#pragma unroll
                        for (int j = 0; j < 4; ++j) { v0[j] = 0.5f * v0[j] * (1.0f + erff(v0[j] * 0.70710678f)); v1[j] = 0.5f * v1[j] * (1.0f + erff(v1[j] * 0.70710678f)); } }
                    u32x4 w; w.x = cvt_pk_bf16(v0[0], v0[1]); w.y = cvt_pk_bf16(v0[2], v0[3]); w.z = cvt_pk_bf16(v1[0], v1[1]); w.w = cvt_pk_bf16(v1[2], v1[3]);
                    *(u32x4*)(rowp + bj * HALF) = w; } }
    }
};
template <class Epi, class Sched, bool STAMP = false, bool F8 = false>
__device__ __forceinline__ void gemm_phase(PG8_LAS unsigned char* lds, const Gemm g, const Sched& S, const Epi& E, unsigned long long* stamps) {
    const int tid = threadIdx.x, wid = __builtin_amdgcn_readfirstlane(tid >> 6), lane = tid & 63, wr = wid >> 2, wc = wid & 3, fr = lane & 15, fq = lane >> 4;
    const int K = g.K, nt = K / BK;
    int ts_lo = 0, ts_hi = 0, nts = 0; const unsigned long long rt_entry = STAMP ? (unsigned long long)wall_clock64() : 0ull;
#define PG8_STAMP() do { if (STAMP && wid == 0 && nts < 64) { const unsigned long long _c = (unsigned long long)clock64(); \
        ts_lo = (lane == nts) ? (int)(unsigned)_c : ts_lo; ts_hi = (lane == nts) ? (int)(unsigned)(_c >> 32) : ts_hi; ++nts; } } while (0)
    PG8_STAMP();
    unsigned voffA[2], voffB[2];
#pragma unroll
    for (int i = 0; i < 2; ++i) { int R, C; stage_rc(tid * 16 + i * 8192, R, C); const int Rb = Epi::PERM ? ((R & ~31) + perm32(R & 31)) : R;
        voffA[i] = (unsigned)(R * K + C) * 2u; voffB[i] = (unsigned)(Rb * K + C) * 2u; }
    const size_t kstep = (size_t)(BK * 2);
    const size_t hstep = (size_t)HALF * K * 2;
    const size_t tstep = 2 * hstep;
    const unsigned ldsw = (unsigned)wid * 1024u;
    const int aoff = lds_byte(wr * 64 + fr, fq * 8), boff = lds_byte(wc * 32 + fr, fq * 8);
#define PG8_SA(b, h) (((b) * 2 + (h)) * HTB)
#define PG8_SB(b, h) ((4 + (b) * 2 + (h)) * HTB)
#define PG8_STAGE(bufoff, gbase, voff) do { _Pragma("unroll") for (int _i = 0; _i < 2; ++_i) \
        __builtin_amdgcn_global_load_lds((const unsigned*)((const char*)(gbase) + (voff)[_i]), (PG8_LAS unsigned*)(lds + (bufoff) + ldsw + _i * 8192), 16, 0, 0); } while (0)
typedef int pg8_i32x4 __attribute__((ext_vector_type(4))); typedef int pg8_i32x8 __attribute__((ext_vector_type(8)));
#define PG8_LD8(addr) __builtin_shufflevector(*(const PG8_LAS pg8_i32x4*)(addr), *(const PG8_LAS pg8_i32x4*)((addr) + 1024), 0, 1, 2, 3, 4, 5, 6, 7)
#define PG8_LDA(dst, b, h) do { if constexpr (F8) { _Pragma("unroll") for (int m = 0; m < 4; ++m) dst##8[m] = PG8_LD8(lds + PG8_SA(b, h) + aoff + m * 2048); } \
        else { _Pragma("unroll") for (int m = 0; m < 4; ++m) _Pragma("unroll") for (int k = 0; k < 2; ++k) dst[m][k] = *(const PG8_LAS bf16x8*)(lds + PG8_SA(b, h) + aoff + m * 2048 + k * 1024); } } while (0)
#define PG8_LDB(dst, b, h) do { if constexpr (F8) { _Pragma("unroll") for (int n = 0; n < 2; ++n) dst##8[n] = PG8_LD8(lds + PG8_SB(b, h) + boff + n * 2048); } \
        else { _Pragma("unroll") for (int n = 0; n < 2; ++n) _Pragma("unroll") for (int k = 0; k < 2; ++k) dst[n][k] = *(const PG8_LAS bf16x8*)(lds + PG8_SB(b, h) + boff + n * 2048 + k * 1024); } } while (0)
#define PG8_MMA(ai, bj, At, Bt) do { __builtin_amdgcn_s_setprio(1); _Pragma("unroll") for (int m = 0; m < 4; ++m) _Pragma("unroll") for (int n = 0; n < 2; ++n) { \
        if constexpr (F8) { asm volatile("v_mfma_scale_f32_16x16x128_f8f6f4 %0, %1, %2, %0, %3, %3 op_sel_hi:[0,0,0]" : "+v"(acc[ai][bj][m][n]) : "v"(Bt##8[n]), "v"(At##8[m]), "v"(sc1_)); } \
        else { _Pragma("unroll") for (int k = 0; k < 2; ++k) acc[ai][bj][m][n] = __builtin_amdgcn_mfma_f32_16x16x32_bf16(Bt[n][k], At[m][k], acc[ai][bj][m][n], 0, 0, 0); } } \
        __builtin_amdgcn_s_setprio(0); } while (0)
#define PG8_WAIT_V(n) asm volatile("s_waitcnt vmcnt(" #n ")" ::: "memory")
#define PG8_WAIT_L(n) asm volatile("s_waitcnt lgkmcnt(" #n ")" ::: "memory")
#define PG8_BAR __builtin_amdgcn_s_barrier()
#define PG8_SCHED __builtin_amdgcn_sched_barrier(0)
    Unit cur, nxt; int ui = 0;
    if (!S.next(0, cur)) return;
    f32x4 acc[2][2][4][2];
#pragma unroll
    for (int a = 0; a < 2; ++a)
#pragma unroll
        for (int b = 0; b < 2; ++b)
#pragma unroll
            for (int m = 0; m < 4; ++m)
#pragma unroll
                for (int n = 0; n < 2; ++n) acc[a][b][m][n] = (f32x4){0.f, 0.f, 0.f, 0.f};
    const int sc1_ = 0x7f7f7f7f;
    bf16x8 At[4][2], B0[2][2], B1[2][2]; pg8_i32x8 At8[4], B08[2], B18[2];
    const char* cA = (const char*)g.A + (size_t)cur.pm * tstep; const char* cB = (const char*)g.Bt + (size_t)cur.pn * tstep;
    S.a_ready(cur);
    PG8_STAGE(PG8_SB(0, 0), cB, voffB); PG8_STAGE(PG8_SA(0, 0), cA, voffA); PG8_STAGE(PG8_SB(0, 1), cB + hstep, voffB); PG8_STAGE(PG8_SA(0, 1), cA + hstep, voffA);
    if (wr == 1) PG8_BAR;
    PG8_WAIT_V(4); PG8_BAR;
    PG8_STAGE(PG8_SB(1, 0), cB + kstep, voffB); PG8_STAGE(PG8_SA(1, 0), cA + kstep, voffA); PG8_STAGE(PG8_SB(1, 1), cB + hstep + kstep, voffB);
    PG8_WAIT_V(6); PG8_BAR;
    PG8_STAMP();
    for (;;) {
        const bool has_next = S.next(ui + 1, nxt);
        const char* nA = has_next ? (const char*)g.A + (size_t)nxt.pm * tstep : cA; const char* nB = has_next ? (const char*)g.Bt + (size_t)nxt.pn * tstep : cB;
        for (int t = 0; t < nt; t += 2) {
            const bool last = (t == nt - 2);
            const char* a1 = cA + (size_t)(t + 1) * kstep;
            const char* a2 = last ? nA : cA + (size_t)(t + 2) * kstep; const char* b2 = last ? nB : cB + (size_t)(t + 2) * kstep;
            const char* a3 = a2 + kstep; const char* b3 = b2 + kstep;
            if (last && has_next) S.a_ready(nxt);
            PG8_LDB(B0, 0, 0); PG8_SCHED; PG8_LDA(At, 0, 0); PG8_STAGE(PG8_SA(1, 1), a1 + hstep, voffA);
            PG8_WAIT_L(8); PG8_BAR; PG8_WAIT_L(0); PG8_MMA(0, 0, At, B0); PG8_BAR; PG8_SCHED;
            PG8_LDB(B1, 0, 1); PG8_STAGE(PG8_SB(0, 0), b2, voffB);
            PG8_BAR; PG8_WAIT_L(0); PG8_MMA(0, 1, At, B1); PG8_BAR;
            PG8_LDA(At, 0, 1); PG8_STAGE(PG8_SA(0, 0), a2, voffA);
            PG8_BAR; PG8_WAIT_L(0); PG8_MMA(1, 0, At, B0); PG8_BAR; PG8_SCHED;
            PG8_STAGE(PG8_SB(0, 1), b2 + hstep, voffB);
            PG8_WAIT_V(6); PG8_BAR; PG8_MMA(1, 1, At, B1); PG8_BAR;
            PG8_LDB(B0, 1, 0); PG8_SCHED; PG8_LDA(At, 1, 0); PG8_STAGE(PG8_SA(0, 1), a2 + hstep, voffA);
            PG8_WAIT_L(8); PG8_BAR; PG8_WAIT_L(0); PG8_MMA(0, 0, At, B0); PG8_BAR; PG8_SCHED;
            PG8_LDB(B1, 1, 1); PG8_STAGE(PG8_SB(1, 0), b3, voffB);
            PG8_BAR; PG8_WAIT_L(0); PG8_MMA(0, 1, At, B1); PG8_BAR;
            PG8_LDA(At, 1, 1); PG8_STAGE(PG8_SA(1, 0), a3, voffA);
            PG8_BAR; PG8_WAIT_L(0); PG8_MMA(1, 0, At, B0); PG8_BAR; PG8_SCHED;
            PG8_STAGE(PG8_SB(1, 1), b3 + hstep, voffB);
            PG8_WAIT_V(6); PG8_BAR; PG8_MMA(1, 1, At, B1); PG8_BAR;
        }
        PG8_STAMP();
        if constexpr (!Epi::AFTER_DRAIN) { E(acc, cur, wr, wc, fr, fq); S.done(cur); }
        PG8_STAMP();
        if (!has_next) break;
#pragma unroll
        for (int a = 0; a < 2; ++a)
#pragma unroll
            for (int b = 0; b < 2; ++b)
#pragma unroll
                for (int m = 0; m < 4; ++m)
#pragma unroll
                    for (int n = 0; n < 2; ++n) acc[a][b][m][n] = (f32x4){0.f, 0.f, 0.f, 0.f};
        cur = nxt; cA = nA; cB = nB; ++ui;
    }
    PG8_WAIT_V(0);
    if (wr == 0) PG8_BAR;
    PG8_BAR;
    if constexpr (Epi::AFTER_DRAIN) { E.fused(acc, cur, wr, wc, fr, fq, lds, wid, lane); S.done(cur); }
    PG8_STAMP();
    if (STAMP && wid == 0) { stamps[lane] = lane < nts ? (((unsigned long long)(unsigned)ts_hi << 32) | (unsigned)ts_lo) : 0ull;
        if (lane == 62) stamps[62] = rt_entry; if (lane == 63) stamps[63] = (unsigned long long)wall_clock64(); }
#undef PG8_STAMP
#undef PG8_SA
#undef PG8_SB
#undef PG8_STAGE
#undef PG8_LDA
#undef PG8_LD8
#undef PG8_LDB
#undef PG8_MMA
#undef PG8_WAIT_V
#undef PG8_WAIT_L
#undef PG8_BAR
#undef PG8_SCHED
}
}
namespace at {
constexpr int D = 128;
constexpr float THR = 8.f;
constexpr float SCALE = 0.08838834764831845f;
constexpr int NW = 8, QBLK = 32, KVBLK = 64, QB = NW * QBLK;
constexpr int SHM_V = KVBLK * D * 2, SHM_K = KVBLK * D * 2;
constexpr int LDS_BYTES = 2 * SHM_V + 2 * SHM_K + NW * 64 * 4;

typedef unsigned short bf16;
typedef short bf16x8 __attribute__((ext_vector_type(8)));
typedef short s16x4 __attribute__((ext_vector_type(4)));
typedef float f32x16 __attribute__((ext_vector_type(16)));
typedef float f32x4 __attribute__((ext_vector_type(4)));
typedef unsigned u32x4 __attribute__((ext_vector_type(4)));
template <class A, class Bt> struct same_t { static constexpr bool v = false; };
template <class A> struct same_t<A, A> { static constexpr bool v = true; };

#define KSWZ(row, colB) ((row) * 256 + ((colB) ^ (((row) & 7) << 4)))
#define SBAR() __builtin_amdgcn_sched_barrier(0)
__device__ __forceinline__ int v_st(int k, int c) { const int kk = (k & ~0xC) | ((k & 4) << 1) | ((k & 8) >> 1); return ((kk >> 3) * 4 + (c >> 5)) * 512 + ((kk & 7) * 32 + (c & 31)) * 2; }
__device__ __forceinline__ int v_rd_base(int lane) { return ((lane & 3) << 3) | (((lane >> 2) & 3) << 6) | (((lane >> 4) & 1) << 5) | (((lane >> 5) & 1) << 8); }
constexpr int v_rd_off(int d0, int ks, int half) { return d0 * 512 + ks * 4096 + half * 2048; }
__device__ __forceinline__ int crow(int r, int hi) { return (r & 3) + 8 * (r >> 2) + 4 * hi; }
__device__ __forceinline__ unsigned cvtpk(float lo, float hi) {
    unsigned r; asm volatile("v_cvt_pk_bf16_f32 %0, %1, %2" : "=v"(r) : "v"(lo), "v"(hi)); return r;
}
__device__ __forceinline__ bf16x8 pack8(f32x4 a, f32x4 b) {
    u32x4 w = {cvtpk(a[0], a[1]), cvtpk(a[2], a[3]), cvtpk(b[0], b[1]), cvtpk(b[2], b[3])};
    return *reinterpret_cast<bf16x8*>(&w);
}
template <class T> __device__ __forceinline__ bf16x8 load8(const T* p) {
    if constexpr (same_t<T, float>::v) { return pack8(*(const f32x4*)p, *(const f32x4*)(p + 4)); }
    else { return *reinterpret_cast<const bf16x8*>(p); }
}
__device__ __forceinline__ void mask_tile(f32x16& p0, f32x16& p1, int dq, unsigned W) {
    const float NEG = -__builtin_inff();
#pragma unroll
    for (int r = 0; r < 16; ++r) {
        const int c = (r & 3) + 8 * (r >> 2);
        if ((unsigned)(dq - c) >= W) p0[r] = NEG;
        if ((unsigned)(dq - c - 32) >= W) p1[r] = NEG;
    }
}
__device__ __forceinline__ void partialSM(f32x16& p0, f32x16& p1, float& m_reg, float& mn, float& alpha) {
    float pmax = p0[0]; for (int r = 1; r < 16; ++r) pmax = fmaxf(pmax, p0[r]); for (int r = 0; r < 16; ++r) pmax = fmaxf(pmax, p1[r]);
    { auto rr = __builtin_amdgcn_permlane32_swap(__float_as_uint(pmax), __float_as_uint(pmax), false, false);
      pmax = fmaxf(__uint_as_float(rr[0]), __uint_as_float(rr[1])); }
    constexpr float C2 = 1.4426950408889634f * SCALE;
    if (__builtin_expect(__all((pmax - m_reg) * SCALE <= THR), 1)) { mn = m_reg; alpha = 1.f; }
    else { mn = fmaxf(m_reg, pmax); alpha = __builtin_amdgcn_exp2f((m_reg - mn) * C2); m_reg = mn; }
    const float mnL = -mn * C2;
    for (int r = 0; r < 16; ++r) p0[r] = fmaf(p0[r], C2, mnL); for (int r = 0; r < 16; ++r) p1[r] = fmaf(p1[r], C2, mnL);
    for (int r = 0; r < 16; ++r) p0[r] = __builtin_amdgcn_exp2f(p0[r]);
}
__device__ __forceinline__ void finishSM(f32x16& p0, f32x16& p1, float alpha, float& l_reg, bf16x8& pa0, bf16x8& pa1, bf16x8& pa2, bf16x8& pa3) {
    for (int r = 0; r < 16; ++r) p1[r] = __builtin_amdgcn_exp2f(p1[r]);
    float ps = 0; for (int r = 0; r < 16; ++r) ps += p0[r]; for (int r = 0; r < 16; ++r) ps += p1[r];
    { auto rr = __builtin_amdgcn_permlane32_swap(__float_as_uint(ps), __float_as_uint(ps), false, false);
      ps = __uint_as_float(rr[0]) + __uint_as_float(rr[1]); }
    l_reg = l_reg * alpha + ps;
#define PK4(P, B_, OUT) do { unsigned a0 = cvtpk(P[B_+0], P[B_+1]), a1 = cvtpk(P[B_+2], P[B_+3]);                          \
        unsigned b0 = cvtpk(P[B_+4], P[B_+5]), b1 = cvtpk(P[B_+6], P[B_+7]);                                             \
        auto r0 = __builtin_amdgcn_permlane32_swap(a0, b0, false, false); auto r1 = __builtin_amdgcn_permlane32_swap(a1, b1, false, false); \
        u32x4 w = {r0[0], r1[0], r0[1], r1[1]}; OUT = *reinterpret_cast<bf16x8*>(&w); } while (0)
    PK4(p0, 0, pa0); PK4(p0, 8, pa1); PK4(p1, 0, pa2); PK4(p1, 8, pa3);
#undef PK4
}
template <int KB, bool SK>
__device__ __forceinline__ void qkt(f32x16& p0, f32x16& p1, const char* K_lds, int r32, int hi, const bf16x8* qr, bool act) {
    if (SK && !act) { const float NEG = -__builtin_inff();
#pragma unroll
        for (int r = 0; r < 16; ++r) { p0[r] = NEG; p1[r] = NEG; } return; }
    p0 = f32x16{}; p1 = f32x16{};
    const char* kb[4];
#pragma unroll
    for (int dd = 0; dd < 4; ++dd) kb[dd] = K_lds + KB * SHM_K + KSWZ(r32, (dd * 16 + hi * 8) * 2);
#pragma unroll
    for (int d0 = 0; d0 < 8; ++d0) { const char* a = kb[d0 & 3] + (d0 >> 2) * 128;
        bf16x8 b0 = *reinterpret_cast<const bf16x8*>(a);
        bf16x8 b1 = *reinterpret_cast<const bf16x8*>(a + 32 * 256);
        p0 = __builtin_amdgcn_mfma_f32_32x32x16_bf16(b0, qr[d0], p0, 0, 0, 0);
        p1 = __builtin_amdgcn_mfma_f32_32x32x16_bf16(b1, qr[d0], p1, 0, 0, 0); }
}
template <int VB, bool SK>
__device__ __forceinline__ void pv_tile(f32x16* o, int vb0, bf16x8 pa0, bf16x8 pa1, bf16x8 pa2, bf16x8 pa3, bool act) {
    if (SK && !act) return;
#define TRRD(dst, off) asm volatile("ds_read_b64_tr_b16 %0, %1 offset:%2" : "=&v"(dst) : "v"(vb0), "i"(off) : "memory")
#define PV_D0(d0) do { s16x4 l0, l1, l2, l3, h0, h1, h2, h3; constexpr int b_ = VB * SHM_V + v_rd_off(d0, 0, 0);     \
        TRRD(l0, b_); TRRD(h0, b_ + 2048); TRRD(l1, b_ + 4096); TRRD(h1, b_ + 6144); TRRD(l2, b_ + 8192); TRRD(h2, b_ + 10240); TRRD(l3, b_ + 12288); TRRD(h3, b_ + 14336); \
        asm volatile("s_waitcnt lgkmcnt(0)" ::: "memory"); SBAR();                 \
        o[d0] = __builtin_amdgcn_mfma_f32_32x32x16_bf16(pa0, (bf16x8){l0[0], l0[1], l0[2], l0[3], h0[0], h0[1], h0[2], h0[3]}, o[d0], 0, 0, 0);   \
        o[d0] = __builtin_amdgcn_mfma_f32_32x32x16_bf16(pa1, (bf16x8){l1[0], l1[1], l1[2], l1[3], h1[0], h1[1], h1[2], h1[3]}, o[d0], 0, 0, 0);   \
        o[d0] = __builtin_amdgcn_mfma_f32_32x32x16_bf16(pa2, (bf16x8){l2[0], l2[1], l2[2], l2[3], h2[0], h2[1], h2[2], h2[3]}, o[d0], 0, 0, 0);   \
        o[d0] = __builtin_amdgcn_mfma_f32_32x32x16_bf16(pa3, (bf16x8){l3[0], l3[1], l3[2], l3[3], h3[0], h3[1], h3[2], h3[3]}, o[d0], 0, 0, 0); } while (0)
    PV_D0(0); PV_D0(1); PV_D0(2); PV_D0(3);
#undef PV_D0
#undef TRRD
}

struct BlockRef { const bf16* Q; const bf16* K; const bf16* V; bf16* O; float* L; int P0, W, skv, rs; };
struct Seam { bf16x8 qr[8]; bf16x8 st_v0, st_v1, st_k0, st_k1; };
__device__ __forceinline__ int swa_jlo(int P0, int W) { const int lowk = P0 - W + 1; return lowk > 0 ? lowk / KVBLK : 0; }
#define VMW() asm volatile("s_waitcnt vmcnt(0)" ::: "memory")
#define VMWN(n) asm volatile("s_waitcnt vmcnt(%0)" :: "i"(n) : "memory")
#define ROW(p, k0, rr) ((p) + (size_t)(unsigned)(((k0) + (rr)) * RS_) + sc)
#define RS_OF(ref) ({ int rs__ = (ref).rs; asm volatile("" : "+s"(rs__)); rs__; })
#define SLOAD_H(Kp, Vp, k0) do { S.st_v0 = load8<bf16>(ROW(Vp, k0, sr)); S.st_v1 = load8<bf16>(ROW(Vp, k0, 32 + sr));              \
                         S.st_k0 = load8<bf16>(ROW(Kp, k0, sr)); S.st_k1 = load8<bf16>(ROW(Kp, k0, 32 + sr)); } while (0)
#define SWRITE_HK(bf) do { *(bf16x8*)(K_lds + (bf) * SHM_K + kws) = S.st_k0; *(bf16x8*)(K_lds + (bf) * SHM_K + kws + 32 * 256) = S.st_k1; } while (0)
#define SWRITE_HV(bf) do { *(bf16x8*)(V_lds + (bf) * SHM_V + vst0) = S.st_v0; *(bf16x8*)(V_lds + (bf) * SHM_V + vst1) = S.st_v1; } while (0)
#define SWRITE_H(bf) do { SWRITE_HV(bf); SWRITE_HK(bf); } while (0)
__device__ __forceinline__ void causal_swa_prime(const BlockRef& cur, char* lds, Seam& S) {
    const int tid = threadIdx.x, wid = __builtin_amdgcn_readfirstlane(tid >> 6), lane = tid & 63, r32 = lane & 31, hi = lane >> 5;
    const int sr = tid >> 4, sc = (tid & 15) * 8, kws = KSWZ(sr, sc * 2); char* K_lds = lds + 2 * SHM_V;
    const int kb0 = swa_jlo(cur.P0, cur.W) * KVBLK;
    { const int RS_ = RS_OF(cur);
    for (int d0 = 0; d0 < 8; ++d0) S.qr[d0] = load8<bf16>(cur.Q + (size_t)(unsigned)((wid * QBLK + r32) * RS_) + d0 * 16 + hi * 8);
    SLOAD_H(cur.K, cur.V, kb0); } VMW(); SWRITE_HK(0);
    __syncthreads();
}
struct Svc { const float* tu; const float* tv; unsigned char* du; unsigned char* dv; int next, p_old, p_new, par, G, bid; };
constexpr int SVC_OFF = 73728, SVC_NCH = 65536;
typedef float svc_f4 __attribute__((ext_vector_type(4)));
__device__ __forceinline__ void svc_top(Svc& sv, char* lds) {
    if (sv.p_old < 0) return;
    int tid; asm volatile("v_mov_b32 %0, %1" : "=v"(tid) : "v"(threadIdx.x));
    const int g = sv.p_old, e = (g >> 1) & 16383;
    svc_f4 x = *(const svc_f4*)(lds + SVC_OFF + sv.par * 8192 + tid * 16);
    x *= (g >> 15) ? 16.0f : 256.0f;
    int w = __builtin_amdgcn_cvt_pk_fp8_f32(x.x, x.y, 0, false); w = __builtin_amdgcn_cvt_pk_fp8_f32(x.z, x.w, w, true);
    unsigned char* d = ((g >> 15) ? sv.dv : sv.du) + (size_t)e * 128 + ((size_t)(g & 1) << 25);
    __builtin_nontemporal_store(w, (int*)(d + (((tid >> 5) << 21) | ((tid & 31) << 2))));
}
__device__ __forceinline__ void svc_dma(Svc& sv, char* lds) {
    int tid; asm volatile("v_mov_b32 %0, %1" : "=v"(tid) : "v"(threadIdx.x));
    const int g = sv.next * sv.G + sv.bid;
    const bool live = sv.next >= 0 && g < SVC_NCH;
    const float* src = live ? ((g >> 15) ? sv.tv : sv.tu) + (size_t)((g >> 1) & 16383) * 4096 + (g & 1) * 2048 : sv.tu;
    const unsigned ldsa = __builtin_amdgcn_readfirstlane((unsigned)(uintptr_t)lds + SVC_OFF + sv.par * 8192 + (tid >> 6) * 1024);
    asm volatile("s_mov_b32 m0, %0\n\ts_nop 0\n\tglobal_load_lds_dwordx4 %1, %2 nt" :: "s"(ldsa), "v"(tid * 16), "s"(src) : "memory", "m0");
    sv.p_old = sv.p_new; sv.p_new = live ? g : -1; sv.next = live ? sv.next + 1 : -1; sv.par ^= 1;
}
__device__ __forceinline__ bool svc_busy(const Svc& sv) { return sv.next >= 0 || sv.p_old >= 0 || sv.p_new >= 0; }
template <bool SK>
__device__ __forceinline__ void causal_swa_block(const BlockRef& cur, const BlockRef& nxt, char* lds, Seam& S, Svc& sv) {
    const int tid = threadIdx.x, wid = __builtin_amdgcn_readfirstlane(tid >> 6), lane = tid & 63, r32 = lane & 31, hi = lane >> 5;
    const int W = cur.W, skv = cur.skv;
    const int j_lo = swa_jlo(cur.P0, W);
    int j_hi = (cur.P0 + QB - 1) / KVBLK + 1; if (j_hi > skv / KVBLK) j_hi = skv / KVBLK;
    const int NT = j_hi - j_lo;
    const int kbn = swa_jlo(nxt.P0, nxt.W) * KVBLK;
    const int qlo = cur.P0 + wid * QBLK, qm = qlo + r32 - 4 * hi;
    char* V_lds = lds; char* K_lds = lds + 2 * SHM_V;
    float* ws = (float*)(lds + 2 * SHM_V + 2 * SHM_K) + wid * 64; float* li_l = ws, * al_l = ws + 32;
    float m_reg = -1e30f, l_reg = 0; f32x16 o[4] = {};
    const int sr = tid >> 4, sc = (tid & 15) * 8, vst0 = v_st(sr, sc), vst1 = v_st(32 + sr, sc), kws = KSWZ(sr, sc * 2);
    const int vb0 = (int)(uintptr_t)V_lds + v_rd_base(lane);
    const bf16* Kh = cur.K; const bf16* Vh = cur.V;
#define RESC(a) do { if (__any((a) < 1.f)) { if (hi == 0) al_l[r32] = (a); asm volatile("s_waitcnt lgkmcnt(0)" ::: "memory");              \
                     for (int d_ = 0; d_ < 4; ++d_) for (int r = 0; r < 16; ++r) o[d_][r] *= al_l[crow(r, hi)]; } } while (0)
#define KBASE(t) ((j_lo + (t)) * KVBLK)
#define ACT(t) (KBASE(t) <= qlo + QBLK - 1 && KBASE(t) + KVBLK - 1 >= qlo - W + 1)
#define MASKT(P0_, P1_, t) do { const int kb_ = KBASE(t); if ((!SK || ACT(t)) && (kb_ + KVBLK - 1 > qlo || kb_ <= qlo + QBLK - 1 - W)) mask_tile(P0_, P1_, qm - kb_, (unsigned)W); } while (0)
    constexpr int NQL = 8;
#define SEAM_K0() do { VMWN(NQL); SWRITE_HK(0); SBAR(); } while (0)
    f32x16 pA0, pA1, pB0, pB1; float mnA, mnB, alA, alB; bf16x8 pa0, pa1, pa2, pa3;
    SWRITE_HV(0); SBAR();
    if (NT > 1) { const int RS_ = RS_OF(cur); SLOAD_H(Kh, Vh, KBASE(1)); }
    SBAR(); qkt<0, SK>(pA0, pA1, K_lds, r32, hi, S.qr, ACT(0));
    MASKT(pA0, pA1, 0); partialSM(pA0, pA1, m_reg, mnA, alA);
    if (NT > 1) { VMW(); SWRITE_H(1); }
    __syncthreads();
#define HALF_STEP(PX0, PX1, mnX, alX, PY0, PY1, alY, t, KB, VB, SB) do {                                                      \
        svc_top(sv, lds);                                                                                                     \
        SBAR(); qkt<KB, SK>(PX0, PX1, K_lds, r32, hi, S.qr, ACT(t));                                             \
        finishSM(PY0, PY1, alY, l_reg, pa0, pa1, pa2, pa3); SBAR();                                                           \
        if ((t) + 1 < NT) { const int RS_ = RS_OF(cur); SLOAD_H(Kh, Vh, KBASE((t) + 1)); } svc_dma(sv, lds); SBAR();                              \
        pv_tile<VB, SK>(o, vb0, pa0, pa1, pa2, pa3, ACT((t) - 1)); MASKT(PX0, PX1, (t)); partialSM(PX0, PX1, m_reg, mnX, alX);                                        \
        __syncthreads();                                                                                                      \
        if ((t) + 1 < NT) { VMWN(1); SWRITE_H(SB); }                                                                        \
        RESC(alX); __syncthreads(); } while (0)
    for (int t = 1; t + 1 < NT; t += 2) {
        HALF_STEP(pB0, pB1, mnB, alB, pA0, pA1, alA, t, 1, 0, 0);
        HALF_STEP(pA0, pA1, mnA, alA, pB0, pB1, alB, t + 1, 0, 1, 1);
    }
    const bool even = (NT & 1) == 0;
    if (even) { SBAR(); qkt<1, SK>(pB0, pB1, K_lds, r32, hi, S.qr, ACT(NT - 1)); SBAR(); }
    { const int RS_ = RS_OF(nxt); SLOAD_H(nxt.K, nxt.V, kbn); SBAR();
#pragma unroll
      for (int d0 = 0; d0 < 8; ++d0) S.qr[d0] = load8<bf16>(nxt.Q + (size_t)(unsigned)((wid * QBLK + r32) * RS_) + d0 * 16 + hi * 8); }
    SBAR();
    finishSM(pA0, pA1, alA, l_reg, pa0, pa1, pa2, pa3); SBAR();
    pv_tile<0, SK>(o, vb0, pa0, pa1, pa2, pa3, ACT(even ? NT - 2 : NT - 1));
    if (even) { MASKT(pB0, pB1, NT - 1); partialSM(pB0, pB1, m_reg, mnB, alB); __syncthreads(); RESC(alB);
        finishSM(pB0, pB1, alB, l_reg, pa0, pa1, pa2, pa3); SBAR(); pv_tile<1, SK>(o, vb0, pa0, pa1, pa2, pa3, ACT(NT - 1)); }
    SBAR(); SEAM_K0();
    if (hi == 0) li_l[r32] = l_reg; asm volatile("s_waitcnt lgkmcnt(0)" ::: "memory");
    if (cur.L != nullptr && hi == 0) cur.L[wid * QBLK + r32] = m_reg * SCALE + __logf(l_reg);
    float rli[16];
#pragma unroll
    for (int r = 0; r < 16; ++r) rli[r] = __builtin_amdgcn_rcpf(li_l[crow(r, hi)]);
    bf16* Ow = cur.O + (size_t)(wid * QBLK) * D;
#pragma unroll
    for (int r = 0; r < 16; ++r) { const int orow = crow(r, hi);
#pragma unroll
        for (int d0 = 0; d0 < 4; ++d0) { const float v = o[d0][r] * rli[r]; const float vn = __shfl_xor(v, 1);
            if ((r32 & 1) == 0) *(unsigned*)(Ow + (size_t)orow * D + d0 * 32 + r32) = cvtpk(v, vn); } }
    __syncthreads();
#undef RESC
#undef KBASE
#undef ACT
#undef MASKT
#undef SEAM_K0
#undef HALF_STEP
}
#undef ROW
#undef RS_OF
#undef VMW
#undef VMWN
#undef SLOAD_H
#undef SWRITE_HK
#undef SWRITE_HV
#undef SWRITE_H
#undef KSWZ
#undef SBAR
}
#define XB_TMO      128
#define XB_XCNT(j)  (256  + 64 * (j))
#define XB_XSUB(j)  (1280 + 64 * (j))
#define XB_XGEN(j)  (2304 + 64 * (j))
#define XB_TOP      3328
#define XB_TOPGEN   3392
#define XCD_BAR_WORDS 3456
#define XB_SPIN_CAP (1u << 18)
#define LAS __attribute__((address_space(3)))

__device__ __forceinline__ unsigned xb_ld(unsigned* p)              { return __hip_atomic_load(p, __ATOMIC_RELAXED, __HIP_MEMORY_SCOPE_AGENT); }
__device__ __forceinline__ unsigned xb_add(unsigned* p, unsigned v) { return __hip_atomic_fetch_add(p, v, __ATOMIC_RELAXED, __HIP_MEMORY_SCOPE_AGENT); }
__device__ __forceinline__ unsigned xb_xcc_id() { return (unsigned)__builtin_amdgcn_s_getreg((3 << 11) | 20) & 0xFu; }
#define XB_SPIN(cond, bar) do { unsigned _sp = 0; while (cond) { __builtin_amdgcn_s_sleep(1); \
    if ((++_sp & 255u) == 0u) { if (xb_ld(&(bar)[XB_TMO])) break; if (_sp > XB_SPIN_CAP) { atomicAdd(&(bar)[XB_TMO], 1u); break; } } } } while (0)

struct XcdBarrier {
    unsigned* bar; unsigned x;
    volatile LAS unsigned* st;
};

__device__ __forceinline__ XcdBarrier xcd_barrier_post(unsigned* bar, volatile LAS unsigned* st) {
    XcdBarrier b; b.bar = bar; b.x = xb_xcc_id(); b.st = st;
    if (threadIdx.x == 0) (void)xb_add(&bar[XB_XCNT(b.x)], 1u);
    return b;
}
__device__ __forceinline__ void xcd_barrier_complete(unsigned* bar, unsigned x, unsigned& nloc, unsigned& nx) {
    const unsigned G = gridDim.x * gridDim.y * gridDim.z;
    unsigned sum, cnt, mine, sp = 0u;
    for (;;) {
        sum = 0u; cnt = 0u; mine = 0u;
#pragma unroll
        for (unsigned j = 0; j < 16; ++j) { const unsigned c = xb_ld(&bar[XB_XCNT(j)]); sum += c; cnt += (c > 0u) ? 1u : 0u; mine = (j == x) ? c : mine; }
        if (sum == G) break;
        __builtin_amdgcn_s_sleep(1);
        if ((++sp & 255u) == 0u) { if (xb_ld(&bar[XB_TMO])) break; if (sp > XB_SPIN_CAP) { atomicAdd(&bar[XB_TMO], 1u); break; } }
    }
    nloc = mine > 0u ? mine : 1u; nx = cnt > 0u ? cnt : 1u;
}

__device__ __forceinline__ void xcd_barrier(const XcdBarrier& b) {
    asm volatile("s_waitcnt vmcnt(0)" ::: "memory");
    __syncthreads();
    if (threadIdx.x == 0) {
        unsigned* bar = b.bar;
        __builtin_amdgcn_s_waitcnt(0);
        unsigned nloc = b.st[0], nx = b.st[1];
        if (nloc == 0u) { xcd_barrier_complete(bar, b.x, nloc, nx); b.st[0] = nloc; b.st[1] = nx; }
        const unsigned old = xb_add(&bar[XB_XSUB(b.x)], 1u);
        const unsigned gen = old / nloc;
        if (old + 1u == (gen + 1u) * nloc) {
            __builtin_amdgcn_fence(__ATOMIC_RELEASE, "agent");
            asm volatile("s_waitcnt vmcnt(0)" ::: "memory");
            const unsigned og = xb_add(&bar[XB_TOP], 1u);
            const unsigned tg = og / nx;
            if (og + 1u == (tg + 1u) * nx) xb_add(&bar[XB_TOPGEN], 1u);
            else XB_SPIN(xb_ld(&bar[XB_TOPGEN]) == tg, bar);
            __builtin_amdgcn_fence(__ATOMIC_ACQUIRE, "agent");
            xb_add(&bar[XB_XGEN(b.x)], 1u);
            asm volatile("s_waitcnt vmcnt(0)" ::: "memory");
        } else {
            XB_SPIN(xb_ld(&bar[XB_XGEN(b.x)]) == gen, bar);
            __builtin_amdgcn_fence(__ATOMIC_ACQUIRE, "agent");
            asm volatile("s_waitcnt vmcnt(0)" ::: "memory");
        }
    }
    __syncthreads();
}
typedef unsigned short bf16_t;
typedef float f32x4 __attribute__((ext_vector_type(4)));
typedef float f32x2 __attribute__((ext_vector_type(2)));
typedef unsigned u32x4 __attribute__((ext_vector_type(4)));
typedef unsigned u32x2 __attribute__((ext_vector_type(2)));
typedef __bf16 bf16v2 __attribute__((ext_vector_type(2)));
#define LDS_WAIT() asm volatile("s_waitcnt lgkmcnt(0)" ::: "memory")

struct Args {
    const float* x; const float* c; const int* positions; const float* norm1_g; const float* norm2_g; const float* w_ada; const float* b_ada;
    const float* w_in; const float* lam_q1; const float* lam_k1; const float* lam_q2; const float* lam_k2; const float* diff_subln_g; const float* dil_out_g;
    const float* w_out; const float* peer_wq; const float* peer_subkeys; const float* peer_u; const float* peer_v; const float* final_g;
    float* out; unsigned char* ws; int ph_lo, ph_hi, flag, pad;
};

__device__ __forceinline__ unsigned cvt_pk(float lo, float hi) { unsigned r; asm volatile("v_cvt_pk_bf16_f32 %0, %1, %2" : "=v"(r) : "v"(lo), "v"(hi)); return r; }
__device__ __forceinline__ float bf_lo(unsigned u) { return __uint_as_float(u << 16); }
__device__ __forceinline__ float bf_hi(unsigned u) { return __uint_as_float(u & 0xffff0000u); }
__device__ __forceinline__ float dot2bf(unsigned a, unsigned b, float c) { return __builtin_amdgcn_fdot2_f32_bf16(__builtin_bit_cast(bf16v2, a), __builtin_bit_cast(bf16v2, b), c, false); }
__device__ __forceinline__ unsigned pk_fp8(const f32x4 v) { int r = __builtin_amdgcn_cvt_pk_fp8_f32(v.x, v.y, 0, false); r = __builtin_amdgcn_cvt_pk_fp8_f32(v.z, v.w, r, true); return (unsigned)r; }
__device__ __forceinline__ f32x4 ld4bf(const bf16_t* p) { const u32x2 w = *(const u32x2*)p; return (f32x4){bf_lo(w.x), bf_hi(w.x), bf_lo(w.y), bf_hi(w.y)}; }
__device__ __forceinline__ float wave_sum(float v) {
#pragma unroll
    for (int o = 1; o < 64; o <<= 1) v += __shfl_xor(v, o);
    return v;
}
__device__ __forceinline__ float half_sum(float v) {
#pragma unroll
    for (int o = 1; o < 32; o <<= 1) v += __shfl_xor(v, o);
    return v;
}

#ifdef PROBE_FLAGS
#define P0SEL(b) (!(A.flag & 0xf00) || (A.flag & (0x100 << (b))))
#else
#define P0SEL(b) true
#endif
__device__ __forceinline__ void p0_gemv_unit(const Args& A, float* mod, LAS float* red, int unit, int tid) {
    LAS float* sc = red + 2048;
    for (int i = tid; i < DM; i += 512) { const float cv = A.c[i]; sc[i] = cv / (1.0f + __expf(-cv)); }
    __syncthreads();
    const int rl = tid / 24, c4 = tid - rl * 24;
    if (tid < 384) {
        const float* wp = A.w_ada + (size_t)rl * NADA + unit * 96 + c4 * 4;
        const LAS float* cp = sc + rl;
        f32x4 acc = {0.f, 0.f, 0.f, 0.f};
        f32x4 w0[8], w1[8];
#pragma unroll
        for (int i = 0; i < 8; ++i) w0[i] = *(const f32x4*)(wp + (size_t)(16 * i) * NADA);
        for (int k0 = 0; k0 < DM; k0 += 256) {
#pragma unroll
            for (int i = 0; i < 8; ++i) w1[i] = *(const f32x4*)(wp + (size_t)(k0 + 128 + 16 * i) * NADA);
#pragma unroll
            for (int i = 0; i < 8; ++i) acc += cp[k0 + 16 * i] * w0[i];
            if (k0 + 256 < DM) {
#pragma unroll
                for (int i = 0; i < 8; ++i) w0[i] = *(const f32x4*)(wp + (size_t)(k0 + 256 + 16 * i) * NADA);
            }
#pragma unroll
            for (int i = 0; i < 8; ++i) acc += cp[k0 + 128 + 16 * i] * w1[i];
        }
        *(LAS f32x4*)(red + rl * 96 + c4 * 4) = acc;
    }
    __syncthreads();
    if (tid < 96) { float s = 0.f;
#pragma unroll
        for (int r = 0; r < 16; ++r) s += red[r * 96 + tid];
        mod[unit * 96 + tid] = s + A.b_ada[unit * 96 + tid]; }
    __syncthreads();
}
__device__ __forceinline__ void p0_tr_load(const float* W, int N, int item, int lane, f32x4 (&ld)[8]) {
    const int nblk = N / 32, kb = item / nblk, nb = item - kb * nblk;
    const float* p = W + (size_t)(64 * kb + (lane >> 3)) * N + 32 * nb + 4 * (lane & 7);
#pragma unroll
    for (int i = 0; i < 8; ++i) ld[i] = *(const f32x4*)(p + (size_t)(8 * i) * N);
}
template <bool F8>
__device__ __forceinline__ void p0_tr_store(const f32x4 (&ld)[8], int K, int N, bf16_t* WT, LAS float* scr, int item, int lane) {
    const int nblk = N / 32, kb = item / nblk, nb = item - kb * nblk, k0 = 64 * kb, n0 = 32 * nb;
#pragma unroll
    for (int i = 0; i < 8; ++i) { LAS float* d = scr + (8 * i + (lane >> 3)) * 33 + 4 * (lane & 7); d[0] = ld[i].x; d[1] = ld[i].y; d[2] = ld[i].z; d[3] = ld[i].w; }
    LDS_WAIT(); asm volatile("" ::: "memory");
    const int c = lane & 7;
#pragma unroll
    for (int j = 0; j < 4; ++j) { const int n = (lane >> 3) + 8 * j; const LAS float* s = scr + (8 * c) * 33 + n;
        if (F8) { u32x2 o8; o8.x = pk_fp8((f32x4){s[0 * 33], s[1 * 33], s[2 * 33], s[3 * 33]} * 1024.0f); o8.y = pk_fp8((f32x4){s[4 * 33], s[5 * 33], s[6 * 33], s[7 * 33]} * 1024.0f);
            *(u32x2*)((unsigned char*)WT + (size_t)(n0 + n) * K + k0 + 8 * c) = o8; }
        else { u32x4 o; o.x = cvt_pk(s[0 * 33], s[1 * 33]); o.y = cvt_pk(s[2 * 33], s[3 * 33]); o.z = cvt_pk(s[4 * 33], s[5 * 33]); o.w = cvt_pk(s[6 * 33], s[7 * 33]);
            *(u32x4*)(WT + (size_t)(n0 + n) * K + k0 + 8 * c) = o; } }
    LDS_WAIT(); asm volatile("" ::: "memory");
}
typedef __bf16 bf16v8_t __attribute__((ext_vector_type(8))); typedef float f32x8_t __attribute__((ext_vector_type(8)));
__device__ __forceinline__ pg8::bf16x8 pack8f(const f32x4 a, const f32x4 b) { const f32x8_t v = {a.x, a.y, a.z, a.w, b.x, b.y, b.z, b.w}; return __builtin_bit_cast(pg8::bf16x8, __builtin_convertvector(v, bf16v8_t)); }
__device__ __forceinline__ void p0_fold_item(const Args& A, bf16_t* wsc, int item, int lane) {
    const int g = item >> 7, d0 = (item & 127) * 32, r = lane & 15, kg = lane >> 4;
    pg8::bf16x8 af[2][4];
#pragma unroll
    for (int mt = 0; mt < 2; ++mt)
#pragma unroll
        for (int ks = 0; ks < 4; ++ks) { const float* p = A.peer_wq + (size_t)(d0 + 16 * mt + r) * 2048 + g * 128 + 32 * ks + 8 * kg; af[mt][ks] = pack8f(*(const f32x4*)p, *(const f32x4*)(p + 4)); }
    const float* skp = A.peer_subkeys + (size_t)g * 16384 + 8 * kg;
#pragma unroll 2
    for (int nt = 0; nt < 8; ++nt) {
        pg8::bf16x8 bfr[4];
#pragma unroll
        for (int ks = 0; ks < 4; ++ks) { const float* p = skp + (size_t)(16 * nt + r) * 128 + 32 * ks; bfr[ks] = pack8f(*(const f32x4*)p, *(const f32x4*)(p + 4)); }
#pragma unroll
        for (int mt = 0; mt < 2; ++mt) {
            f32x4 c = {0.f, 0.f, 0.f, 0.f};
#pragma unroll
            for (int ks = 0; ks < 4; ++ks) c = __builtin_amdgcn_mfma_f32_16x16x32_bf16(af[mt][ks], bfr[ks], c, 0, 0, 0);
            typedef __bf16 bf16v4_t __attribute__((ext_vector_type(4)));
            const u32x2 w = __builtin_bit_cast(u32x2, __builtin_convertvector(c, bf16v4_t));
            *(u32x2*)(wsc + (size_t)(g * 128 + 16 * nt + r) * DM + d0 + 16 * mt + 4 * kg) = w;
        }
    }
}
__device__ __forceinline__ void p0_cv_load(const Args& A, int item, int lane, f32x4 (&lu)[4], f32x4 (&lv)[4]) {
    const int eb = item >> 5, s = item & 31;
    const size_t off = (size_t)(eb * 8 + (lane >> 3)) * DM + s * 128 + 16 * (lane & 7);
#pragma unroll
    for (int i = 0; i < 4; ++i) { lu[i] = *(const f32x4*)(A.peer_u + off + 4 * i); lv[i] = *(const f32x4*)(A.peer_v + off + 4 * i); }
}
__device__ __forceinline__ void p0_cv_store(unsigned char* ws, int item, int lane, const f32x4 (&lu)[4], const f32x4 (&lv)[4]) {
    const int eb = item >> 5, s = item & 31;
    const size_t dst = ((size_t)s * NEXP + (size_t)eb * 8) * 8 + lane;
    u32x4 o, p;
    o.x = pk_fp8(lu[0] * 256.0f); o.y = pk_fp8(lu[1] * 256.0f); o.z = pk_fp8(lu[2] * 256.0f); o.w = pk_fp8(lu[3] * 256.0f);
    p.x = pk_fp8(lv[0] * 16.0f); p.y = pk_fp8(lv[1] * 16.0f); p.z = pk_fp8(lv[2] * 16.0f); p.w = pk_fp8(lv[3] * 16.0f);
    ((u32x4*)(ws + WS_UB))[dst] = o; ((u32x4*)(ws + WS_VB))[dst] = p;
}
__device__ __forceinline__ void p0_fold_item_old(const Args& A, bf16_t* wsc, LAS float* lds, int item, int tid) {
    const int g = item >> 6, d0 = (item & 63) * 64;
    LAS float* SK = lds;
    LAS float* WQ = lds + 128 * 132;
    const float* skp = A.peer_subkeys + (size_t)g * 16384;
    for (int i = tid; i < 128 * 32; i += 512) { const int n = i >> 5, k4 = i & 31; *(LAS f32x4*)(SK + n * 132 + 4 * k4) = *(const f32x4*)(skp + n * 128 + 4 * k4); }
    for (int i = tid; i < 64 * 32; i += 512) { const int d = i >> 5, k4 = i & 31; *(LAS f32x4*)(WQ + d * 132 + 4 * k4) = *(const f32x4*)(A.peer_wq + (size_t)(d0 + d) * 2048 + g * 128 + 4 * k4); }
    __syncthreads();
    const int n = tid & 127, dg = tid >> 7;
    float acc[16];
#pragma unroll
    for (int j = 0; j < 16; ++j) acc[j] = 0.f;
    for (int k4 = 0; k4 < 32; ++k4) {
        const f32x4 a = *(const LAS f32x4*)(SK + n * 132 + 4 * k4);
#pragma unroll
        for (int j = 0; j < 16; ++j) { const f32x4 b = *(const LAS f32x4*)(WQ + (dg * 16 + j) * 132 + 4 * k4); acc[j] += a.x * b.x + a.y * b.y + a.z * b.z + a.w * b.w; }
    }
    u32x4 o0, o1;
    o0.x = cvt_pk(acc[0], acc[1]); o0.y = cvt_pk(acc[2], acc[3]); o0.z = cvt_pk(acc[4], acc[5]); o0.w = cvt_pk(acc[6], acc[7]);
    o1.x = cvt_pk(acc[8], acc[9]); o1.y = cvt_pk(acc[10], acc[11]); o1.z = cvt_pk(acc[12], acc[13]); o1.w = cvt_pk(acc[14], acc[15]);
    bf16_t* op = wsc + (size_t)(g * 128 + n) * DM + d0 + dg * 16;
    *(u32x4*)op = o0; *(u32x4*)(op + 8) = o1;
    __syncthreads();
}
__device__ __forceinline__ void p0_prologue(const Args& A, LAS unsigned char* lds, int G, int bid, int tid) {
    const int lane = tid & 63, wave = __builtin_amdgcn_readfirstlane(tid >> 6);
    unsigned char* ws = A.ws;
    float* mod = (float*)(ws + WS_MOD);
    const int gw = bid * 8 + wave, NGW = G * 8;
    if (P0SEL(0)) for (int u = bid; u < NADA / 96; u += G) p0_gemv_unit(A, mod, (LAS float*)lds, u, tid);
    if (bid == G - 1 && wave == 0) {
        float a = 0.f, b = 0.f;
        for (int i = lane; i < 128; i += 64) { a += A.lam_q1[i] * A.lam_k1[i]; b += A.lam_q2[i] * A.lam_k2[i]; }
        a = wave_sum(a); b = wave_sum(b);
        if (lane == 0) *(float*)(ws + WS_LAM) = expf(a) - expf(b) + LAM_INIT;
    }
    {
        float* rope = (float*)(ws + WS_ROPE);
        for (int i = bid * 512 + tid; i < S * 16; i += G * 512) {
            const int s = i >> 4, f = i & 15;
            const float inv = powf(500000.0f, -(float)(2 * f) / 32.0f);
            const float ang = (float)A.positions[s] * inv;
            double rev = (double)ang * 0.15915494309189535; rev -= rint(rev);
            const float fr = (float)rev;
            rope[s * 32 + f] = __builtin_amdgcn_cosf(fr);
            rope[s * 32 + 16 + f] = __builtin_amdgcn_sinf(fr);
        }
    }
    if (P0SEL(1)) {
        LAS float* scr = (LAS float*)(lds + wave * 16384);
        constexpr int I_IN = (DM / 64) * (NIN / 32), I_OUT = (DM / 64) * (DM / 32);
        bf16_t* win = (bf16_t*)(ws + WS_WIN); bf16_t* wout = (bf16_t*)(ws + WS_WOUT);
        f32x4 cur[8], nxt[8];
        int it = gw;
        if (it < I_IN + I_OUT) { if (it < I_IN) p0_tr_load(A.w_in, NIN, it, lane, cur); else p0_tr_load(A.w_out, DM, it - I_IN, lane, cur); }
        for (; it < I_IN + I_OUT; it += NGW) {
            const int itn = it + NGW;
            if (itn < I_IN + I_OUT) { if (itn < I_IN) p0_tr_load(A.w_in, NIN, itn, lane, nxt); else p0_tr_load(A.w_out, DM, itn - I_IN, lane, nxt); }
            if (it < I_IN) { const int T_ = ((it % (NIN / 32)) * 32) >> 11;
                if (T_ == 2 || T_ == 5) p0_tr_store<true>(cur, DM, NIN, (bf16_t*)((unsigned char*)win + WIN8_OFF + ((ptrdiff_t)(T_ == 2 ? -4096 : -8192)) * DM), scr, it, lane);
                else p0_tr_store<false>(cur, DM, NIN, win + ((ptrdiff_t)(T_ > 2 ? -2048 : 0)) * DM, scr, it, lane); }
            else p0_tr_store<true>(cur, DM, DM, wout, scr, it - I_IN, lane);
#pragma unroll
            for (int i = 0; i < 8; ++i) cur[i] = nxt[i];
        }
    }
#ifdef OLD_FOLD
    __syncthreads();
    if (P0SEL(2)) for (int it = bid; it < 16 * 64; it += G) p0_fold_item_old(A, (bf16_t*)(ws + WS_WSC), (LAS float*)lds, it, tid);
#else
    if (P0SEL(2)) for (int it = gw; it < 16 * 128; it += NGW) p0_fold_item(A, (bf16_t*)(ws + WS_WSC), it, lane);
#endif
    if (false) {
        constexpr int NIT = (NEXP / 8) * 32;
        f32x4 cu[4], cv[4], nu[4], nv[4];
        int it = gw;
        if (it < NIT) p0_cv_load(A, it, lane, cu, cv);
        for (; it < NIT; it += NGW) {
            const int itn = it + NGW;
            if (itn < NIT) p0_cv_load(A, itn, lane, nu, nv);
            p0_cv_store(ws, it, lane, cu, cv);
#pragma unroll
            for (int i = 0; i < 4; ++i) { cu[i] = nu[i]; cv[i] = nv[i]; }
        }
    }
    __syncthreads();
}

template <bool INBF, bool F8OUT>
__device__ __forceinline__ void row_modulate(const void* xin_, const float* g, const float* sh, const float* sc, bf16_t* out, unsigned char* out8, LAS float* lv, int tid, int gw, int ngw, int lane) {
    for (int i = tid; i < DM / 4; i += 512) { const f32x4 gv = ((const f32x4*)g)[i], sv = ((const f32x4*)sc)[i]; ((LAS f32x4*)lv)[i] = gv * (1.0f + sv); ((LAS f32x4*)(lv + DM))[i] = ((const f32x4*)sh)[i]; }
    __syncthreads();
    for (int r = gw; r < S; r += ngw) {
        f32x4 v[16]; float ss = 0.f;
        if (INBF) { const bf16_t* xr = (const bf16_t*)xin_ + (size_t)r * DM + 8 * lane;
#pragma unroll
            for (int j = 0; j < 8; ++j) { const u32x4 w = *(const u32x4*)(xr + 512 * j);
                v[2 * j] = (f32x4){bf_lo(w.x), bf_hi(w.x), bf_lo(w.y), bf_hi(w.y)}; v[2 * j + 1] = (f32x4){bf_lo(w.z), bf_hi(w.z), bf_lo(w.w), bf_hi(w.w)}; }
        } else { const float* xr = (const float*)xin_ + (size_t)r * DM + 8 * lane;
#pragma unroll
            for (int j = 0; j < 8; ++j) { v[2 * j] = *(const f32x4*)(xr + 512 * j); v[2 * j + 1] = *(const f32x4*)(xr + 512 * j + 4); }
        }
#pragma unroll
        for (int j = 0; j < 16; ++j) ss += (v[j].x * v[j].x + v[j].y * v[j].y) + (v[j].z * v[j].z + v[j].w * v[j].w);
        ss = wave_sum(ss);
        const float rstd = 1.0f / sqrtf(ss * (1.0f / DM) + NORM_EPS);
        bf16_t* orow = out + (size_t)r * DM + 8 * lane;
#pragma unroll
        for (int j = 0; j < 8; ++j) { const int c = 8 * lane + 512 * j;
            const f32x4 a0 = *(const LAS f32x4*)(lv + c), a1 = *(const LAS f32x4*)(lv + c + 4), h0 = *(const LAS f32x4*)(lv + DM + c), h1 = *(const LAS f32x4*)(lv + DM + c + 4);
            const f32x4 y0 = v[2 * j] * rstd * a0 + h0, y1 = v[2 * j + 1] * rstd * a1 + h1;
            u32x4 w; w.x = cvt_pk(y0.x, y0.y); w.y = cvt_pk(y0.z, y0.w); w.z = cvt_pk(y1.x, y1.y); w.w = cvt_pk(y1.z, y1.w);
            *(u32x4*)(orow + 512 * j) = w;
            if (F8OUT) { u32x2 w8; w8.x = pk_fp8(y0 * 16.0f); w8.y = pk_fp8(y1 * 16.0f); *(u32x2*)(out8 + (size_t)r * DM + c) = w8; }
            if ((j & 3) == 3) __builtin_amdgcn_sched_barrier(0); }
    }
    __syncthreads();
}

struct EpiQKV {
    static constexpr bool PERM = true, AFTER_DRAIN = false;
    bf16_t* qkv; bf16_t* qkv2; const float* rope; int skip;
    __device__ __forceinline__ void operator()(const pg8::f32x4 (&acc)[2][2][4][2], const pg8::Unit& u, int wr, int wc, int fr, int fq) const {
        if (skip) return;
        const int tt_ = u.pn >> 3, T = tt_ + (tt_ >= 2 ? 1 : 0), hh0 = 2 * (u.pn & 7);
        const bool rot = (wc == 0);
        const int d0 = wc * 32 + 8 * fq;
        const float sgn = (fq < 2) ? -1.0f : 1.0f;
        bf16_t* base = qkv + (size_t)T * QKV_T + d0;
        const int rowb = u.pm * 256 + wr * 64 + fr;
        f32x4 cs0 = {1.f, 1.f, 1.f, 1.f}, cs1 = cs0, sn0 = {0.f, 0.f, 0.f, 0.f}, sn1 = sn0, ncs0 = cs0, ncs1 = cs0, nsn0 = sn0, nsn1 = sn0;
        if (rot) { const float* rp = rope + (size_t)rowb * 32 + 8 * (fq & 1);
            cs0 = *(const f32x4*)rp; cs1 = *(const f32x4*)(rp + 4); sn0 = *(const f32x4*)(rp + 16); sn1 = *(const f32x4*)(rp + 20); }
#pragma unroll
        for (int gi = 0; gi < 8; ++gi) {
            const int ai = gi >> 2, m = gi & 3;
            const int row = rowb + ai * 128 + m * 16;
            if (rot && gi < 7) { const int nrow = rowb + ((gi + 1) >> 2) * 128 + ((gi + 1) & 3) * 16; const float* rp = rope + (size_t)nrow * 32 + 8 * (fq & 1);
                ncs0 = *(const f32x4*)rp; ncs1 = *(const f32x4*)(rp + 4); nsn0 = *(const f32x4*)(rp + 16); nsn1 = *(const f32x4*)(rp + 20); }
#pragma unroll
            for (int bj = 0; bj < 2; ++bj) {
                f32x4 v0 = acc[ai][bj][m][0], v1 = acc[ai][bj][m][1];
                if (rot) {
                    f32x4 o0, o1;
                    o0.x = __shfl_xor(v0.x, 32); o0.y = __shfl_xor(v0.y, 32); o0.z = __shfl_xor(v0.z, 32); o0.w = __shfl_xor(v0.w, 32);
                    o1.x = __shfl_xor(v1.x, 32); o1.y = __shfl_xor(v1.y, 32); o1.z = __shfl_xor(v1.z, 32); o1.w = __shfl_xor(v1.w, 32);
                    v0 = v0 * cs0 + sgn * o0 * sn0; v1 = v1 * cs1 + sgn * o1 * sn1;
                }
                u32x4 w; w.x = cvt_pk(v0[0], v0[1]); w.y = cvt_pk(v0[2], v0[3]); w.z = cvt_pk(v1[0], v1[1]); w.w = cvt_pk(v1[2], v1[3]);
                *(u32x4*)(base + ((size_t)(hh0 + bj) * S + row) * 128) = w;
            }
            cs0 = ncs0; cs1 = ncs1; sn0 = nsn0; sn1 = nsn1;
        }
    }
};
struct EpiSV {
    static constexpr bool PERM = true, AFTER_DRAIN = false;
    bf16_t* qkv; bf16_t* qkv2;
    __device__ __forceinline__ void operator()(const pg8::f32x4 (&acc)[2][2][4][2], const pg8::Unit& u, int wr, int wc, int fr, int fq) const {
        const bool dil = (u.pn >> 3) != 0; const int T = dil ? 5 : 2;
        const int hh0 = 2 * (u.pn & 7), d0 = wc * 32 + 8 * fq, rowb = u.pm * 256 + wr * 64 + fr;
        bf16_t* base = qkv + (size_t)T * QKV_T + d0;
#pragma unroll
        for (int gi = 0; gi < 8; ++gi) { const int ai = gi >> 2, m = gi & 3, row = rowb + ai * 128 + m * 16;
#pragma unroll
            for (int bj = 0; bj < 2; ++bj) {
                const f32x4 v0 = acc[ai][bj][m][0] * (1.0f / 16384.0f), v1 = acc[ai][bj][m][1] * (1.0f / 16384.0f);
                u32x4 w; w.x = cvt_pk(v0[0], v0[1]); w.y = cvt_pk(v0[2], v0[3]); w.z = cvt_pk(v1[0], v1[1]); w.w = cvt_pk(v1[2], v1[3]);
                *(u32x4*)(base + ((size_t)(hh0 + bj) * S + row) * 128) = w;
            } }
    }
};
struct EpiResid {
    static constexpr bool PERM = true, AFTER_DRAIN = false;
    const float* x; const float* gate; bf16_t* out;
    __device__ __forceinline__ void operator()(const pg8::f32x4 (&acc)[2][2][4][2], const pg8::Unit& u, int wr, int wc, int fr, int fq) const {
        const int row0 = u.pm * 256 + wr * 64 + fr, col0 = u.pn * 256 + wc * 32 + 8 * fq;
        f32x4 gv[2][2];
#pragma unroll
        for (int bj = 0; bj < 2; ++bj)
#pragma unroll
            for (int n = 0; n < 2; ++n) gv[bj][n] = *(const f32x4*)(gate + col0 + bj * 128 + n * 4) * (1.0f / 16384.0f);
        f32x4 xq[2][2][2];
#define ER_LOAD(slot, gi_) do { const size_t o_ = (size_t)(row0 + ((gi_) >> 2) * 128 + ((gi_) & 3) * 16) * DM + col0; \
            _Pragma("unroll") for (int bj = 0; bj < 2; ++bj) { xq[slot][bj][0] = *(const f32x4*)(x + o_ + bj * 128); xq[slot][bj][1] = *(const f32x4*)(x + o_ + bj * 128 + 4); } } while (0)
        ER_LOAD(0, 0); ER_LOAD(1, 1);
#pragma unroll
        for (int gi = 0; gi < 8; ++gi) { const int ai = gi >> 2, m = gi & 3;
            const size_t off = (size_t)(row0 + ai * 128 + m * 16) * DM + col0;
            f32x4 xc[2][2];
#pragma unroll
            for (int bj = 0; bj < 2; ++bj) { xc[bj][0] = xq[gi % 2][bj][0]; xc[bj][1] = xq[gi % 2][bj][1]; }
            if (gi + 2 < 8) ER_LOAD(gi % 2, gi + 2);
#pragma unroll
            for (int bj = 0; bj < 2; ++bj) {
#ifdef DBG_NO_MIXER
                const f32x4 r0 = xc[bj][0], r1 = xc[bj][1];
#else
                const f32x4 r0 = xc[bj][0] + gv[bj][0] * acc[ai][bj][m][0], r1 = xc[bj][1] + gv[bj][1] * acc[ai][bj][m][1];
#endif
                u32x4 w; w.x = cvt_pk(r0[0], r0[1]); w.y = cvt_pk(r0[2], r0[3]); w.z = cvt_pk(r1[0], r1[1]); w.w = cvt_pk(r1[2], r1[3]);
                *(u32x4*)(out + off + bj * 128) = w;
            }
            __builtin_amdgcn_sched_barrier(0);
        }
#undef ER_LOAD
    }
};

struct AttIt { int kind, L, pass; };
__device__ __forceinline__ at::BlockRef att_ref(const AttIt& it, unsigned char* ws, bool remap) {
    const bf16_t* qkv = (const bf16_t*)(ws + WS_QKV);
    at::BlockRef r;
    if (it.kind == 0) {
        const int b_ = it.L & 255, L_ = remap ? ((((it.L >> 8) * 16 + 2 * (b_ & 7) + (b_ >> 7)) << 4) + ((b_ >> 3) & 15)) : it.L;
        const int vp = L_ >> 4, x = L_ & 15, qb = it.pass ? 31 - x : x;
        const int h = vp >> 2, s = (vp >> 1) & 1, hf = vp & 1;
        const size_t hq = (size_t)(2 * h + s) * S * 128, hv = (size_t)(2 * h + hf) * S * 128;
        r.Q = qkv + 0 * QKV_T + hq + (size_t)qb * 256 * 128; r.K = qkv + 1 * QKV_T + hq; r.V = qkv + 2 * QKV_T + hv;
        r.O = (bf16_t*)(ws + WS_OD) + ((size_t)vp * S + (size_t)qb * 256) * 128; r.L = nullptr;
        r.P0 = qb * 256; r.W = S; r.skv = S; r.rs = 128;
    } else {
        const int b_ = it.L & 255, L_ = remap ? ((((b_ & 7) * 6 + (it.L >> 8)) << 5) + (b_ >> 3)) : it.L;
        const int g = L_ >> 9, rem = L_ & 511, h = rem >> 5, blk = rem & 31;
        const int dil = (g == 0) ? 1 : (g == 1 ? 4 : 16), bpr = 32 / dil, res = blk / bpr, qb = blk % bpr;
        const bf16_t* tb = qkv + 3 * QKV_T;
        const size_t hb = ((size_t)h * S + (size_t)res * (S / dil)) * 128, hn = ((size_t)h * S + (size_t)res) * 128;
        r.skv = S / dil; r.P0 = qb * 256; r.W = 129; r.rs = 128 * dil;
        r.Q = tb + 0 * QKV_T + hn + (size_t)qb * 256 * 128 * dil; r.K = tb + 1 * QKV_T + hn; r.V = tb + 2 * QKV_T + hn;
        r.O = (bf16_t*)(ws + WS_OS) + ((size_t)(g * 16 + h) * S + (size_t)res * (S / dil) + (size_t)qb * 256) * 128;
        r.L = (float*)(ws + WS_LSE) + (size_t)(g * 16 + h) * S + (size_t)res * (S / dil) + (size_t)qb * 256;
    }
    return r;
}
__device__ __forceinline__ AttIt att_next(const AttIt& it, int G, int bid) {
    AttIt n = it;
    if (it.kind == 0) {
        if (it.pass == 0) { n.pass = 1; return n; }
        n.pass = 0; n.L = it.L + G;
        if (n.L < 512) return n;
        n.kind = 1; n.L = bid; if (n.L >= 1536) n.kind = 2;
        return n;
    }
    n.L = it.L + G; if (n.L >= 1536) n.kind = 2;
    return n;
}
__device__ __forceinline__ void attn_phase(const Args& A, char* lds, int G, int bid) {
    AttIt it; it.kind = 0; it.L = bid; it.pass = 0;
    if (it.L >= 512) { it.kind = 1; it.L = bid; if (it.L >= 1536) it.kind = 2; }
    const bool remap = (G == 256);
    at::Svc sv; sv.tu = A.peer_u; sv.tv = A.peer_v; sv.du = A.ws + WS_UB; sv.dv = A.ws + WS_VB; sv.next = 0; sv.p_old = -1; sv.p_new = -1; sv.par = 0; sv.G = G; sv.bid = bid;
    if (it.kind != 2) {
        at::BlockRef cur = att_ref(it, A.ws, remap);
        at::Seam Sm;
        at::causal_swa_prime(cur, lds, Sm);
        while (it.kind != 2) {
            const AttIt itn = att_next(it, G, bid);
            const at::BlockRef nxt = (itn.kind == 2) ? cur : att_ref(itn, A.ws, remap);
            at::causal_swa_block<false>(cur, nxt, lds, Sm, sv);
            cur = nxt; it = itn;
        }
    }
    while (at::svc_busy(sv)) { asm volatile("s_waitcnt vmcnt(0)" ::: "memory"); at::svc_top(sv, lds); at::svc_dma(sv, lds); }
    asm volatile("s_waitcnt vmcnt(0)" ::: "memory");
}

__device__ __forceinline__ void ld16bf(const bf16_t* p, f32x4 (&o)[4]) { const u32x4 a = *(const u32x4*)p, b = *(const u32x4*)(p + 8);
    o[0] = (f32x4){bf_lo(a.x), bf_hi(a.x), bf_lo(a.y), bf_hi(a.y)}; o[1] = (f32x4){bf_lo(a.z), bf_hi(a.z), bf_lo(a.w), bf_hi(a.w)};
    o[2] = (f32x4){bf_lo(b.x), bf_hi(b.x), bf_lo(b.y), bf_hi(b.y)}; o[3] = (f32x4){bf_lo(b.z), bf_hi(b.z), bf_lo(b.w), bf_hi(b.w)}; }
__device__ __forceinline__ float sq16(const f32x4 (&v)[4]) { float s = 0.f;
#pragma unroll
    for (int i = 0; i < 4; ++i) s += (v[i].x * v[i].x + v[i].y * v[i].y) + (v[i].z * v[i].z + v[i].w * v[i].w);
    return s; }
__device__ __forceinline__ void combine_phase(const Args& A, int gw, int ngw, int lane) {
    unsigned char* ws = A.ws;
    const float lam = *(const float*)(ws + WS_LAM);
    const bf16_t* OD = (const bf16_t*)(ws + WS_OD); const bf16_t* OS = (const bf16_t*)(ws + WS_OS); const float* LSE = (const float*)(ws + WS_LSE);
    unsigned char* Y = (unsigned char*)(ws + WS_Y);
    for (int t = gw; t < S; t += ngw) {
#pragma unroll
        for (int hq = 0; hq < 2; ++hq) {
            const int h = 4 * hq + (lane >> 4), e0 = 16 * (lane & 15), hf = e0 >> 7, d0 = e0 & 127;
            f32x4 a[4], b[4], v[4];
            ld16bf(OD + ((size_t)(h * 4 + 0 + hf) * S + t) * 128 + d0, a); ld16bf(OD + ((size_t)(h * 4 + 2 + hf) * S + t) * 128 + d0, b);
#pragma unroll
            for (int i = 0; i < 4; ++i) v[i] = a[i] - lam * b[i];
            float ss = sq16(v);
            ss += __shfl_xor(ss, 1); ss += __shfl_xor(ss, 2); ss += __shfl_xor(ss, 4); ss += __shfl_xor(ss, 8);
            const float rstd = 16.0f * (1.0f - LAM_INIT) / sqrtf(ss * (1.0f / 256.0f) + NORM_EPS);
            u32x4 w;
            w.x = pk_fp8(v[0] * rstd * *(const f32x4*)(A.diff_subln_g + e0)); w.y = pk_fp8(v[1] * rstd * *(const f32x4*)(A.diff_subln_g + e0 + 4));
            w.z = pk_fp8(v[2] * rstd * *(const f32x4*)(A.diff_subln_g + e0 + 8)); w.w = pk_fp8(v[3] * rstd * *(const f32x4*)(A.diff_subln_g + e0 + 12));
            *(u32x4*)(Y + (size_t)t * DM + h * 256 + e0) = w;
        }
        const int r1 = (t & 3) * (S / 4) + (t >> 2), r2 = (t & 15) * (S / 16) + (t >> 4);
#pragma unroll
        for (int hq = 0; hq < 2; ++hq) {
            const int h = 8 * hq + (lane >> 3), d0 = 16 * (lane & 7);
            const float l0 = LSE[(size_t)(0 * 16 + h) * S + t], l1 = LSE[(size_t)(1 * 16 + h) * S + r1], l2 = LSE[(size_t)(2 * 16 + h) * S + r2];
            const float mx = fmaxf(l0, fmaxf(l1, l2));
            const float e0 = __expf(l0 - mx), e1 = __expf(l1 - mx), e2 = __expf(l2 - mx), inv = 1.0f / (e0 + e1 + e2);
            f32x4 o0[4], o1[4], o2[4], v[4];
            ld16bf(OS + ((size_t)(0 * 16 + h) * S + t) * 128 + d0, o0); ld16bf(OS + ((size_t)(1 * 16 + h) * S + r1) * 128 + d0, o1); ld16bf(OS + ((size_t)(2 * 16 + h) * S + r2) * 128 + d0, o2);
#pragma unroll
            for (int i = 0; i < 4; ++i) v[i] = (e0 * inv) * o0[i] + (e1 * inv) * o1[i] + (e2 * inv) * o2[i];
            float ss = sq16(v);
            ss += __shfl_xor(ss, 1); ss += __shfl_xor(ss, 2); ss += __shfl_xor(ss, 4);
            const float rstd = 16.0f / sqrtf(ss * (1.0f / 128.0f) + NORM_EPS);
            const float* gp = A.dil_out_g + h * 128 + d0;
            u32x4 w;
            w.x = pk_fp8(v[0] * rstd * *(const f32x4*)gp); w.y = pk_fp8(v[1] * rstd * *(const f32x4*)(gp + 4));
            w.z = pk_fp8(v[2] * rstd * *(const f32x4*)(gp + 8)); w.w = pk_fp8(v[3] * rstd * *(const f32x4*)(gp + 12));
            *(u32x4*)(Y + (size_t)t * DM + 2048 + h * 128 + d0) = w;
        }
    }
}

__device__ __forceinline__ unsigned fkey(float f) { const unsigned b = __float_as_uint(f); return b ^ ((b >> 31) ? 0xFFFFFFFFu : 0x80000000u); }
__device__ __forceinline__ int mbcnt64(unsigned long long m) { return (int)__builtin_amdgcn_mbcnt_hi((unsigned)(m >> 32), __builtin_amdgcn_mbcnt_lo((unsigned)m, 0u)); }
template <int NR> __device__ __forceinline__ unsigned kth16_key(const unsigned (&key)[NR]) {
    unsigned T = 0u;
    for (int bit = 31; bit >= 0; --bit) {
        const unsigned cand = T | (1u << bit); int cnt = 0;
#pragma unroll
        for (int r = 0; r < NR; ++r) cnt += __builtin_popcountll(__ballot(key[r] >= cand));
        if (cnt >= 16) T = cand;
    }
    return T;
}
template <int NR> __device__ __forceinline__ void select16(const unsigned (&key)[NR], bool (&sel)[NR], int (&pos)[NR]) {
    const unsigned T = kth16_key<NR>(key);
    int cgt = 0;
#pragma unroll
    for (int r = 0; r < NR; ++r) cgt += __builtin_popcountll(__ballot(key[r] > T));
    const int need = 16 - cgt; int eqb = 0, selb = 0;
#pragma unroll
    for (int r = 0; r < NR; ++r) {
        const bool gt = key[r] > T, eq = key[r] == T;
        const unsigned long long beq = __ballot(eq);
        const bool s = gt || (eq && (eqb + mbcnt64(beq)) < need);
        const unsigned long long bs = __ballot(s);
        sel[r] = s; pos[r] = selb + mbcnt64(bs);
        selb += __builtin_popcountll(bs); eqb += __builtin_popcountll(beq);
    }
}
__device__ __forceinline__ float funkey(unsigned k) { return __uint_as_float((k & 0x80000000u) ? (k ^ 0x80000000u) : ~k); }
__device__ __forceinline__ void ins16(unsigned (&L)[16], unsigned x) {
#pragma unroll
    for (int i = 0; i < 16; ++i) { const unsigned hi = L[i] > x ? L[i] : x, lo = L[i] > x ? x : L[i]; L[i] = hi; x = lo; }
}
__device__ __forceinline__ void topk_phase(const Args& A, LAS unsigned char* lds, int gw, int ngw, int wave, int lane, int nwb = S * 16 / 64) {
    unsigned char* ws = A.ws;
    const float* SC = (const float*)(ws + WS_SC); int* IDX = (int*)(ws + WS_IDX); float* GATE = (float*)(ws + WS_GATE);
    LAS float* scr = (LAS float*)(lds + wave * 8448);
    LAS int* tab = (LAS int*)scr;
    for (int wb = gw; wb < nwb; wb += ngw) {
        const float* base = SC + (size_t)wb * 64 * 128;
        unsigned L[16];
#pragma unroll
        for (int i = 0; i < 16; ++i) L[i] = 0u;
        f32x4 ld[8], ln[8];
        const int lr = lane >> 3, lc = lane & 7;
#pragma unroll
        for (int i = 0; i < 8; ++i) ld[i] = *(const f32x4*)(base + (size_t)(8 * i + lr) * 128 + 4 * lc);
#pragma unroll
        for (int c = 0; c < 4; ++c) {
            if (c < 3) {
#pragma unroll
                for (int i = 0; i < 8; ++i) ln[i] = *(const f32x4*)(base + (size_t)(8 * i + lr) * 128 + 32 * (c + 1) + 4 * lc);
            }
#pragma unroll
            for (int i = 0; i < 8; ++i) { LAS float* d = scr + (8 * i + lr) * 33 + 4 * lc; d[0] = ld[i].x; d[1] = ld[i].y; d[2] = ld[i].z; d[3] = ld[i].w; }
            LDS_WAIT(); __builtin_amdgcn_wave_barrier();
#pragma unroll
            for (int j = 0; j < 32; ++j) { const float v = scr[lane * 33 + j]; ins16(L, (fkey(v) & ~127u) | (unsigned)(127 - (32 * c + j))); }
            LDS_WAIT(); __builtin_amdgcn_wave_barrier();
#pragma unroll
            for (int i = 0; i < 8; ++i) ld[i] = ln[i];
        }
        unsigned M[16];
#pragma unroll
        for (int i = 0; i < 16; ++i) M[i] = (unsigned)__shfl_down((int)L[i], 1);
        float av[16], bv[16];
#pragma unroll
        for (int i = 0; i < 16; ++i) { av[i] = funkey((L[i] & ~127u) | 64u); bv[i] = funkey((M[i] & ~127u) | 64u);
            tab[lane * 33 + i] = 127 - (int)(L[i] & 127u); tab[lane * 33 + 16 + i] = 127 - (int)(M[i] & 127u); }
        unsigned K2[16];
#pragma unroll
        for (int i = 0; i < 16; ++i) K2[i] = 0u;
#pragma unroll
        for (int i = 0; i < 16; ++i)
#pragma unroll
            for (int j = 0; j < 16; ++j)
                if ((i + 1) * (j + 1) <= 16) ins16(K2, (fkey(av[i] + bv[j]) & ~255u) | (unsigned)(255 - (i * 16 + j)));
        LDS_WAIT(); __builtin_amdgcn_wave_barrier();
        float fv[16]; int fe[16]; float sm = 0.f;
        const float mx = funkey((K2[0] & ~255u) | 128u);
#pragma unroll
        for (int q = 0; q < 16; ++q) { const int cid = 255 - (int)(K2[q] & 255u);
            fe[q] = tab[lane * 33 + (cid >> 4)] * 128 + tab[lane * 33 + 16 + (cid & 15)];
            fv[q] = __expf(funkey((K2[q] & ~255u) | 128u) - mx); sm += fv[q]; }
        const float inv = 1.0f / sm;
        if ((lane & 1) == 0) {
            const size_t o = ((size_t)wb * 32 + (lane >> 1)) * 16;
#pragma unroll
            for (int q = 0; q < 4; ++q) {
                *(u32x4*)(IDX + o + 4 * q) = (u32x4){(unsigned)fe[4 * q], (unsigned)fe[4 * q + 1], (unsigned)fe[4 * q + 2], (unsigned)fe[4 * q + 3]};
                *(f32x4*)(GATE + o + 4 * q) = (f32x4){fv[4 * q] * inv, fv[4 * q + 1] * inv, fv[4 * q + 2] * inv, fv[4 * q + 3] * inv};
            }
        }
        LDS_WAIT(); __builtin_amdgcn_wave_barrier();
    }
}

__device__ __forceinline__ float gelu_erf(float x) { return 0.5f * x * (1.0f + erff(x * 0.70710678118654752f)); }
__device__ __forceinline__ f32x2 fp8lo(unsigned w) { return __builtin_amdgcn_cvt_pk_f32_fp8((int)w, false); }
__device__ __forceinline__ f32x2 fp8hi(unsigned w) { return __builtin_amdgcn_cvt_pk_f32_fp8((int)w, true); }
__device__ __forceinline__ float dot16_fp8(const u32x4 w, const f32x2 (&hp)[8]) {
    f32x2 t = fp8lo(w.x) * hp[0];
    t = __builtin_elementwise_fma(fp8hi(w.x), hp[1], t); t = __builtin_elementwise_fma(fp8lo(w.y), hp[2], t); t = __builtin_elementwise_fma(fp8hi(w.y), hp[3], t);
    t = __builtin_elementwise_fma(fp8lo(w.z), hp[4], t); t = __builtin_elementwise_fma(fp8hi(w.z), hp[5], t); t = __builtin_elementwise_fma(fp8lo(w.w), hp[6], t);
    t = __builtin_elementwise_fma(fp8hi(w.w), hp[7], t);
    return t.x + t.y;
}
__device__ __forceinline__ float d2cv(unsigned w, bool hi, unsigned hpair, float acc) {
    return __builtin_amdgcn_fdot2_f32_bf16(hi ? __builtin_amdgcn_cvt_scalef32_pk_bf16_fp8(w, 1.0f, true) : __builtin_amdgcn_cvt_scalef32_pk_bf16_fp8(w, 1.0f, false), __builtin_bit_cast(bf16v2, hpair), acc, false); }
__device__ __forceinline__ float dot16_fp8_bf(const u32x4 w, const u32x4 h0, const u32x4 h1, float acc) {
    acc = d2cv(w.x, false, h0.x, acc); acc = d2cv(w.x, true, h0.y, acc); acc = d2cv(w.y, false, h0.z, acc); acc = d2cv(w.y, true, h0.w, acc);
    acc = d2cv(w.z, false, h1.x, acc); acc = d2cv(w.z, true, h1.y, acc); acc = d2cv(w.w, false, h1.z, acc); return d2cv(w.w, true, h1.w, acc);
}
__device__ __forceinline__ void axpy16_fp8(const u32x4 w, const float a, f32x2 (&o)[8]) {
    const f32x2 av = {a, a};
    o[0] = __builtin_elementwise_fma(fp8lo(w.x), av, o[0]); o[1] = __builtin_elementwise_fma(fp8hi(w.x), av, o[1]);
    o[2] = __builtin_elementwise_fma(fp8lo(w.y), av, o[2]); o[3] = __builtin_elementwise_fma(fp8hi(w.y), av, o[3]);
    o[4] = __builtin_elementwise_fma(fp8lo(w.z), av, o[4]); o[5] = __builtin_elementwise_fma(fp8hi(w.z), av, o[5]);
    o[6] = __builtin_elementwise_fma(fp8lo(w.w), av, o[6]); o[7] = __builtin_elementwise_fma(fp8hi(w.w), av, o[7]);
}
__device__ __forceinline__ void peer_phase(const Args& A, LAS unsigned char* lds, int G, int bid, int tid) {
    unsigned char* ws = A.ws;
    const bf16_t* H2 = (const bf16_t*)(ws + WS_H2);
    const int* IDX = (const int*)(ws + WS_IDX); const float* GATE = (const float*)(ws + WS_GATE);
    bf16_t* X1 = (bf16_t*)(ws + WS_X1); const float* g2 = (const float*)(ws + WS_MOD) + 5 * DM;
    const int grp = tid >> 3, sub = tid & 7, tok = grp >> 1, eh = grp & 1;
    const int srot = 4 * (int)(xb_xcc_id() & 7u);
    const unsigned so = (unsigned)sub * 16u;
    LAS int* lidx = (LAS int*)lds; LAS float* lact = (LAS float*)(lds + 16384); LAS float* lrs = (LAS float*)(lds + 32768);
    const LAS int* myidx = lidx + tok * 128 + eh * 64; const LAS float* myact = lact + tok * 128 + eh * 64;
    for (int tt = bid; tt < S / 32; tt += G) {
        const int t0 = tt * 32;
        topk_phase(A, lds + 40960, tt * 8 + (tid >> 6), 1 << 30, tid >> 6, tid & 63, tt * 8 + (tid >> 6) + 1);
        asm volatile("s_waitcnt vmcnt(0)" ::: "memory"); __syncthreads();
        for (int i = tid; i < 1024; i += 512) ((LAS u32x4*)lidx)[i] = ((const u32x4*)(IDX + (size_t)t0 * 128))[i];
        __syncthreads();
        float acc[64];
#pragma unroll
        for (int j = 0; j < 64; ++j) acc[j] = 0.f;
        for (int si = 0; si < 32; ++si) {
            const int s = (si + srot) & 31;
            const u32x4 h0 = *(const u32x4*)(H2 + (size_t)(t0 + tok) * DM + s * 128 + sub * 16), h1 = *(const u32x4*)(H2 + (size_t)(t0 + tok) * DM + s * 128 + sub * 16 + 8);
            const char* ub = (const char*)(ws + WS_UB) + (size_t)s * ((size_t)NEXP * 128);
#pragma unroll
            for (int eb = 0; eb < 64; eb += 16) {
                u32x4 id4[4];
#pragma unroll
                for (int k = 0; k < 4; ++k) id4[k] = *(const LAS u32x4*)(myidx + eb + 4 * k);
                u32x4 uv[16];
#pragma unroll
                for (int k = 0; k < 4; ++k) { uv[4 * k + 0] = *(const u32x4*)(ub + (id4[k].x * 128u + so)); uv[4 * k + 1] = *(const u32x4*)(ub + (id4[k].y * 128u + so));
                                              uv[4 * k + 2] = *(const u32x4*)(ub + (id4[k].z * 128u + so)); uv[4 * k + 3] = *(const u32x4*)(ub + (id4[k].w * 128u + so)); }
#pragma unroll
                for (int i = 0; i < 16; ++i) acc[eb + i] = dot16_fp8_bf(uv[i], h0, h1, acc[eb + i]);
                asm volatile("" ::: "memory");
            }
        }
        {
            float g8[8];
#pragma unroll
            for (int k = 0; k < 8; ++k) g8[k] = GATE[(size_t)(t0 + tok) * 128 + eh * 64 + 8 * k + sub];
            const bool b4 = (sub & 4) != 0, b2 = (sub & 2) != 0, b1 = (sub & 1) != 0;
            float a32[32], a16[16], a8[8];
#pragma unroll
            for (int p = 0; p < 32; ++p) { const int jl = (p >> 2) * 8 + (p & 3), jh = jl + 4;
                float x0 = acc[jl], x1 = acc[jh]; asm volatile("" : "+v"(x0), "+v"(x1));
                const float keep = b4 ? x1 : x0, send = b4 ? x0 : x1; a32[p] = keep + __shfl_xor(send, 4); }
#pragma unroll
            for (int p = 0; p < 16; ++p) { const int il = (p >> 1) * 4 + (p & 1), ih = il + 2;
                float x0 = a32[il], x1 = a32[ih]; asm volatile("" : "+v"(x0), "+v"(x1));
                const float keep = b2 ? x1 : x0, send = b2 ? x0 : x1; a16[p] = keep + __shfl_xor(send, 2); }
#pragma unroll
            for (int k = 0; k < 8; ++k) { float x0 = a16[2 * k], x1 = a16[2 * k + 1]; asm volatile("" : "+v"(x0), "+v"(x1));
                const float keep = b1 ? x1 : x0, send = b1 ? x0 : x1; a8[k] = keep + __shfl_xor(send, 1); }
#pragma unroll
            for (int k = 0; k < 8; ++k) lact[tok * 128 + eh * 64 + 8 * k + sub] = g8[k] * gelu_erf(a8[k] * (1.0f / 256.0f));
        }
        __syncthreads();
        float ssq = 0.f;
        for (int si = 0; si < 32; ++si) {
            const int s = (si + srot) & 31;
            const char* vb = (const char*)(ws + WS_VB) + (size_t)s * ((size_t)NEXP * 128);
            f32x2 o[8];
#pragma unroll
            for (int i = 0; i < 8; ++i) o[i] = (f32x2){0.f, 0.f};
#pragma unroll
            for (int eb = 0; eb < 64; eb += 16) {
                u32x4 id4[4]; f32x4 a4[4];
#pragma unroll
                for (int k = 0; k < 4; ++k) { id4[k] = *(const LAS u32x4*)(myidx + eb + 4 * k); a4[k] = *(const LAS f32x4*)(myact + eb + 4 * k); }
                u32x4 vv[16];
#pragma unroll
                for (int k = 0; k < 4; ++k) { vv[4 * k + 0] = *(const u32x4*)(vb + (id4[k].x * 128u + so)); vv[4 * k + 1] = *(const u32x4*)(vb + (id4[k].y * 128u + so));
                                              vv[4 * k + 2] = *(const u32x4*)(vb + (id4[k].z * 128u + so)); vv[4 * k + 3] = *(const u32x4*)(vb + (id4[k].w * 128u + so)); }
#pragma unroll
                for (int k = 0; k < 4; ++k) { axpy16_fp8(vv[4 * k + 0], a4[k].x, o); axpy16_fp8(vv[4 * k + 1], a4[k].y, o); axpy16_fp8(vv[4 * k + 2], a4[k].z, o); axpy16_fp8(vv[4 * k + 3], a4[k].w, o); }
                asm volatile("" ::: "memory");
            }
#pragma unroll
            for (int i = 0; i < 8; ++i) { o[i].x += __shfl_xor(o[i].x, 8); o[i].y += __shfl_xor(o[i].y, 8); }
            if (eh == 0) {
                const size_t off = (size_t)(t0 + tok) * DM + s * 128 + sub * 16;
#pragma unroll
                for (int q = 0; q < 4; ++q) {
                    const f32x4 xv = ld4bf(X1 + off + 4 * q); const f32x4 gv = *(const f32x4*)(g2 + s * 128 + sub * 16 + 4 * q) * (1.0f / 16.0f);
                    f32x4 r; r.x = xv.x + gv.x * o[2 * q].x; r.y = xv.y + gv.y * o[2 * q].y; r.z = xv.z + gv.z * o[2 * q + 1].x; r.w = xv.w + gv.w * o[2 * q + 1].y;
                    ssq += (r.x * r.x + r.y * r.y) + (r.z * r.z + r.w * r.w);
                    u32x2 w; w.x = cvt_pk(r.x, r.y); w.y = cvt_pk(r.z, r.w); *(u32x2*)(X1 + off + 4 * q) = w;
                }
            }
        }
        ssq += __shfl_xor(ssq, 1); ssq += __shfl_xor(ssq, 2); ssq += __shfl_xor(ssq, 4);
        if (eh == 0 && sub == 0) lrs[tok] = 1.0f / sqrtf(ssq * (1.0f / DM) + NORM_EPS);
        __syncthreads();
        for (int i0 = tid; i0 < 32 * 1024; i0 += 512 * 8) {
            u32x2 pv[8];
#pragma unroll
            for (int k = 0; k < 8; ++k) { const int i = i0 + 512 * k, tn = i >> 10, c4 = i & 1023; pv[k] = *((const u32x2*)(X1 + (size_t)(t0 + tn) * DM) + c4); }
#pragma unroll
            for (int k = 0; k < 8; ++k) { const int i = i0 + 512 * k, tn = i >> 10, c4 = i & 1023;
                const f32x4 xv = (f32x4){bf_lo(pv[k].x), bf_hi(pv[k].x), bf_lo(pv[k].y), bf_hi(pv[k].y)};
                *((f32x4*)(A.out + (size_t)(t0 + tn) * DM) + c4) = xv * lrs[tn] * ((const f32x4*)A.final_g)[c4]; }
        }
        __syncthreads();
    }
}

#ifdef DBG_CHECK
__device__ __forceinline__ void dbg_flag(unsigned char* ws, int bit) { atomicOr((unsigned*)(ws + WS_CTL + 65536), 1u << bit); }
__device__ __forceinline__ void dbg_phase(const Args& A, LAS unsigned char* lds, int bid, int tid) {
    unsigned char* ws = A.ws;
    const int lane = tid & 63, wave = __builtin_amdgcn_readfirstlane(tid >> 6);
    const bf16_t* H2 = (const bf16_t*)(ws + WS_H2); const float* SC = (const float*)(ws + WS_SC);
    const int* IDX = (const int*)(ws + WS_IDX); const float* GATE = (const float*)(ws + WS_GATE);
    const float* X1 = (const float*)(ws + WS_X1); const float* mod = (const float*)(ws + WS_MOD);
    if (wave != 0) return;
    if (bid < 4) {
        const int t = bid == 0 ? 5 : (bid == 1 ? 1234 : (bid == 2 ? 4097 : 8191)), g = (3 * bid + 5) & 15;
        LAS float* q = (LAS float*)lds;
        float q0 = 0.f, q1 = 0.f;
        for (int d = 0; d < DM; ++d) { const float hv = __uint_as_float(((unsigned)H2[(size_t)t * DM + d]) << 16);
            q0 += hv * A.peer_wq[(size_t)d * 2048 + g * 128 + lane]; q1 += hv * A.peer_wq[(size_t)d * 2048 + g * 128 + 64 + lane]; }
        q[lane] = q0; q[lane + 64] = q1; LDS_WAIT(); __builtin_amdgcn_wave_barrier();
        bool bad = false;
        for (int r = 0; r < 2; ++r) { const int n = lane + 64 * r; float s = 0.f;
            for (int k = 0; k < 128; ++k) s += q[k] * A.peer_subkeys[(size_t)g * 16384 + n * 128 + k];
            const float got = SC[(size_t)t * 2048 + g * 128 + n];
            if (!(fabsf(got - s) <= 0.03f * fabsf(s) + 0.03f)) bad = true; }
        if (__any(bad) && lane == 0) dbg_flag(ws, 0);
    } else if (bid < 8) {
        const int b = bid - 4, t = b == 0 ? 5 : (b == 1 ? 1234 : (b == 2 ? 4097 : 8191)), h = (2 * b + 1) & 7;
        LAS float* sv = (LAS float*)lds;
        LAS int* si = (LAS int*)(lds + 2048);
        LAS float* fv = (LAS float*)(lds + 4096);
        for (int i = lane; i < 256; i += 64) sv[i] = SC[(size_t)t * 2048 + h * 256 + i];
        LDS_WAIT(); __builtin_amdgcn_wave_barrier();
        if (lane == 0) {
            for (int p = 0; p < 2; ++p) for (int k = 0; k < 16; ++k) { float best = -3e38f; int bi = 0;
                for (int n = 0; n < 128; ++n) { const float x = sv[p * 128 + n]; if (x > best) { best = x; bi = n; } }
                sv[256 + p * 16 + k] = best; si[p * 16 + k] = bi; sv[p * 128 + bi] = -3e38f; }
            for (int a = 0; a < 16; ++a) for (int c = 0; c < 16; ++c) fv[16 + a * 16 + c] = sv[256 + a] + sv[272 + c];
            float mx = -3e38f;
            for (int k = 0; k < 16; ++k) { float best = -3e38f; int bi = 0;
                for (int c = 0; c < 256; ++c) { const float x = fv[16 + c]; if (x > best) { best = x; bi = c; } }
                fv[k] = best; si[32 + k] = si[bi >> 4] * 128 + si[16 + (bi & 15)]; fv[16 + bi] = -3e38f; if (best > mx) mx = best; }
            float sm = 0.f; for (int k = 0; k < 16; ++k) sm += __expf(fv[k] - mx);
            bool bad = false;
            for (int k = 0; k < 16; ++k) { const float gk = __expf(fv[k] - mx) / sm; bool found = false;
                for (int j = 0; j < 16; ++j) if (IDX[(size_t)t * 128 + h * 16 + j] == si[32 + k]) { found = true; if (fabsf(GATE[(size_t)t * 128 + h * 16 + j] - gk) > 2e-3f) bad = true; }
                if (!found && gk > 0.02f) bad = true; }
            if (bad) dbg_flag(ws, 1);
        }
    } else if (bid < 12) {
        const int b = bid - 8, t = b == 0 ? 5 : (b == 1 ? 1234 : (b == 2 ? 4097 : 8191));
        LAS float* av = (LAS float*)lds;
        for (int j = 0; j < 128; ++j) { const int e = IDX[(size_t)t * 128 + j]; float s = 0.f;
            for (int d = lane; d < DM; d += 64) s += __uint_as_float(((unsigned)H2[(size_t)t * DM + d]) << 16) * A.peer_u[(size_t)e * DM + d];
            s = wave_sum(s); if (lane == 0) av[j] = GATE[(size_t)t * 128 + j] * gelu_erf(s); }
        LDS_WAIT(); __builtin_amdgcn_wave_barrier();
        float ss = 0.f;
        for (int d = lane; d < DM; d += 64) { float o = 0.f;
            for (int j = 0; j < 128; ++j) o += av[j] * A.peer_v[(size_t)IDX[(size_t)t * 128 + j] * DM + d];
            const float x2 = X1[(size_t)t * DM + d] + mod[5 * DM + d] * o; ss += x2 * x2; }
        ss = wave_sum(ss); const float rstd = 1.0f / sqrtf(ss / DM + NORM_EPS);
        bool bad = false;
        for (int d = lane; d < DM; d += 64) { float o = 0.f;
            for (int j = 0; j < 128; ++j) o += av[j] * A.peer_v[(size_t)IDX[(size_t)t * 128 + j] * DM + d];
            const float ref = (X1[(size_t)t * DM + d] + mod[5 * DM + d] * o) * rstd * A.final_g[d];
            if (!(fabsf(A.out[(size_t)t * DM + d] - ref) <= 0.02f * fabsf(ref) + 0.02f)) bad = true; }
        if (__any(bad) && lane == 0) dbg_flag(ws, 2);
    } else if (bid < 16) {
        const int b = bid - 12, t = b == 0 ? 5 : (b == 1 ? 1234 : (b == 2 ? 4097 : 8191));
        float ss = 0.f; for (int d = lane; d < DM; d += 64) { const float x = X1[(size_t)t * DM + d]; ss += x * x; }
        ss = wave_sum(ss); const float rstd = 1.0f / sqrtf(ss / DM + NORM_EPS); bool bad = false;
        for (int d = lane; d < DM; d += 64) { const float ref = X1[(size_t)t * DM + d] * rstd * A.norm2_g[d] * (1.0f + mod[4 * DM + d]) + mod[3 * DM + d];
            const float got = __uint_as_float(((unsigned)H2[(size_t)t * DM + d]) << 16);
            if (!(fabsf(got - ref) <= 0.01f * fabsf(ref) + 0.01f)) bad = true; }
        if (__any(bad) && lane == 0) dbg_flag(ws, 3);
    } else if (bid < 20) {
        const int b = bid - 16; bool bad = false;
        for (int r = 0; r < 6; ++r) { const int n = r * DM + 37 * lane + 500 * b; float s = 0.f;
            for (int k = 0; k < DM; ++k) { const float cv = A.c[k]; s += cv / (1.0f + __expf(-cv)) * A.w_ada[(size_t)k * NADA + n]; }
            s += A.b_ada[n]; if (!(fabsf(mod[n] - s) <= 1e-3f * fabsf(s) + 1e-3f)) bad = true; }
        if (__any(bad) && lane == 0) dbg_flag(ws, 4);
    } else if (bid < 24) {
        const int b = bid - 20, g = (5 * b + 2) & 15, n = 17 * b + 3; bool bad = false;
        const bf16_t* wsc = (const bf16_t*)(ws + WS_WSC);
        for (int d = lane; d < DM; d += 64) { float s = 0.f;
            for (int k = 0; k < 128; ++k) s += A.peer_subkeys[(size_t)g * 16384 + n * 128 + k] * A.peer_wq[(size_t)d * 2048 + g * 128 + k];
            const float got = __uint_as_float(((unsigned)wsc[(size_t)(g * 128 + n) * DM + d]) << 16);
            if (!(fabsf(got - s) <= 0.01f * fabsf(s) + 2e-4f)) bad = true; }
        if (__any(bad) && lane == 0) dbg_flag(ws, 5);
    }
}
__device__ __forceinline__ void dbg_emit(const Args& A, int bid, int tid, int G) {
    const unsigned mask = *(const unsigned*)(A.ws + WS_CTL + 65536);
    const float cval = sqrtf((float)mask + 1.0f);
    for (size_t i = (size_t)bid * 512 + tid; i < (size_t)S * DM; i += (size_t)G * 512) A.out[i] = cval;
}
#endif
__global__ void __launch_bounds__(512, 2) hymba_fwd(Args A) {
    extern __shared__ __attribute__((aligned(16))) unsigned char lds_raw[];
    LAS unsigned char* lds = (LAS unsigned char*)lds_raw;
    const int tid = threadIdx.x, lane = tid & 63, wave = __builtin_amdgcn_readfirstlane(tid >> 6);
    const int G = gridDim.x, bid = blockIdx.x;
    const int gw = bid * 8 + wave, ngw = G * 8;
    unsigned char* ws = A.ws;
    for (int u = tid; u < (LDS_BYTES - RING_BYTES) / 4; u += 512) ((LAS unsigned*)(lds + RING_BYTES))[u] = 0u;
    __syncthreads();
    XcdBarrier bar; bar.bar = (unsigned*)(ws + WS_CTL) + CW_BAR; bar.x = 0; bar.st = nullptr;
    if (MK_N_LAUNCHES == 1) bar = xcd_barrier_post((unsigned*)(ws + WS_CTL) + CW_BAR, (volatile LAS unsigned*)(lds + MISC_OFF + 32));
    const int lo = A.ph_lo, hi = A.ph_hi;
#ifndef PH_MASK
#define PH_MASK 0xfff
#endif
#define IN(k) (((PH_MASK >> (k)) & 1) && lo <= (k) && (k) < hi)
#define REP(k) (((REP_MASK >> (k)) & 1) ? 2 : 1)
#ifdef DBG_TIME
#define SEAM(k) do { if (IN(k) && IN((k) + 1)) xcd_barrier(bar); if (bid == 0 && tid == 0) ((unsigned long long*)(ws + WS_CTL + 32768))[(k) + 1] = __builtin_amdgcn_s_memrealtime(); } while (0)
#else
#define SEAM(k) do { if (IN(k) && IN((k) + 1)) xcd_barrier(bar); } while (0)
#endif
    float* mod = (float*)(ws + WS_MOD);
#ifdef DBG_TIME
    if (bid == 0 && tid == 0) ((unsigned long long*)(ws + WS_CTL + 32768))[0] = __builtin_amdgcn_s_memrealtime();
#endif

    if (IN(0)) for (int rep_ = 0; rep_ < REP(0); ++rep_) { p0_prologue(A, lds, G, bid, tid); }
    SEAM(0);
    if (IN(1)) for (int rep_ = 0; rep_ < REP(1); ++rep_) { row_modulate<false, true>(A.x, A.norm1_g, mod + 0 * DM, mod + 1 * DM, (bf16_t*)(ws + WS_H1), ws + WS_H1F8, (LAS float*)lds, tid, gw, ngw, lane); }
    SEAM(1);
    if (IN(2)) for (int rep_ = 0; rep_ < REP(2); ++rep_) {
        {
            pg8::Gemm g{(const bf16_t*)(ws + WS_H1), (const bf16_t*)(ws + WS_WIN), S, 8192, DM}; pg8::StaticOrder So; So.init(S, 8192, G, bid);
            EpiQKV E{(bf16_t*)(ws + WS_QKV), (bf16_t*)(ws + WS_QKV2), (const float*)(ws + WS_ROPE), 0};
            pg8::gemm_phase<EpiQKV, pg8::StaticOrder, false>(lds, g, So, E, nullptr);
        }
        __syncthreads();
        {
            pg8::Gemm g{(const bf16_t*)(ws + WS_H1F8), (const bf16_t*)(ws + WS_WIN + WIN8_OFF), S, 4096, DM / 2}; pg8::StaticOrder So; So.init(S, 4096, G, bid);
            EpiSV E{(bf16_t*)(ws + WS_QKV), (bf16_t*)(ws + WS_QKV2)};
            pg8::gemm_phase<EpiSV, pg8::StaticOrder, false, true>(lds, g, So, E, nullptr);
        }
    }
    SEAM(2);
    if (IN(3)) for (int rep_ = 0; rep_ < REP(3); ++rep_) { attn_phase(A, (char*)lds_raw, G, bid); }
    SEAM(3);
    if (IN(4)) for (int rep_ = 0; rep_ < REP(4); ++rep_) { combine_phase(A, gw, ngw, lane); }
    SEAM(4);
    if (IN(5)) for (int rep_ = 0; rep_ < REP(5); ++rep_) {
        pg8::Gemm g{(const bf16_t*)(ws + WS_Y), (const bf16_t*)(ws + WS_WOUT), S, DM, DM / 2}; pg8::StaticOrder So; So.init(S, DM, G, bid);
        EpiResid E{A.x, mod + 2 * DM, (bf16_t*)(ws + WS_X1)};
        pg8::gemm_phase<EpiResid, pg8::StaticOrder, false, true>(lds, g, So, E, nullptr);
    }
    SEAM(5);
    if (IN(6)) for (int rep_ = 0; rep_ < REP(6); ++rep_) { row_modulate<true, false>(ws + WS_X1, A.norm2_g, mod + 3 * DM, mod + 4 * DM, (bf16_t*)(ws + WS_H2), nullptr, (LAS float*)lds, tid, gw, ngw, lane); }
    SEAM(6);
    if (IN(7)) for (int rep_ = 0; rep_ < REP(7); ++rep_) {
        pg8::Gemm g{(const bf16_t*)(ws + WS_H2), (const bf16_t*)(ws + WS_WSC), S, 2048, DM}; pg8::StaticOrder So; So.init(S, 2048, G, bid);
#ifdef PROBE_FLAGS
        if (A.flag & 2) g.K = DM / 2;
        if (A.flag & 4) g.K = 256;
#endif
        pg8::EpiF32 E{(float*)(ws + WS_SC), 2048, nullptr};
        pg8::gemm_phase<pg8::EpiF32, pg8::StaticOrder, false>(lds, g, So, E, nullptr);
    }
    SEAM(7);
    if (IN(9)) for (int rep_ = 0; rep_ < REP(9); ++rep_) { peer_phase(A, lds, G, bid, tid); }
#ifdef DBG_TIME
    xcd_barrier(bar);
    if (bid == 0 && tid == 0) ((unsigned long long*)(ws + WS_CTL + 32768))[10] = __builtin_amdgcn_s_memrealtime();
    xcd_barrier(bar);
    {
        const unsigned long long* ts = (const unsigned long long*)(ws + WS_CTL + 32768);
        const float d1 = (float)(ts[DBG_T1 + 1] - ts[DBG_T1]) * 0.01f, d2 = (float)(ts[DBG_T2 + 1] - ts[DBG_T2]) * 0.01f;
        const float cval = sqrtf(fmaxf(d1 * 0.1f, 0.f));
        for (size_t i = (size_t)bid * 512 + tid; i < (size_t)S * DM; i += (size_t)G * 512) A.out[i] = (i == 0) ? 10.0f * d2 : cval;
    }
#endif
#undef IN
#undef SEAM
}

#ifdef DBG_CHECK
__global__ void __launch_bounds__(512) dbg_kernel(Args A, int which) {
    __shared__ __attribute__((aligned(16))) unsigned char dl[8192];
    if (which == 0) dbg_phase(A, (LAS unsigned char*)dl, blockIdx.x, threadIdx.x);
    else dbg_emit(A, blockIdx.x, threadIdx.x, gridDim.x);
}
#endif
extern "C" void kernel_launch(void* const* d_in, const int* in_sizes, int n_in, void* d_out, int out_size, void* d_ws, size_t ws_size, hipStream_t stream) {
    static int grid = 0;
    if (grid == 0) {
        if (n_in != 20 || out_size != S * DM || ws_size < WS_END) { fprintf(stderr, "kernel_launch: unexpected shapes (n_in %d out %d ws %zu)\n", n_in, out_size, ws_size); grid = -1; return; }
        int dev = 0, cus = 0, per_cu = 0;
        if (hipGetDevice(&dev) != hipSuccess || hipDeviceGetAttribute(&cus, hipDeviceAttributeMultiprocessorCount, dev) != hipSuccess) { grid = -1; return; }
        if (hipFuncSetAttribute((const void*)hymba_fwd, hipFuncAttributeMaxDynamicSharedMemorySize, LDS_BYTES) != hipSuccess) { fprintf(stderr, "kernel_launch: hipFuncSetAttribute failed\n"); grid = -1; return; }
        if (hipOccupancyMaxActiveBlocksPerMultiprocessor(&per_cu, (const void*)hymba_fwd, 512, LDS_BYTES) != hipSuccess || per_cu < 1) fprintf(stderr, "kernel_launch: occupancy query reports %d\n", per_cu);
        (void)hipGetLastError();
        grid = cus;
    }
    if (grid < 0) return;
    (void)hipMemsetAsync((char*)d_ws + WS_CTL, 0, CTL_ZERO_BYTES, stream);
    Args a{};
    a.x = (const float*)d_in[0]; a.c = (const float*)d_in[1]; a.positions = (const int*)d_in[2]; a.norm1_g = (const float*)d_in[3]; a.norm2_g = (const float*)d_in[4];
    a.w_ada = (const float*)d_in[5]; a.b_ada = (const float*)d_in[6]; a.w_in = (const float*)d_in[7]; a.lam_q1 = (const float*)d_in[8]; a.lam_k1 = (const float*)d_in[9];
    a.lam_q2 = (const float*)d_in[10]; a.lam_k2 = (const float*)d_in[11]; a.diff_subln_g = (const float*)d_in[12]; a.dil_out_g = (const float*)d_in[13];
    a.w_out = (const float*)d_in[14]; a.peer_wq = (const float*)d_in[15]; a.peer_subkeys = (const float*)d_in[16]; a.peer_u = (const float*)d_in[17]; a.peer_v = (const float*)d_in[18];
    a.final_g = (const float*)d_in[19];
    a.out = (float*)d_out; a.ws = (unsigned char*)d_ws;
    if (MK_N_LAUNCHES == 1) { a.ph_lo = 0; a.ph_hi = NPHASE; hipLaunchKernelGGL(hymba_fwd, dim3(grid), dim3(512), LDS_BYTES, stream, a); }
    else { for (int p = 0; p < NPHASE; ++p) { a.ph_lo = p; a.ph_hi = p + 1; const int nr = ((REP_MASK >> p) & 1) ? 2 : 1;
            for (int r = 0; r < nr; ++r) { a.flag = (nr == 2 && r == 0) ? PROBE_FLAG_VAL : 0; hipLaunchKernelGGL(hymba_fwd, dim3(grid), dim3(512), LDS_BYTES, stream, a); } } }
#ifdef DBG_CHECK
    hipLaunchKernelGGL(dbg_kernel, dim3(grid), dim3(512), 0, stream, a, 0);
    hipLaunchKernelGGL(dbg_kernel, dim3(grid), dim3(512), 0, stream, a, 1);
#endif
}
```

```cpp
#include <hip/hip_runtime.h>
#include <cstdint>
#include <cstdio>

#define REP_MASK 0x000
#define PROBE_FLAG_VAL 0
#ifndef MK_N_LAUNCHES
#define MK_N_LAUNCHES 1
#endif
constexpr int NPHASE = 10;

constexpr int S = 8192, DM = 4096, NIN = 12288, NADA = 24576, NEXP = 16384;
constexpr float NORM_EPS = 1e-6f;
constexpr float LAM_INIT = 0.2f;

constexpr size_t MiB = 1u << 20;
constexpr size_t WS_CTL = 0, CTL_ZERO_BYTES = 128 * 1024;
constexpr size_t WS_MOD = 1 * MiB;
constexpr size_t WS_LAM = 1 * MiB + 128 * 1024;
constexpr size_t WS_ROPE = 2 * MiB;
constexpr size_t WS_WIN = 4 * MiB;
constexpr size_t WS_WOUT = 100 * MiB;
constexpr size_t WS_WSC = 132 * MiB;
constexpr size_t WS_UB = 148 * MiB;
constexpr size_t WS_VB = 276 * MiB;
constexpr size_t WS_H1 = 404 * MiB;
constexpr size_t WS_Y = 468 * MiB;
constexpr size_t WS_H2 = 532 * MiB;
constexpr size_t WS_QKV = 596 * MiB;
constexpr size_t QKV_T = (size_t)16 * S * 128;
constexpr size_t WS_OD = 788 * MiB;
constexpr size_t WS_OS = 916 * MiB;
constexpr size_t WS_H1F8 = 1012 * MiB;
constexpr size_t WIN8_OFF = 64 * MiB;
constexpr size_t WS_LSE = 1108 * MiB;
constexpr size_t WS_X1 = 1110 * MiB;
constexpr size_t WS_SC = 1238 * MiB;
constexpr size_t WS_IDX = 1302 * MiB;
constexpr size_t WS_GATE = 1306 * MiB;
constexpr size_t WS_QKV2 = 1310 * MiB;
constexpr size_t WS_END = 1502 * MiB;
constexpr int CW_BAR = 4096;

constexpr int RING_BYTES = 131072;
constexpr int MISC_OFF = RING_BYTES + 320;
constexpr int LDS_BYTES = 147456;

namespace pg8 {
#define PG8_LAS __attribute__((address_space(3)))
typedef unsigned short bf16_t;
typedef short bf16x8 __attribute__((ext_vector_type(8)));
typedef float f32x4 __attribute__((ext_vector_type(4)));
typedef unsigned u32x4 __attribute__((ext_vector_type(4)));
constexpr int BM = 256, BK = 64, HALF = 128, HTB = HALF * BK * 2  , STAGE_BYTES = 8 * HTB, NXCD = 8, WGM = 8;

__host__ __device__ __forceinline__ int lds_byte(int r, int c) { const int st = (r >> 4) * 2 + (c >> 5), rr = r & 15, cc = c & 31, ob = rr * 64 + cc * 2; return st * 1024 + (ob ^ (((ob >> 9) & 1) << 5)); }
__host__ __device__ __forceinline__ void stage_rc(int b, int& R, int& C) { const int st = b / 1024, sb = b % 1024, swz = sb ^ (((sb >> 9) & 1) << 5); R = (st >> 1) * 16 + swz / 64; C = (st & 1) * 32 + (swz % 64) / 2; }
__host__ __device__ __forceinline__ int perm32(int rho) { const int n = rho >> 4, i = rho & 15; return 8 * (i >> 2) + 4 * n + (i & 3); }

struct Unit { int pm, pn; };
struct Gemm { const bf16_t* A; const bf16_t* Bt; int M, N, K; };

struct StaticOrder {
    int nM, nN, nwg, G, c;
    __host__ __device__ void init(int M, int N, int G_, int c_) { nM = M / BM; nN = N / BM; nwg = nM * nN; G = G_; c = c_; }
    __host__ __device__ bool next(int i, Unit& u) const {
        const long L = (long)i * G + c; if (L >= nwg) return false;
        int wgid = (int)L; { const int q = nwg / NXCD, r = nwg % NXCD, xcd = wgid % NXCD, off = wgid / NXCD; wgid = (xcd < r ? xcd * (q + 1) : r * (q + 1) + (xcd - r) * q) + off; }
        const int nig = WGM * nN, gid = wgid / nig, fm = gid * WGM, gsz = (nM - fm) < WGM ? (nM - fm) : WGM;
        u.pm = fm + ((wgid % nig) % gsz); u.pn = (wgid % nig) / gsz; return true;
    }
    __device__ __forceinline__ void a_ready(const Unit&) const {}
    __device__ __forceinline__ void done(const Unit&) const {}
};
struct CountedOrder : StaticOrder {
    const unsigned* ready; unsigned need; unsigned* tmo;
    __device__ __forceinline__ void a_ready(const Unit& u) const {
        if (threadIdx.x < 64) {
            const unsigned long long t0 = __builtin_amdgcn_s_memrealtime(); unsigned polls = 0;
            while ((unsigned)__builtin_amdgcn_readfirstlane(__hip_atomic_load(ready + 64 * u.pm, __ATOMIC_RELAXED, __HIP_MEMORY_SCOPE_AGENT)) < need) {
                if ((++polls & 255u) == 0u && __builtin_amdgcn_readfirstlane(__hip_atomic_load(tmo, __ATOMIC_RELAXED, __HIP_MEMORY_SCOPE_AGENT)) != 0u) break;
                if (__builtin_amdgcn_s_memrealtime() - t0 > 2000000ull) {
                    if (threadIdx.x == 0) { unsigned expect = 0u; __hip_atomic_compare_exchange_strong(tmo + 1, &expect, 0x600u | (unsigned)(u.pm & 0xff), __ATOMIC_RELAXED, __ATOMIC_RELAXED, __HIP_MEMORY_SCOPE_AGENT); __hip_atomic_store(tmo, 1u, __ATOMIC_RELAXED, __HIP_MEMORY_SCOPE_AGENT); }
                    break; }
                __builtin_amdgcn_s_sleep(2); }
            __builtin_amdgcn_fence(__ATOMIC_ACQUIRE, "agent");
            asm volatile("s_waitcnt vmcnt(0)" ::: "memory");
        }
#if !defined(BROKEN_HOOK_NO_BARRIER)
        asm volatile("" ::: "memory"); __builtin_amdgcn_s_barrier(); asm volatile("" ::: "memory");
#endif
    }
};

__device__ __forceinline__ unsigned cvt_pk_bf16(float lo, float hi) { unsigned r; asm volatile("v_cvt_pk_bf16_f32 %0, %1, %2" : "=v"(r) : "v"(lo), "v"(hi)); return r; }
typedef float f32x2 __attribute__((ext_vector_type(2)));
__device__ __forceinline__ f32x2 gelu_pk(f32x2 v) {
    const f32x2 av = __builtin_elementwise_abs(v), d = av * 0.2316418882f + 1.0f;
    f32x2 t; t.x = __builtin_amdgcn_rcpf(d.x); t.y = __builtin_amdgcn_rcpf(d.y);
    f32x2 q = t * 0.5307027145f + (-0.7265760135f); q = q * t + 0.7107068705f; q = q * t + (-0.142248368f); q = q * t + 0.127414796f; q = q * t;
    const f32x2 s = (v * v) * (-0.72134752044f);
    f32x2 e; e.x = __builtin_amdgcn_exp2f(s.x); e.y = __builtin_amdgcn_exp2f(s.y);
    const f32x2 m = v * (q * e), r = v - m;
    f32x2 o; o.x = v.x < 0.f ? m.x : r.x; o.y = v.y < 0.f ? m.y : r.y; return o;
}

struct EpiF32 {
    static constexpr bool PERM = false, AFTER_DRAIN = false;
    float* C; int ldc; const float* bias;
    __device__ __forceinline__ void operator()(const f32x4 (&acc)[2][2][4][2], const Unit& u, int wr, int wc, int fr, int fq) const {
        const int row0 = u.pm * BM + wr * 64 + fr, col0 = u.pn * BM + wc * 32 + 4 * fq;
        f32x4 bv[2][2];
#pragma unroll
        for (int bj = 0; bj < 2; ++bj)
#pragma unroll
            for (int n = 0; n < 2; ++n) bv[bj][n] = bias ? *(const f32x4*)(bias + col0 + bj * HALF + n * 16) : (f32x4){0.f, 0.f, 0.f, 0.f};
#pragma unroll
        for (int ai = 0; ai < 2; ++ai)
#pragma unroll
            for (int m = 0; m < 4; ++m) { float* rowp = C + (size_t)(row0 + ai * HALF + m * 16) * ldc + col0;
#pragma unroll
                for (int bj = 0; bj < 2; ++bj)
#pragma unroll
                    for (int n = 0; n < 2; ++n) *(f32x4*)(rowp + bj * HALF + n * 16) = acc[ai][bj][m][n] + bv[bj][n]; }
    }
};
template <int ACT  > struct EpiBf16 {
    static constexpr bool PERM = true, AFTER_DRAIN = false;
    bf16_t* O; int ldc; const float* bias; int split_cols; size_t split_stride;
    __device__ __forceinline__ void operator()(const f32x4 (&acc)[2][2][4][2], const Unit& u, int wr, int wc, int fr, int fq) const {
        const int row0 = u.pm * BM + wr * 64 + fr; int colt = u.pn * BM; bf16_t* base = O;
        if (split_cols) { const int t = colt / split_cols; base += (size_t)t * split_stride; colt -= t * split_cols; }
        const int col0 = colt + wc * 32 + 8 * fq, bcol0 = u.pn * BM + wc * 32 + 8 * fq;
        f32x4 bv[2][2];
#pragma unroll
        for (int bj = 0; bj < 2; ++bj)
#pragma unroll
            for (int n = 0; n < 2; ++n) bv[bj][n] = bias ? *(const f32x4*)(bias + bcol0 + bj * HALF + 4 * n) : (f32x4){0.f, 0.f, 0.f, 0.f};
#pragma unroll
        for (int ai = 0; ai < 2; ++ai)
#pragma unroll
            for (int m = 0; m < 4; ++m) { bf16_t* rowp = base + (size_t)(row0 + ai * HALF + m * 16) * ldc + col0;
#pragma unroll
                for (int bj = 0; bj < 2; ++bj) { f32x4 v0 = acc[ai][bj][m][0] + bv[bj][0], v1 = acc[ai][bj][m][1] + bv[bj][1];
                    if (ACT == 1) { f32x2 a = gelu_pk((f32x2){v0[0], v0[1]}), b = gelu_pk((f32x2){v0[2], v0[3]}), c = gelu_pk((f32x2){v1[0], v1[1]}), d = gelu_pk((f32x2){v1[2], v1[3]});
                        v0 = (f32x4){a.x, a.y, b.x, b.y}; v1 = (f32x4){c.x, c.y, d.x, d.y}; }
                    if (ACT == 2) {
#pragma unroll
                        for (int j = 0; j < 4; ++j) { v0[j] = 0.5f * v0[j] * (1.0f + erff(v0[j] * 0.70710678f)); v1[j] = 0.5f * v1[j] * (1.0f + erff(v1[j] * 0.70710678f)); } }
                    u32x4 w; w.x = cvt_pk_bf16(v0[0], v0[1]); w.y = cvt_pk_bf16(v0[2], v0[3]); w.z = cvt_pk_bf16(v1[0], v1[1]); w.w = cvt_pk_bf16(v1[2], v1[3]);
                    *(u32x4*)(rowp + bj * HALF) = w; } }
    }
};
template <class Epi, class Sched, bool STAMP = false, bool F8 = false>
__device__ __forceinline__ void gemm_phase(PG8_LAS unsigned char* lds, const Gemm g, const Sched& S, const Epi& E, unsigned long long* stamps) {
    const int tid = threadIdx.x, wid = __builtin_amdgcn_readfirstlane(tid >> 6), lane = tid & 63, wr = wid >> 2, wc = wid & 3, fr = lane & 15, fq = lane >> 4;
    const int K = g.K, nt = K / BK;
    int ts_lo = 0, ts_hi = 0, nts = 0; const unsigned long long rt_entry = STAMP ? (unsigned long long)wall_clock64() : 0ull;
#define PG8_STAMP() do { if (STAMP && wid == 0 && nts < 64) { const unsigned long long _c = (unsigned long long)clock64(); \
        ts_lo = (lane == nts) ? (int)(unsigned)_c : ts_lo; ts_hi = (lane == nts) ? (int)(unsigned)(_c >> 32) : ts_hi; ++nts; } } while (0)
    PG8_STAMP();
    unsigned voffA[2], voffB[2];
#pragma unroll
    for (int i = 0; i < 2; ++i) { int R, C; stage_rc(tid * 16 + i * 8192, R, C); const int Rb = Epi::PERM ? ((R & ~31) + perm32(R & 31)) : R;
        voffA[i] = (unsigned)(R * K + C) * 2u; voffB[i] = (unsigned)(Rb * K + C) * 2u; }
    const size_t kstep = (size_t)(BK * 2);
    const size_t hstep = (size_t)HALF * K * 2;
    const size_t tstep = 2 * hstep;
    const unsigned ldsw = (unsigned)wid * 1024u;
    const int aoff = lds_byte(wr * 64 + fr, fq * 8), boff = lds_byte(wc * 32 + fr, fq * 8);
#define PG8_SA(b, h) (((b) * 2 + (h)) * HTB)
#define PG8_SB(b, h) ((4 + (b) * 2 + (h)) * HTB)
#define PG8_STAGE(bufoff, gbase, voff) do { _Pragma("unroll") for (int _i = 0; _i < 2; ++_i) \
        __builtin_amdgcn_global_load_lds((const unsigned*)((const char*)(gbase) + (voff)[_i]), (PG8_LAS unsigned*)(lds + (bufoff) + ldsw + _i * 8192), 16, 0, 0); } while (0)
typedef int pg8_i32x4 __attribute__((ext_vector_type(4))); typedef int pg8_i32x8 __attribute__((ext_vector_type(8)));
#define PG8_LD8(addr) __builtin_shufflevector(*(const PG8_LAS pg8_i32x4*)(addr), *(const PG8_LAS pg8_i32x4*)((addr) + 1024), 0, 1, 2, 3, 4, 5, 6, 7)
#define PG8_LDA(dst, b, h) do { if constexpr (F8) { _Pragma("unroll") for (int m = 0; m < 4; ++m) dst##8[m] = PG8_LD8(lds + PG8_SA(b, h) + aoff + m * 2048); } \
        else { _Pragma("unroll") for (int m = 0; m < 4; ++m) _Pragma("unroll") for (int k = 0; k < 2; ++k) dst[m][k] = *(const PG8_LAS bf16x8*)(lds + PG8_SA(b, h) + aoff + m * 2048 + k * 1024); } } while (0)
#define PG8_LDB(dst, b, h) do { if constexpr (F8) { _Pragma("unroll") for (int n = 0; n < 2; ++n) dst##8[n] = PG8_LD8(lds + PG8_SB(b, h) + boff + n * 2048); } \
        else { _Pragma("unroll") for (int n = 0; n < 2; ++n) _Pragma("unroll") for (int k = 0; k < 2; ++k) dst[n][k] = *(const PG8_LAS bf16x8*)(lds + PG8_SB(b, h) + boff + n * 2048 + k * 1024); } } while (0)
#define PG8_MMA(ai, bj, At, Bt) do { __builtin_amdgcn_s_setprio(1); _Pragma("unroll") for (int m = 0; m < 4; ++m) _Pragma("unroll") for (int n = 0; n < 2; ++n) { \
        if constexpr (F8) { asm volatile("v_mfma_scale_f32_16x16x128_f8f6f4 %0, %1, %2, %0, %3, %3 op_sel_hi:[0,0,0]" : "+v"(acc[ai][bj][m][n]) : "v"(Bt##8[n]), "v"(At##8[m]), "v"(sc1_)); } \
        else { _Pragma("unroll") for (int k = 0; k < 2; ++k) acc[ai][bj][m][n] = __builtin_amdgcn_mfma_f32_16x16x32_bf16(Bt[n][k], At[m][k], acc[ai][bj][m][n], 0, 0, 0); } } \
        __builtin_amdgcn_s_setprio(0); } while (0)
#define PG8_WAIT_V(n) asm volatile("s_waitcnt vmcnt(" #n ")" ::: "memory")
#define PG8_WAIT_L(n) asm volatile("s_waitcnt lgkmcnt(" #n ")" ::: "memory")
#define PG8_BAR __builtin_amdgcn_s_barrier()
#define PG8_SCHED __builtin_amdgcn_sched_barrier(0)
    Unit cur, nxt; int ui = 0;
    if (!S.next(0, cur)) return;
    f32x4 acc[2][2][4][2];
#pragma unroll
    for (int a = 0; a < 2; ++a)
#pragma unroll
        for (int b = 0; b < 2; ++b)
#pragma unroll
            for (int m = 0; m < 4; ++m)
#pragma unroll
                for (int n = 0; n < 2; ++n) acc[a][b][m][n] = (f32x4){0.f, 0.f, 0.f, 0.f};
    const int sc1_ = 0x7f7f7f7f;
    bf16x8 At[4][2], B0[2][2], B1[2][2]; pg8_i32x8 At8[4], B08[2], B18[2];
    const char* cA = (const char*)g.A + (size_t)cur.pm * tstep; const char* cB = (const char*)g.Bt + (size_t)cur.pn * tstep;
    S.a_ready(cur);
    PG8_STAGE(PG8_SB(0, 0), cB, voffB); PG8_STAGE(PG8_SA(0, 0), cA, voffA); PG8_STAGE(PG8_SB(0, 1), cB + hstep, voffB); PG8_STAGE(PG8_SA(0, 1), cA + hstep, voffA);
    if (wr == 1) PG8_BAR;
    PG8_WAIT_V(4); PG8_BAR;
    PG8_STAGE(PG8_SB(1, 0), cB + kstep, voffB); PG8_STAGE(PG8_SA(1, 0), cA + kstep, voffA); PG8_STAGE(PG8_SB(1, 1), cB + hstep + kstep, voffB);
    PG8_WAIT_V(6); PG8_BAR;
    PG8_STAMP();
    for (;;) {
        const bool has_next = S.next(ui + 1, nxt);
        const char* nA = has_next ? (const char*)g.A + (size_t)nxt.pm * tstep : cA; const char* nB = has_next ? (const char*)g.Bt + (size_t)nxt.pn * tstep : cB;
        for (int t = 0; t < nt; t += 2) {
            const bool last = (t == nt - 2);
            const char* a1 = cA + (size_t)(t + 1) * kstep;
            const char* a2 = last ? nA : cA + (size_t)(t + 2) * kstep; const char* b2 = last ? nB : cB + (size_t)(t + 2) * kstep;
            const char* a3 = a2 + kstep; const char* b3 = b2 + kstep;
            if (last && has_next) S.a_ready(nxt);
            PG8_LDB(B0, 0, 0); PG8_SCHED; PG8_LDA(At, 0, 0); PG8_STAGE(PG8_SA(1, 1), a1 + hstep, voffA);
            PG8_WAIT_L(8); PG8_BAR; PG8_WAIT_L(0); PG8_MMA(0, 0, At, B0); PG8_BAR; PG8_SCHED;
            PG8_LDB(B1, 0, 1); PG8_STAGE(PG8_SB(0, 0), b2, voffB);
            PG8_BAR; PG8_WAIT_L(0); PG8_MMA(0, 1, At, B1); PG8_BAR;
            PG8_LDA(At, 0, 1); PG8_STAGE(PG8_SA(0, 0), a2, voffA);
            PG8_BAR; PG8_WAIT_L(0); PG8_MMA(1, 0, At, B0); PG8_BAR; PG8_SCHED;
            PG8_STAGE(PG8_SB(0, 1), b2 + hstep, voffB);
            PG8_WAIT_V(6); PG8_BAR; PG8_MMA(1, 1, At, B1); PG8_BAR;
            PG8_LDB(B0, 1, 0); PG8_SCHED; PG8_LDA(At, 1, 0); PG8_STAGE(PG8_SA(0, 1), a2 + hstep, voffA);
            PG8_WAIT_L(8); PG8_BAR; PG8_WAIT_L(0); PG8_MMA(0, 0, At, B0); PG8_BAR; PG8_SCHED;
            PG8_LDB(B1, 1, 1); PG8_STAGE(PG8_SB(1, 0), b3, voffB);
            PG8_BAR; PG8_WAIT_L(0); PG8_MMA(0, 1, At, B1); PG8_BAR;
            PG8_LDA(At, 1, 1); PG8_STAGE(PG8_SA(1, 0), a3, voffA);
            PG8_BAR; PG8_WAIT_L(0); PG8_MMA(1, 0, At, B0); PG8_BAR; PG8_SCHED;
            PG8_STAGE(PG8_SB(1, 1), b3 + hstep, voffB);
            PG8_WAIT_V(6); PG8_BAR; PG8_MMA(1, 1, At, B1); PG8_BAR;
        }
        PG8_STAMP();
        if constexpr (!Epi::AFTER_DRAIN) { E(acc, cur, wr, wc, fr, fq); S.done(cur); }
        PG8_STAMP();
        if (!has_next) break;
#pragma unroll
        for (int a = 0; a < 2; ++a)
#pragma unroll
            for (int b = 0; b < 2; ++b)
#pragma unroll
                for (int m = 0; m < 4; ++m)
#pragma unroll
                    for (int n = 0; n < 2; ++n) acc[a][b][m][n] = (f32x4){0.f, 0.f, 0.f, 0.f};
        cur = nxt; cA = nA; cB = nB; ++ui;
    }
    PG8_WAIT_V(0);
    if (wr == 0) PG8_BAR;
    PG8_BAR;
    if constexpr (Epi::AFTER_DRAIN) { E.fused(acc, cur, wr, wc, fr, fq, lds, wid, lane); S.done(cur); }
    PG8_STAMP();
    if (STAMP && wid == 0) { stamps[lane] = lane < nts ? (((unsigned long long)(unsigned)ts_hi << 32) | (unsigned)ts_lo) : 0ull;
        if (lane == 62) stamps[62] = rt_entry; if (lane == 63) stamps[63] = (unsigned long long)wall_clock64(); }
#undef PG8_STAMP
#undef PG8_SA
#undef PG8_SB
#undef PG8_STAGE
#undef PG8_LDA
#undef PG8_LD8
#undef PG8_LDB
#undef PG8_MMA
#undef PG8_WAIT_V
#undef PG8_WAIT_L
#undef PG8_BAR
#undef PG8_SCHED
}
}
namespace at {
constexpr int D = 128;
constexpr float THR = 8.f;
constexpr float SCALE = 0.08838834764831845f;
constexpr int NW = 8, QBLK = 32, KVBLK = 64, QB = NW * QBLK;
constexpr int SHM_V = KVBLK * D * 2, SHM_K = KVBLK * D * 2;
constexpr int LDS_BYTES = 2 * SHM_V + 2 * SHM_K + NW * 64 * 4;

typedef unsigned short bf16;
typedef short bf16x8 __attribute__((ext_vector_type(8)));
typedef short s16x4 __attribute__((ext_vector_type(4)));
typedef float f32x16 __attribute__((ext_vector_type(16)));
typedef float f32x4 __attribute__((ext_vector_type(4)));
typedef unsigned u32x4 __attribute__((ext_vector_type(4)));
template <class A, class Bt> struct same_t { static constexpr bool v = false; };
template <class A> struct same_t<A, A> { static constexpr bool v = true; };

#define KSWZ(row, colB) ((row) * 256 + ((colB) ^ (((row) & 7) << 4)))
#define SBAR() __builtin_amdgcn_sched_barrier(0)
__device__ __forceinline__ int v_st(int k, int c) { const int kk = (k & ~0xC) | ((k & 4) << 1) | ((k & 8) >> 1); return ((kk >> 3) * 4 + (c >> 5)) * 512 + ((kk & 7) * 32 + (c & 31)) * 2; }
__device__ __forceinline__ int v_rd_base(int lane) { return ((lane & 3) << 3) | (((lane >> 2) & 3) << 6) | (((lane >> 4) & 1) << 5) | (((lane >> 5) & 1) << 8); }
constexpr int v_rd_off(int d0, int ks, int half) { return d0 * 512 + ks * 4096 + half * 2048; }
__device__ __forceinline__ int crow(int r, int hi) { return (r & 3) + 8 * (r >> 2) + 4 * hi; }
__device__ __forceinline__ unsigned cvtpk(float lo, float hi) {
    unsigned r; asm volatile("v_cvt_pk_bf16_f32 %0, %1, %2" : "=v"(r) : "v"(lo), "v"(hi)); return r;
}
__device__ __forceinline__ bf16x8 pack8(f32x4 a, f32x4 b) {
    u32x4 w = {cvtpk(a[0], a[1]), cvtpk(a[2], a[3]), cvtpk(b[0], b[1]), cvtpk(b[2], b[3])};
    return *reinterpret_cast<bf16x8*>(&w);
}
template <class T> __device__ __forceinline__ bf16x8 load8(const T* p) {
    if constexpr (same_t<T, float>::v) { return pack8(*(const f32x4*)p, *(const f32x4*)(p + 4)); }
    else { return *reinterpret_cast<const bf16x8*>(p); }
}
__device__ __forceinline__ void mask_tile(f32x16& p0, f32x16& p1, int dq, unsigned W) {
    const float NEG = -__builtin_inff();
#pragma unroll
    for (int r = 0; r < 16; ++r) {
        const int c = (r & 3) + 8 * (r >> 2);
        if ((unsigned)(dq - c) >= W) p0[r] = NEG;
        if ((unsigned)(dq - c - 32) >= W) p1[r] = NEG;
    }
}
__device__ __forceinline__ void partialSM(f32x16& p0, f32x16& p1, float& m_reg, float& mn, float& alpha) {
    float pmax = p0[0]; for (int r = 1; r < 16; ++r) pmax = fmaxf(pmax, p0[r]); for (int r = 0; r < 16; ++r) pmax = fmaxf(pmax, p1[r]);
    { auto rr = __builtin_amdgcn_permlane32_swap(__float_as_uint(pmax), __float_as_uint(pmax), false, false);
      pmax = fmaxf(__uint_as_float(rr[0]), __uint_as_float(rr[1])); }
    constexpr float C2 = 1.4426950408889634f * SCALE;
    if (__builtin_expect(__all((pmax - m_reg) * SCALE <= THR), 1)) { mn = m_reg; alpha = 1.f; }
    else { mn = fmaxf(m_reg, pmax); alpha = __builtin_amdgcn_exp2f((m_reg - mn) * C2); m_reg = mn; }
    const float mnL = -mn * C2;
    for (int r = 0; r < 16; ++r) p0[r] = fmaf(p0[r], C2, mnL); for (int r = 0; r < 16; ++r) p1[r] = fmaf(p1[r], C2, mnL);
    for (int r = 0; r < 16; ++r) p0[r] = __builtin_amdgcn_exp2f(p0[r]);
}
__device__ __forceinline__ void finishSM(f32x16& p0, f32x16& p1, float alpha, float& l_reg, bf16x8& pa0, bf16x8& pa1, bf16x8& pa2, bf16x8& pa3) {
    for (int r = 0; r < 16; ++r) p1[r] = __builtin_amdgcn_exp2f(p1[r]);
    float ps = 0; for (int r = 0; r < 16; ++r) ps += p0[r]; for (int r = 0; r < 16; ++r) ps += p1[r];
    { auto rr = __builtin_amdgcn_permlane32_swap(__float_as_uint(ps), __float_as_uint(ps), false, false);
      ps = __uint_as_float(rr[0]) + __uint_as_float(rr[1]); }
    l_reg = l_reg * alpha + ps;
#define PK4(P, B_, OUT) do { unsigned a0 = cvtpk(P[B_+0], P[B_+1]), a1 = cvtpk(P[B_+2], P[B_+3]);                          \
        unsigned b0 = cvtpk(P[B_+4], P[B_+5]), b1 = cvtpk(P[B_+6], P[B_+7]);                                             \
        auto r0 = __builtin_amdgcn_permlane32_swap(a0, b0, false, false); auto r1 = __builtin_amdgcn_permlane32_swap(a1, b1, false, false); \
        u32x4 w = {r0[0], r1[0], r0[1], r1[1]}; OUT = *reinterpret_cast<bf16x8*>(&w); } while (0)
    PK4(p0, 0, pa0); PK4(p0, 8, pa1); PK4(p1, 0, pa2); PK4(p1, 8, pa3);
#undef PK4
}
template <int KB, bool SK>
__device__ __forceinline__ void qkt(f32x16& p0, f32x16& p1, const char* K_lds, int r32, int hi, const bf16x8* qr, bool act) {
    if (SK && !act) { const float NEG = -__builtin_inff();
#pragma unroll
        for (int r = 0; r < 16; ++r) { p0[r] = NEG; p1[r] = NEG; } return; }
    p0 = f32x16{}; p1 = f32x16{};
    const char* kb[4];
#pragma unroll
    for (int dd = 0; dd < 4; ++dd) kb[dd] = K_lds + KB * SHM_K + KSWZ(r32, (dd * 16 + hi * 8) * 2);
#pragma unroll
    for (int d0 = 0; d0 < 8; ++d0) { const char* a = kb[d0 & 3] + (d0 >> 2) * 128;
        bf16x8 b0 = *reinterpret_cast<const bf16x8*>(a);
        bf16x8 b1 = *reinterpret_cast<const bf16x8*>(a + 32 * 256);
        p0 = __builtin_amdgcn_mfma_f32_32x32x16_bf16(b0, qr[d0], p0, 0, 0, 0);
        p1 = __builtin_amdgcn_mfma_f32_32x32x16_bf16(b1, qr[d0], p1, 0, 0, 0); }
}
template <int VB, bool SK>
__device__ __forceinline__ void pv_tile(f32x16* o, int vb0, bf16x8 pa0, bf16x8 pa1, bf16x8 pa2, bf16x8 pa3, bool act) {
    if (SK && !act) return;
#define TRRD(dst, off) asm volatile("ds_read_b64_tr_b16 %0, %1 offset:%2" : "=&v"(dst) : "v"(vb0), "i"(off) : "memory")
#define PV_D0(d0) do { s16x4 l0, l1, l2, l3, h0, h1, h2, h3; constexpr int b_ = VB * SHM_V + v_rd_off(d0, 0, 0);     \
        TRRD(l0, b_); TRRD(h0, b_ + 2048); TRRD(l1, b_ + 4096); TRRD(h1, b_ + 6144); TRRD(l2, b_ + 8192); TRRD(h2, b_ + 10240); TRRD(l3, b_ + 12288); TRRD(h3, b_ + 14336); \
        asm volatile("s_waitcnt lgkmcnt(0)" ::: "memory"); SBAR();                 \
        o[d0] = __builtin_amdgcn_mfma_f32_32x32x16_bf16(pa0, (bf16x8){l0[0], l0[1], l0[2], l0[3], h0[0], h0[1], h0[2], h0[3]}, o[d0], 0, 0, 0);   \
        o[d0] = __builtin_amdgcn_mfma_f32_32x32x16_bf16(pa1, (bf16x8){l1[0], l1[1], l1[2], l1[3], h1[0], h1[1], h1[2], h1[3]}, o[d0], 0, 0, 0);   \
        o[d0] = __builtin_amdgcn_mfma_f32_32x32x16_bf16(pa2, (bf16x8){l2[0], l2[1], l2[2], l2[3], h2[0], h2[1], h2[2], h2[3]}, o[d0], 0, 0, 0);   \
        o[d0] = __builtin_amdgcn_mfma_f32_32x32x16_bf16(pa3, (bf16x8){l3[0], l3[1], l3[2], l3[3], h3[0], h3[1], h3[2], h3[3]}, o[d0], 0, 0, 0); } while (0)
    PV_D0(0); PV_D0(1); PV_D0(2); PV_D0(3);
#undef PV_D0
#undef TRRD
}

struct BlockRef { const bf16* Q; const bf16* K; const bf16* V; bf16* O; float* L; int P0, W, skv, rs; };
struct Seam { bf16x8 qr[8]; bf16x8 st_v0, st_v1, st_k0, st_k1; };
__device__ __forceinline__ int swa_jlo(int P0, int W) { const int lowk = P0 - W + 1; return lowk > 0 ? lowk / KVBLK : 0; }
#define VMW() asm volatile("s_waitcnt vmcnt(0)" ::: "memory")
#define VMWN(n) asm volatile("s_waitcnt vmcnt(%0)" :: "i"(n) : "memory")
#define ROW(p, k0, rr) ((p) + (size_t)(unsigned)(((k0) + (rr)) * RS_) + sc)
#define RS_OF(ref) ({ int rs__ = (ref).rs; asm volatile("" : "+s"(rs__)); rs__; })
#define SLOAD_H(Kp, Vp, k0) do { S.st_v0 = load8<bf16>(ROW(Vp, k0, sr)); S.st_v1 = load8<bf16>(ROW(Vp, k0, 32 + sr));              \
                         S.st_k0 = load8<bf16>(ROW(Kp, k0, sr)); S.st_k1 = load8<bf16>(ROW(Kp, k0, 32 + sr)); } while (0)
#define SWRITE_HK(bf) do { *(bf16x8*)(K_lds + (bf) * SHM_K + kws) = S.st_k0; *(bf16x8*)(K_lds + (bf) * SHM_K + kws + 32 * 256) = S.st_k1; } while (0)
#define SWRITE_HV(bf) do { *(bf16x8*)(V_lds + (bf) * SHM_V + vst0) = S.st_v0; *(bf16x8*)(V_lds + (bf) * SHM_V + vst1) = S.st_v1; } while (0)
#define SWRITE_H(bf) do { SWRITE_HV(bf); SWRITE_HK(bf); } while (0)
__device__ __forceinline__ void causal_swa_prime(const BlockRef& cur, char* lds, Seam& S) {
    const int tid = threadIdx.x, wid = __builtin_amdgcn_readfirstlane(tid >> 6), lane = tid & 63, r32 = lane & 31, hi = lane >> 5;
    const int sr = tid >> 4, sc = (tid & 15) * 8, kws = KSWZ(sr, sc * 2); char* K_lds = lds + 2 * SHM_V;
    const int kb0 = swa_jlo(cur.P0, cur.W) * KVBLK;
    { const int RS_ = RS_OF(cur);
    for (int d0 = 0; d0 < 8; ++d0) S.qr[d0] = load8<bf16>(cur.Q + (size_t)(unsigned)((wid * QBLK + r32) * RS_) + d0 * 16 + hi * 8);
    SLOAD_H(cur.K, cur.V, kb0); } VMW(); SWRITE_HK(0);
    __syncthreads();
}
struct Svc { const float* tu; const float* tv; unsigned char* du; unsigned char* dv; int next, p_old, p_new, par, G, bid; };
constexpr int SVC_OFF = 73728, SVC_NCH = 65536;
typedef float svc_f4 __attribute__((ext_vector_type(4)));
__device__ __forceinline__ void svc_top(Svc& sv, char* lds) {
    if (sv.p_old < 0) return;
    int tid; asm volatile("v_mov_b32 %0, %1" : "=v"(tid) : "v"(threadIdx.x));
    const int g = sv.p_old, e = (g >> 1) & 16383;
    svc_f4 x = *(const svc_f4*)(lds + SVC_OFF + sv.par * 8192 + tid * 16);
    x *= (g >> 15) ? 16.0f : 256.0f;
    int w = __builtin_amdgcn_cvt_pk_fp8_f32(x.x, x.y, 0, false); w = __builtin_amdgcn_cvt_pk_fp8_f32(x.z, x.w, w, true);
    unsigned char* d = ((g >> 15) ? sv.dv : sv.du) + (size_t)e * 128 + ((size_t)(g & 1) << 25);
    __builtin_nontemporal_store(w, (int*)(d + (((tid >> 5) << 21) | ((tid & 31) << 2))));
}
__device__ __forceinline__ void svc_dma(Svc& sv, char* lds) {
    int tid; asm volatile("v_mov_b32 %0, %1" : "=v"(tid) : "v"(threadIdx.x));
    const int g = sv.next * sv.G + sv.bid;
    const bool live = sv.next >= 0 && g < SVC_NCH;
    const float* src = live ? ((g >> 15) ? sv.tv : sv.tu) + (size_t)((g >> 1) & 16383) * 4096 + (g & 1) * 2048 : sv.tu;
    const unsigned ldsa = __builtin_amdgcn_readfirstlane((unsigned)(uintptr_t)lds + SVC_OFF + sv.par * 8192 + (tid >> 6) * 1024);
    asm volatile("s_mov_b32 m0, %0\n\ts_nop 0\n\tglobal_load_lds_dwordx4 %1, %2 nt" :: "s"(ldsa), "v"(tid * 16), "s"(src) : "memory", "m0");
    sv.p_old = sv.p_new; sv.p_new = live ? g : -1; sv.next = live ? sv.next + 1 : -1; sv.par ^= 1;
}
__device__ __forceinline__ bool svc_busy(const Svc& sv) { return sv.next >= 0 || sv.p_old >= 0 || sv.p_new >= 0; }
template <bool SK>
__device__ __forceinline__ void causal_swa_block(const BlockRef& cur, const BlockRef& nxt, char* lds, Seam& S, Svc& sv) {
    const int tid = threadIdx.x, wid = __builtin_amdgcn_readfirstlane(tid >> 6), lane = tid & 63, r32 = lane & 31, hi = lane >> 5;
    const int W = cur.W, skv = cur.skv;
    const int j_lo = swa_jlo(cur.P0, W);
    int j_hi = (cur.P0 + QB - 1) / KVBLK + 1; if (j_hi > skv / KVBLK) j_hi = skv / KVBLK;
    const int NT = j_hi - j_lo;
    const int kbn = swa_jlo(nxt.P0, nxt.W) * KVBLK;
    const int qlo = cur.P0 + wid * QBLK, qm = qlo + r32 - 4 * hi;
    char* V_lds = lds; char* K_lds = lds + 2 * SHM_V;
    float* ws = (float*)(lds + 2 * SHM_V + 2 * SHM_K) + wid * 64; float* li_l = ws, * al_l = ws + 32;
    float m_reg = -1e30f, l_reg = 0; f32x16 o[4] = {};
    const int sr = tid >> 4, sc = (tid & 15) * 8, vst0 = v_st(sr, sc), vst1 = v_st(32 + sr, sc), kws = KSWZ(sr, sc * 2);
    const int vb0 = (int)(uintptr_t)V_lds + v_rd_base(lane);
    const bf16* Kh = cur.K; const bf16* Vh = cur.V;
#define RESC(a) do { if (__any((a) < 1.f)) { if (hi == 0) al_l[r32] = (a); asm volatile("s_waitcnt lgkmcnt(0)" ::: "memory");              \
                     for (int d_ = 0; d_ < 4; ++d_) for (int r = 0; r < 16; ++r) o[d_][r] *= al_l[crow(r, hi)]; } } while (0)
#define KBASE(t) ((j_lo + (t)) * KVBLK)
#define ACT(t) (KBASE(t) <= qlo + QBLK - 1 && KBASE(t) + KVBLK - 1 >= qlo - W + 1)
#define MASKT(P0_, P1_, t) do { const int kb_ = KBASE(t); if ((!SK || ACT(t)) && (kb_ + KVBLK - 1 > qlo || kb_ <= qlo + QBLK - 1 - W)) mask_tile(P0_, P1_, qm - kb_, (unsigned)W); } while (0)
    constexpr int NQL = 8;
#define SEAM_K0() do { VMWN(NQL); SWRITE_HK(0); SBAR(); } while (0)
    f32x16 pA0, pA1, pB0, pB1; float mnA, mnB, alA, alB; bf16x8 pa0, pa1, pa2, pa3;
    SWRITE_HV(0); SBAR();
    if (NT > 1) { const int RS_ = RS_OF(cur); SLOAD_H(Kh, Vh, KBASE(1)); }
    SBAR(); qkt<0, SK>(pA0, pA1, K_lds, r32, hi, S.qr, ACT(0));
    MASKT(pA0, pA1, 0); partialSM(pA0, pA1, m_reg, mnA, alA);
    if (NT > 1) { VMW(); SWRITE_H(1); }
    __syncthreads();
#define HALF_STEP(PX0, PX1, mnX, alX, PY0, PY1, alY, t, KB, VB, SB) do {                                                      \
        svc_top(sv, lds);                                                                                                     \
        SBAR(); qkt<KB, SK>(PX0, PX1, K_lds, r32, hi, S.qr, ACT(t));                                             \
        finishSM(PY0, PY1, alY, l_reg, pa0, pa1, pa2, pa3); SBAR();                                                           \
        if ((t) + 1 < NT) { const int RS_ = RS_OF(cur); SLOAD_H(Kh, Vh, KBASE((t) + 1)); } svc_dma(sv, lds); SBAR();                              \
        pv_tile<VB, SK>(o, vb0, pa0, pa1, pa2, pa3, ACT((t) - 1)); MASKT(PX0, PX1, (t)); partialSM(PX0, PX1, m_reg, mnX, alX);                                        \
        __syncthreads();                                                                                                      \
        if ((t) + 1 < NT) { VMWN(1); SWRITE_H(SB); }                                                                        \
        RESC(alX); __syncthreads(); } while (0)
    for (int t = 1; t + 1 < NT; t += 2) {
        HALF_STEP(pB0, pB1, mnB, alB, pA0, pA1, alA, t, 1, 0, 0);
        HALF_STEP(pA0, pA1, mnA, alA, pB0, pB1, alB, t + 1, 0, 1, 1);
    }
    const bool even = (NT & 1) == 0;
    if (even) { SBAR(); qkt<1, SK>(pB0, pB1, K_lds, r32, hi, S.qr, ACT(NT - 1)); SBAR(); }
    { const int RS_ = RS_OF(nxt); SLOAD_H(nxt.K, nxt.V, kbn); SBAR();
#pragma unroll
      for (int d0 = 0; d0 < 8; ++d0) S.qr[d0] = load8<bf16>(nxt.Q + (size_t)(unsigned)((wid * QBLK + r32) * RS_) + d0 * 16 + hi * 8); }
    SBAR();
    finishSM(pA0, pA1, alA, l_reg, pa0, pa1, pa2, pa3); SBAR();
    pv_tile<0, SK>(o, vb0, pa0, pa1, pa2, pa3, ACT(even ? NT - 2 : NT - 1));
    if (even) { MASKT(pB0, pB1, NT - 1); partialSM(pB0, pB1, m_reg, mnB, alB); __syncthreads(); RESC(alB);
        finishSM(pB0, pB1, alB, l_reg, pa0, pa1, pa2, pa3); SBAR(); pv_tile<1, SK>(o, vb0, pa0, pa1, pa2, pa3, ACT(NT - 1)); }
    SBAR(); SEAM_K0();
    if (hi == 0) li_l[r32] = l_reg; asm volatile("s_waitcnt lgkmcnt(0)" ::: "memory");
    if (cur.L != nullptr && hi == 0) cur.L[wid * QBLK + r32] = m_reg * SCALE + __logf(l_reg);
    float rli[16];
#pragma unroll
    for (int r = 0; r < 16; ++r) rli[r] = __builtin_amdgcn_rcpf(li_l[crow(r, hi)]);
    bf16* Ow = cur.O + (size_t)(wid * QBLK) * D;
#pragma unroll
    for (int r = 0; r < 16; ++r) { const int orow = crow(r, hi);
#pragma unroll
        for (int d0 = 0; d0 < 4; ++d0) { const float v = o[d0][r] * rli[r]; const float vn = __shfl_xor(v, 1);
            if ((r32 & 1) == 0) *(unsigned*)(Ow + (size_t)orow * D + d0 * 32 + r32) = cvtpk(v, vn); } }
    __syncthreads();
#undef RESC
#undef KBASE
#undef ACT
#undef MASKT
#undef SEAM_K0
#undef HALF_STEP
}
#undef ROW
#undef RS_OF
#undef VMW
#undef VMWN
#undef SLOAD_H
#undef SWRITE_HK
#undef SWRITE_HV
#undef SWRITE_H
#undef KSWZ
#undef SBAR
}
#define XB_TMO      128
#define XB_XCNT(j)  (256  + 64 * (j))
#define XB_XSUB(j)  (1280 + 64 * (j))
#define XB_XGEN(j)  (2304 + 64 * (j))
#define XB_TOP      3328
#define XB_TOPGEN   3392
#define XCD_BAR_WORDS 3456
#define XB_SPIN_CAP (1u << 18)
#define LAS __attribute__((address_space(3)))

__device__ __forceinline__ unsigned xb_ld(unsigned* p)              { return __hip_atomic_load(p, __ATOMIC_RELAXED, __HIP_MEMORY_SCOPE_AGENT); }
__device__ __forceinline__ unsigned xb_add(unsigned* p, unsigned v) { return __hip_atomic_fetch_add(p, v, __ATOMIC_RELAXED, __HIP_MEMORY_SCOPE_AGENT); }
__device__ __forceinline__ unsigned xb_xcc_id() { return (unsigned)__builtin_amdgcn_s_getreg((3 << 11) | 20) & 0xFu; }
#define XB_SPIN(cond, bar) do { unsigned _sp = 0; while (cond) { __builtin_amdgcn_s_sleep(1); \
    if ((++_sp & 255u) == 0u) { if (xb_ld(&(bar)[XB_TMO])) break; if (_sp > XB_SPIN_CAP) { atomicAdd(&(bar)[XB_TMO], 1u); break; } } } } while (0)

struct XcdBarrier {
    unsigned* bar; unsigned x;
    volatile LAS unsigned* st;
};

__device__ __forceinline__ XcdBarrier xcd_barrier_post(unsigned* bar, volatile LAS unsigned* st) {
    XcdBarrier b; b.bar = bar; b.x = xb_xcc_id(); b.st = st;
    if (threadIdx.x == 0) (void)xb_add(&bar[XB_XCNT(b.x)], 1u);
    return b;
}
__device__ __forceinline__ void xcd_barrier_complete(unsigned* bar, unsigned x, unsigned& nloc, unsigned& nx) {
    const unsigned G = gridDim.x * gridDim.y * gridDim.z;
    unsigned sum, cnt, mine, sp = 0u;
    for (;;) {
        sum = 0u; cnt = 0u; mine = 0u;
#pragma unroll
        for (unsigned j = 0; j < 16; ++j) { const unsigned c = xb_ld(&bar[XB_XCNT(j)]); sum += c; cnt += (c > 0u) ? 1u : 0u; mine = (j == x) ? c : mine; }
        if (sum == G) break;
        __builtin_amdgcn_s_sleep(1);
        if ((++sp & 255u) == 0u) { if (xb_ld(&bar[XB_TMO])) break; if (sp > XB_SPIN_CAP) { atomicAdd(&bar[XB_TMO], 1u); break; } }
    }
    nloc = mine > 0u ? mine : 1u; nx = cnt > 0u ? cnt : 1u;
}

__device__ __forceinline__ void xcd_barrier(const XcdBarrier& b) {
    asm volatile("s_waitcnt vmcnt(0)" ::: "memory");
    __syncthreads();
    if (threadIdx.x == 0) {
        unsigned* bar = b.bar;
        __builtin_amdgcn_s_waitcnt(0);
        unsigned nloc = b.st[0], nx = b.st[1];
        if (nloc == 0u) { xcd_barrier_complete(bar, b.x, nloc, nx); b.st[0] = nloc; b.st[1] = nx; }
        const unsigned old = xb_add(&bar[XB_XSUB(b.x)], 1u);
        const unsigned gen = old / nloc;
        if (old + 1u == (gen + 1u) * nloc) {
            __builtin_amdgcn_fence(__ATOMIC_RELEASE, "agent");
            asm volatile("s_waitcnt vmcnt(0)" ::: "memory");
            const unsigned og = xb_add(&bar[XB_TOP], 1u);
            const unsigned tg = og / nx;
            if (og + 1u == (tg + 1u) * nx) xb_add(&bar[XB_TOPGEN], 1u);
            else XB_SPIN(xb_ld(&bar[XB_TOPGEN]) == tg, bar);
            __builtin_amdgcn_fence(__ATOMIC_ACQUIRE, "agent");
            xb_add(&bar[XB_XGEN(b.x)], 1u);
            asm volatile("s_waitcnt vmcnt(0)" ::: "memory");
        } else {
            XB_SPIN(xb_ld(&bar[XB_XGEN(b.x)]) == gen, bar);
            __builtin_amdgcn_fence(__ATOMIC_ACQUIRE, "agent");
            asm volatile("s_waitcnt vmcnt(0)" ::: "memory");
        }
    }
    __syncthreads();
}
typedef unsigned short bf16_t;
typedef float f32x4 __attribute__((ext_vector_type(4)));
typedef float f32x2 __attribute__((ext_vector_type(2)));
typedef unsigned u32x4 __attribute__((ext_vector_type(4)));
typedef unsigned u32x2 __attribute__((ext_vector_type(2)));
typedef __bf16 bf16v2 __attribute__((ext_vector_type(2)));
#define LDS_WAIT() asm volatile("s_waitcnt lgkmcnt(0)" ::: "memory")

struct Args {
    const float* x; const float* c; const int* positions; const float* norm1_g; const float* norm2_g; const float* w_ada; const float* b_ada;
    const float* w_in; const float* lam_q1; const float* lam_k1; const float* lam_q2; const float* lam_k2; const float* diff_subln_g; const float* dil_out_g;
    const float* w_out; const float* peer_wq; const float* peer_subkeys; const float* peer_u; const float* peer_v; const float* final_g;
    float* out; unsigned char* ws; int ph_lo, ph_hi, flag, pad;
};

__device__ __forceinline__ unsigned cvt_pk(float lo, float hi) { unsigned r; asm volatile("v_cvt_pk_bf16_f32 %0, %1, %2" : "=v"(r) : "v"(lo), "v"(hi)); return r; }
__device__ __forceinline__ float bf_lo(unsigned u) { return __uint_as_float(u << 16); }
__device__ __forceinline__ float bf_hi(unsigned u) { return __uint_as_float(u & 0xffff0000u); }
__device__ __forceinline__ float dot2bf(unsigned a, unsigned b, float c) { return __builtin_amdgcn_fdot2_f32_bf16(__builtin_bit_cast(bf16v2, a), __builtin_bit_cast(bf16v2, b), c, false); }
__device__ __forceinline__ unsigned pk_fp8(const f32x4 v) { int r = __builtin_amdgcn_cvt_pk_fp8_f32(v.x, v.y, 0, false); r = __builtin_amdgcn_cvt_pk_fp8_f32(v.z, v.w, r, true); return (unsigned)r; }
__device__ __forceinline__ f32x4 ld4bf(const bf16_t* p) { const u32x2 w = *(const u32x2*)p; return (f32x4){bf_lo(w.x), bf_hi(w.x), bf_lo(w.y), bf_hi(w.y)}; }
__device__ __forceinline__ float wave_sum(float v) {
#pragma unroll
    for (int o = 1; o < 64; o <<= 1) v += __shfl_xor(v, o);
    return v;
}
__device__ __forceinline__ float half_sum(float v) {
#pragma unroll
    for (int o = 1; o < 32; o <<= 1) v += __shfl_xor(v, o);
    return v;
}

#ifdef PROBE_FLAGS
#define P0SEL(b) (!(A.flag & 0xf00) || (A.flag & (0x100 << (b))))
#else
#define P0SEL(b) true
#endif
__device__ __forceinline__ void p0_gemv_unit(const Args& A, float* mod, LAS float* red, int unit, int tid) {
    LAS float* sc = red + 2048;
    for (int i = tid; i < DM; i += 512) { const float cv = A.c[i]; sc[i] = cv / (1.0f + __expf(-cv)); }
    __syncthreads();
    const int rl = tid / 24, c4 = tid - rl * 24;
    if (tid < 384) {
        const float* wp = A.w_ada + (size_t)rl * NADA + unit * 96 + c4 * 4;
        const LAS float* cp = sc + rl;
        f32x4 acc = {0.f, 0.f, 0.f, 0.f};
        f32x4 w0[8], w1[8];
#pragma unroll
        for (int i = 0; i < 8; ++i) w0[i] = *(const f32x4*)(wp + (size_t)(16 * i) * NADA);
        for (int k0 = 0; k0 < DM; k0 += 256) {
#pragma unroll
            for (int i = 0; i < 8; ++i) w1[i] = *(const f32x4*)(wp + (size_t)(k0 + 128 + 16 * i) * NADA);
#pragma unroll
            for (int i = 0; i < 8; ++i) acc += cp[k0 + 16 * i] * w0[i];
            if (k0 + 256 < DM) {
#pragma unroll
                for (int i = 0; i < 8; ++i) w0[i] = *(const f32x4*)(wp + (size_t)(k0 + 256 + 16 * i) * NADA);
            }
#pragma unroll
            for (int i = 0; i < 8; ++i) acc += cp[k0 + 128 + 16 * i] * w1[i];
        }
        *(LAS f32x4*)(red + rl * 96 + c4 * 4) = acc;
    }
    __syncthreads();
    if (tid < 96) { float s = 0.f;
#pragma unroll
        for (int r = 0; r < 16; ++r) s += red[r * 96 + tid];
        mod[unit * 96 + tid] = s + A.b_ada[unit * 96 + tid]; }
    __syncthreads();
}
__device__ __forceinline__ void p0_tr_load(const float* W, int N, int item, int lane, f32x4 (&ld)[8]) {
    const int nblk = N / 32, kb = item / nblk, nb = item - kb * nblk;
    const float* p = W + (size_t)(64 * kb + (lane >> 3)) * N + 32 * nb + 4 * (lane & 7);
#pragma unroll
    for (int i = 0; i < 8; ++i) ld[i] = *(const f32x4*)(p + (size_t)(8 * i) * N);
}
template <bool F8>
__device__ __forceinline__ void p0_tr_store(const f32x4 (&ld)[8], int K, int N, bf16_t* WT, LAS float* scr, int item, int lane) {
    const int nblk = N / 32, kb = item / nblk, nb = item - kb * nblk, k0 = 64 * kb, n0 = 32 * nb;
#pragma unroll
    for (int i = 0; i < 8; ++i) { LAS float* d = scr + (8 * i + (lane >> 3)) * 33 + 4 * (lane & 7); d[0] = ld[i].x; d[1] = ld[i].y; d[2] = ld[i].z; d[3] = ld[i].w; }
    LDS_WAIT(); asm volatile("" ::: "memory");
    const int c = lane & 7;
#pragma unroll
    for (int j = 0; j < 4; ++j) { const int n = (lane >> 3) + 8 * j; const LAS float* s = scr + (8 * c) * 33 + n;
        if (F8) { u32x2 o8; o8.x = pk_fp8((f32x4){s[0 * 33], s[1 * 33], s[2 * 33], s[3 * 33]} * 1024.0f); o8.y = pk_fp8((f32x4){s[4 * 33], s[5 * 33], s[6 * 33], s[7 * 33]} * 1024.0f);
            *(u32x2*)((unsigned char*)WT + (size_t)(n0 + n) * K + k0 + 8 * c) = o8; }
        else { u32x4 o; o.x = cvt_pk(s[0 * 33], s[1 * 33]); o.y = cvt_pk(s[2 * 33], s[3 * 33]); o.z = cvt_pk(s[4 * 33], s[5 * 33]); o.w = cvt_pk(s[6 * 33], s[7 * 33]);
            *(u32x4*)(WT + (size_t)(n0 + n) * K + k0 + 8 * c) = o; } }
    LDS_WAIT(); asm volatile("" ::: "memory");
}
typedef __bf16 bf16v8_t __attribute__((ext_vector_type(8))); typedef float f32x8_t __attribute__((ext_vector_type(8)));
__device__ __forceinline__ pg8::bf16x8 pack8f(const f32x4 a, const f32x4 b) { const f32x8_t v = {a.x, a.y, a.z, a.w, b.x, b.y, b.z, b.w}; return __builtin_bit_cast(pg8::bf16x8, __builtin_convertvector(v, bf16v8_t)); }
__device__ __forceinline__ void p0_fold_item(const Args& A, bf16_t* wsc, int item, int lane) {
    const int g = item >> 7, d0 = (item & 127) * 32, r = lane & 15, kg = lane >> 4;
    pg8::bf16x8 af[2][4];
#pragma unroll
    for (int mt = 0; mt < 2; ++mt)
#pragma unroll
        for (int ks = 0; ks < 4; ++ks) { const float* p = A.peer_wq + (size_t)(d0 + 16 * mt + r) * 2048 + g * 128 + 32 * ks + 8 * kg; af[mt][ks] = pack8f(*(const f32x4*)p, *(const f32x4*)(p + 4)); }
    const float* skp = A.peer_subkeys + (size_t)g * 16384 + 8 * kg;
#pragma unroll 2
    for (int nt = 0; nt < 8; ++nt) {
        pg8::bf16x8 bfr[4];
#pragma unroll
        for (int ks = 0; ks < 4; ++ks) { const float* p = skp + (size_t)(16 * nt + r) * 128 + 32 * ks; bfr[ks] = pack8f(*(const f32x4*)p, *(const f32x4*)(p + 4)); }
#pragma unroll
        for (int mt = 0; mt < 2; ++mt) {
            f32x4 c = {0.f, 0.f, 0.f, 0.f};
#pragma unroll
            for (int ks = 0; ks < 4; ++ks) c = __builtin_amdgcn_mfma_f32_16x16x32_bf16(af[mt][ks], bfr[ks], c, 0, 0, 0);
            typedef __bf16 bf16v4_t __attribute__((ext_vector_type(4)));
            const u32x2 w = __builtin_bit_cast(u32x2, __builtin_convertvector(c, bf16v4_t));
            *(u32x2*)(wsc + (size_t)(g * 128 + 16 * nt + r) * DM + d0 + 16 * mt + 4 * kg) = w;
        }
    }
}
__device__ __forceinline__ void p0_cv_load(const Args& A, int item, int lane, f32x4 (&lu)[4], f32x4 (&lv)[4]) {
    const int eb = item >> 5, s = item & 31;
    const size_t off = (size_t)(eb * 8 + (lane >> 3)) * DM + s * 128 + 16 * (lane & 7);
#pragma unroll
    for (int i = 0; i < 4; ++i) { lu[i] = *(const f32x4*)(A.peer_u + off + 4 * i); lv[i] = *(const f32x4*)(A.peer_v + off + 4 * i); }
}
__device__ __forceinline__ void p0_cv_store(unsigned char* ws, int item, int lane, const f32x4 (&lu)[4], const f32x4 (&lv)[4]) {
    const int eb = item >> 5, s = item & 31;
    const size_t dst = ((size_t)s * NEXP + (size_t)eb * 8) * 8 + lane;
    u32x4 o, p;
    o.x = pk_fp8(lu[0] * 256.0f); o.y = pk_fp8(lu[1] * 256.0f); o.z = pk_fp8(lu[2] * 256.0f); o.w = pk_fp8(lu[3] * 256.0f);
    p.x = pk_fp8(lv[0] * 16.0f); p.y = pk_fp8(lv[1] * 16.0f); p.z = pk_fp8(lv[2] * 16.0f); p.w = pk_fp8(lv[3] * 16.0f);
    ((u32x4*)(ws + WS_UB))[dst] = o; ((u32x4*)(ws + WS_VB))[dst] = p;
}
__device__ __forceinline__ void p0_fold_item_old(const Args& A, bf16_t* wsc, LAS float* lds, int item, int tid) {
    const int g = item >> 6, d0 = (item & 63) * 64;
    LAS float* SK = lds;
    LAS float* WQ = lds + 128 * 132;
    const float* skp = A.peer_subkeys + (size_t)g * 16384;
    for (int i = tid; i < 128 * 32; i += 512) { const int n = i >> 5, k4 = i & 31; *(LAS f32x4*)(SK + n * 132 + 4 * k4) = *(const f32x4*)(skp + n * 128 + 4 * k4); }
    for (int i = tid; i < 64 * 32; i += 512) { const int d = i >> 5, k4 = i & 31; *(LAS f32x4*)(WQ + d * 132 + 4 * k4) = *(const f32x4*)(A.peer_wq + (size_t)(d0 + d) * 2048 + g * 128 + 4 * k4); }
    __syncthreads();
    const int n = tid & 127, dg = tid >> 7;
    float acc[16];
#pragma unroll
    for (int j = 0; j < 16; ++j) acc[j] = 0.f;
    for (int k4 = 0; k4 < 32; ++k4) {
        const f32x4 a = *(const LAS f32x4*)(SK + n * 132 + 4 * k4);
#pragma unroll
        for (int j = 0; j < 16; ++j) { const f32x4 b = *(const LAS f32x4*)(WQ + (dg * 16 + j) * 132 + 4 * k4); acc[j] += a.x * b.x + a.y * b.y + a.z * b.z + a.w * b.w; }
    }
    u32x4 o0, o1;
    o0.x = cvt_pk(acc[0], acc[1]); o0.y = cvt_pk(acc[2], acc[3]); o0.z = cvt_pk(acc[4], acc[5]); o0.w = cvt_pk(acc[6], acc[7]);
    o1.x = cvt_pk(acc[8], acc[9]); o1.y = cvt_pk(acc[10], acc[11]); o1.z = cvt_pk(acc[12], acc[13]); o1.w = cvt_pk(acc[14], acc[15]);
    bf16_t* op = wsc + (size_t)(g * 128 + n) * DM + d0 + dg * 16;
    *(u32x4*)op = o0; *(u32x4*)(op + 8) = o1;
    __syncthreads();
}
__device__ __forceinline__ void p0_prologue(const Args& A, LAS unsigned char* lds, int G, int bid, int tid) {
    const int lane = tid & 63, wave = __builtin_amdgcn_readfirstlane(tid >> 6);
    unsigned char* ws = A.ws;
    float* mod = (float*)(ws + WS_MOD);
    const int gw = bid * 8 + wave, NGW = G * 8;
    if (P0SEL(0)) for (int u = bid; u < NADA / 96; u += G) p0_gemv_unit(A, mod, (LAS float*)lds, u, tid);
    if (bid == G - 1 && wave == 0) {
        float a = 0.f, b = 0.f;
        for (int i = lane; i < 128; i += 64) { a += A.lam_q1[i] * A.lam_k1[i]; b += A.lam_q2[i] * A.lam_k2[i]; }
        a = wave_sum(a); b = wave_sum(b);
        if (lane == 0) *(float*)(ws + WS_LAM) = expf(a) - expf(b) + LAM_INIT;
    }
    {
        float* rope = (float*)(ws + WS_ROPE);
        for (int i = bid * 512 + tid; i < S * 16; i += G * 512) {
            const int s = i >> 4, f = i & 15;
            const float inv = powf(500000.0f, -(float)(2 * f) / 32.0f);
            const float ang = (float)A.positions[s] * inv;
            double rev = (double)ang * 0.15915494309189535; rev -= rint(rev);
            const float fr = (float)rev;
            rope[s * 32 + f] = __builtin_amdgcn_cosf(fr);
            rope[s * 32 + 16 + f] = __builtin_amdgcn_sinf(fr);
        }
    }
    if (P0SEL(1)) {
        LAS float* scr = (LAS float*)(lds + wave * 16384);
        constexpr int I_IN = (DM / 64) * (NIN / 32), I_OUT = (DM / 64) * (DM / 32);
        bf16_t* win = (bf16_t*)(ws + WS_WIN); bf16_t* wout = (bf16_t*)(ws + WS_WOUT);
        f32x4 cur[8], nxt[8];
        int it = gw;
        if (it < I_IN + I_OUT) { if (it < I_IN) p0_tr_load(A.w_in, NIN, it, lane, cur); else p0_tr_load(A.w_out, DM, it - I_IN, lane, cur); }
        for (; it < I_IN + I_OUT; it += NGW) {
            const int itn = it + NGW;
            if (itn < I_IN + I_OUT) { if (itn < I_IN) p0_tr_load(A.w_in, NIN, itn, lane, nxt); else p0_tr_load(A.w_out, DM, itn - I_IN, lane, nxt); }
            if (it < I_IN) { const int T_ = ((it % (NIN / 32)) * 32) >> 11;
                if (T_ == 2 || T_ == 5) p0_tr_store<true>(cur, DM, NIN, (bf16_t*)((unsigned char*)win + WIN8_OFF + ((ptrdiff_t)(T_ == 2 ? -4096 : -8192)) * DM), scr, it, lane);
                else p0_tr_store<false>(cur, DM, NIN, win + ((ptrdiff_t)(T_ > 2 ? -2048 : 0)) * DM, scr, it, lane); }
            else p0_tr_store<true>(cur, DM, DM, wout, scr, it - I_IN, lane);
#pragma unroll
            for (int i = 0; i < 8; ++i) cur[i] = nxt[i];
        }
    }
#ifdef OLD_FOLD
    __syncthreads();
    if (P0SEL(2)) for (int it = bid; it < 16 * 64; it += G) p0_fold_item_old(A, (bf16_t*)(ws + WS_WSC), (LAS float*)lds, it, tid);
#else
    if (P0SEL(2)) for (int it = gw; it < 16 * 128; it += NGW) p0_fold_item(A, (bf16_t*)(ws + WS_WSC), it, lane);
#endif
    if (false) {
        constexpr int NIT = (NEXP / 8) * 32;
        f32x4 cu[4], cv[4], nu[4], nv[4];
        int it = gw;
        if (it < NIT) p0_cv_load(A, it, lane, cu, cv);
        for (; it < NIT; it += NGW) {
            const int itn = it + NGW;
            if (itn < NIT) p0_cv_load(A, itn, lane, nu, nv);
            p0_cv_store(ws, it, lane, cu, cv);
#pragma unroll
            for (int i = 0; i < 4; ++i) { cu[i] = nu[i]; cv[i] = nv[i]; }
        }
    }
    __syncthreads();
}

template <bool INBF, bool F8OUT>
__device__ __forceinline__ void row_modulate(const void* xin_, const float* g, const float* sh, const float* sc, bf16_t* out, unsigned char* out8, LAS float* lv, int tid, int gw, int ngw, int lane) {
    for (int i = tid; i < DM / 4; i += 512) { const f32x4 gv = ((const f32x4*)g)[i], sv = ((const f32x4*)sc)[i]; ((LAS f32x4*)lv)[i] = gv * (1.0f + sv); ((LAS f32x4*)(lv + DM))[i] = ((const f32x4*)sh)[i]; }
    __syncthreads();
    for (int r = gw; r < S; r += ngw) {
        f32x4 v[16]; float ss = 0.f;
        if (INBF) { const bf16_t* xr = (const bf16_t*)xin_ + (size_t)r * DM + 8 * lane;
#pragma unroll
            for (int j = 0; j < 8; ++j) { const u32x4 w = *(const u32x4*)(xr + 512 * j);
                v[2 * j] = (f32x4){bf_lo(w.x), bf_hi(w.x), bf_lo(w.y), bf_hi(w.y)}; v[2 * j + 1] = (f32x4){bf_lo(w.z), bf_hi(w.z), bf_lo(w.w), bf_hi(w.w)}; }
        } else { const float* xr = (const float*)xin_ + (size_t)r * DM + 8 * lane;
#pragma unroll
            for (int j = 0; j < 8; ++j) { v[2 * j] = *(const f32x4*)(xr + 512 * j); v[2 * j + 1] = *(const f32x4*)(xr + 512 * j + 4); }
        }
#pragma unroll
        for (int j = 0; j < 16; ++j) ss += (v[j].x * v[j].x + v[j].y * v[j].y) + (v[j].z * v[j].z + v[j].w * v[j].w);
        ss = wave_sum(ss);
        const float rstd = 1.0f / sqrtf(ss * (1.0f / DM) + NORM_EPS);
        bf16_t* orow = out + (size_t)r * DM + 8 * lane;
#pragma unroll
        for (int j = 0; j < 8; ++j) { const int c = 8 * lane + 512 * j;
            const f32x4 a0 = *(const LAS f32x4*)(lv + c), a1 = *(const LAS f32x4*)(lv + c + 4), h0 = *(const LAS f32x4*)(lv + DM + c), h1 = *(const LAS f32x4*)(lv + DM + c + 4);
            const f32x4 y0 = v[2 * j] * rstd * a0 + h0, y1 = v[2 * j + 1] * rstd * a1 + h1;
            u32x4 w; w.x = cvt_pk(y0.x, y0.y); w.y = cvt_pk(y0.z, y0.w); w.z = cvt_pk(y1.x, y1.y); w.w = cvt_pk(y1.z, y1.w);
            *(u32x4*)(orow + 512 * j) = w;
            if (F8OUT) { u32x2 w8; w8.x = pk_fp8(y0 * 16.0f); w8.y = pk_fp8(y1 * 16.0f); *(u32x2*)(out8 + (size_t)r * DM + c) = w8; }
            if ((j & 3) == 3) __builtin_amdgcn_sched_barrier(0); }
    }
    __syncthreads();
}

struct EpiQKV {
    static constexpr bool PERM = true, AFTER_DRAIN = false;
    bf16_t* qkv; bf16_t* qkv2; const float* rope; int skip;
    __device__ __forceinline__ void operator()(const pg8::f32x4 (&acc)[2][2][4][2], const pg8::Unit& u, int wr, int wc, int fr, int fq) const {
        if (skip) return;
        const int tt_ = u.pn >> 3, T = tt_ + (tt_ >= 2 ? 1 : 0), hh0 = 2 * (u.pn & 7);
        const bool rot = (wc == 0);
        const int d0 = wc * 32 + 8 * fq;
        const float sgn = (fq < 2) ? -1.0f : 1.0f;
        bf16_t* base = qkv + (size_t)T * QKV_T + d0;
        const int rowb = u.pm * 256 + wr * 64 + fr;
        f32x4 cs0 = {1.f, 1.f, 1.f, 1.f}, cs1 = cs0, sn0 = {0.f, 0.f, 0.f, 0.f}, sn1 = sn0, ncs0 = cs0, ncs1 = cs0, nsn0 = sn0, nsn1 = sn0;
        if (rot) { const float* rp = rope + (size_t)rowb * 32 + 8 * (fq & 1);
            cs0 = *(const f32x4*)rp; cs1 = *(const f32x4*)(rp + 4); sn0 = *(const f32x4*)(rp + 16); sn1 = *(const f32x4*)(rp + 20); }
#pragma unroll
        for (int gi = 0; gi < 8; ++gi) {
            const int ai = gi >> 2, m = gi & 3;
            const int row = rowb + ai * 128 + m * 16;
            if (rot && gi < 7) { const int nrow = rowb + ((gi + 1) >> 2) * 128 + ((gi + 1) & 3) * 16; const float* rp = rope + (size_t)nrow * 32 + 8 * (fq & 1);
                ncs0 = *(const f32x4*)rp; ncs1 = *(const f32x4*)(rp + 4); nsn0 = *(const f32x4*)(rp + 16); nsn1 = *(const f32x4*)(rp + 20); }
#pragma unroll
            for (int bj = 0; bj < 2; ++bj) {
                f32x4 v0 = acc[ai][bj][m][0], v1 = acc[ai][bj][m][1];
                if (rot) {
                    f32x4 o0, o1;
                    o0.x = __shfl_xor(v0.x, 32); o0.y = __shfl_xor(v0.y, 32); o0.z = __shfl_xor(v0.z, 32); o0.w = __shfl_xor(v0.w, 32);
                    o1.x = __shfl_xor(v1.x, 32); o1.y = __shfl_xor(v1.y, 32); o1.z = __shfl_xor(v1.z, 32); o1.w = __shfl_xor(v1.w, 32);
                    v0 = v0 * cs0 + sgn * o0 * sn0; v1 = v1 * cs1 + sgn * o1 * sn1;
                }
                u32x4 w; w.x = cvt_pk(v0[0], v0[1]); w.y = cvt_pk(v0[2], v0[3]); w.z = cvt_pk(v1[0], v1[1]); w.w = cvt_pk(v1[2], v1[3]);
                *(u32x4*)(base + ((size_t)(hh0 + bj) * S + row) * 128) = w;
            }
            cs0 = ncs0; cs1 = ncs1; sn0 = nsn0; sn1 = nsn1;
        }
    }
};
struct EpiSV {
    static constexpr bool PERM = true, AFTER_DRAIN = false;
    bf16_t* qkv; bf16_t* qkv2;
    __device__ __forceinline__ void operator()(const pg8::f32x4 (&acc)[2][2][4][2], const pg8::Unit& u, int wr, int wc, int fr, int fq) const {
        const bool dil = (u.pn >> 3) != 0; const int T = dil ? 5 : 2;
        const int hh0 = 2 * (u.pn & 7), d0 = wc * 32 + 8 * fq, rowb = u.pm * 256 + wr * 64 + fr;
        bf16_t* base = qkv + (size_t)T * QKV_T + d0;
#pragma unroll
        for (int gi = 0; gi < 8; ++gi) { const int ai = gi >> 2, m = gi & 3, row = rowb + ai * 128 + m * 16;
#pragma unroll
            for (int bj = 0; bj < 2; ++bj) {
                const f32x4 v0 = acc[ai][bj][m][0] * (1.0f / 16384.0f), v1 = acc[ai][bj][m][1] * (1.0f / 16384.0f);
                u32x4 w; w.x = cvt_pk(v0[0], v0[1]); w.y = cvt_pk(v0[2], v0[3]); w.z = cvt_pk(v1[0], v1[1]); w.w = cvt_pk(v1[2], v1[3]);
                *(u32x4*)(base + ((size_t)(hh0 + bj) * S + row) * 128) = w;
            } }
    }
};
struct EpiResid {
    static constexpr bool PERM = true, AFTER_DRAIN = false;
    const float* x; const float* gate; bf16_t* out;
    __device__ __forceinline__ void operator()(const pg8::f32x4 (&acc)[2][2][4][2], const pg8::Unit& u, int wr, int wc, int fr, int fq) const {
        const int row0 = u.pm * 256 + wr * 64 + fr, col0 = u.pn * 256 + wc * 32 + 8 * fq;
        f32x4 gv[2][2];
#pragma unroll
        for (int bj = 0; bj < 2; ++bj)
#pragma unroll
            for (int n = 0; n < 2; ++n) gv[bj][n] = *(const f32x4*)(gate + col0 + bj * 128 + n * 4) * (1.0f / 16384.0f);
        f32x4 xq[2][2][2];
#define ER_LOAD(slot, gi_) do { const size_t o_ = (size_t)(row0 + ((gi_) >> 2) * 128 + ((gi_) & 3) * 16) * DM + col0; \
            _Pragma("unroll") for (int bj = 0; bj < 2; ++bj) { xq[slot][bj][0] = *(const f32x4*)(x + o_ + bj * 128); xq[slot][bj][1] = *(const f32x4*)(x + o_ + bj * 128 + 4); } } while (0)
        ER_LOAD(0, 0); ER_LOAD(1, 1);
#pragma unroll
        for (int gi = 0; gi < 8; ++gi) { const int ai = gi >> 2, m = gi & 3;
            const size_t off = (size_t)(row0 + ai * 128 + m * 16) * DM + col0;
            f32x4 xc[2][2];
#pragma unroll
            for (int bj = 0; bj < 2; ++bj) { xc[bj][0] = xq[gi % 2][bj][0]; xc[bj][1] = xq[gi % 2][bj][1]; }
            if (gi + 2 < 8) ER_LOAD(gi % 2, gi + 2);
#pragma unroll
            for (int bj = 0; bj < 2; ++bj) {
#ifdef DBG_NO_MIXER
                const f32x4 r0 = xc[bj][0], r1 = xc[bj][1];
#else
                const f32x4 r0 = xc[bj][0] + gv[bj][0] * acc[ai][bj][m][0], r1 = xc[bj][1] + gv[bj][1] * acc[ai][bj][m][1];
#endif
                u32x4 w; w.x = cvt_pk(r0[0], r0[1]); w.y = cvt_pk(r0[2], r0[3]); w.z = cvt_pk(r1[0], r1[1]); w.w = cvt_pk(r1[2], r1[3]);
                *(u32x4*)(out + off + bj * 128) = w;
            }
            __builtin_amdgcn_sched_barrier(0);
        }
#undef ER_LOAD
    }
};

struct AttIt { int kind, L, pass; };
__device__ __forceinline__ at::BlockRef att_ref(const AttIt& it, unsigned char* ws, bool remap) {
    const bf16_t* qkv = (const bf16_t*)(ws + WS_QKV);
    at::BlockRef r;
    if (it.kind == 0) {
        const int b_ = it.L & 255, L_ = remap ? ((((it.L >> 8) * 16 + 2 * (b_ & 7) + (b_ >> 7)) << 4) + ((b_ >> 3) & 15)) : it.L;
        const int vp = L_ >> 4, x = L_ & 15, qb = it.pass ? 31 - x : x;
        const int h = vp >> 2, s = (vp >> 1) & 1, hf = vp & 1;
        const size_t hq = (size_t)(2 * h + s) * S * 128, hv = (size_t)(2 * h + hf) * S * 128;
        r.Q = qkv + 0 * QKV_T + hq + (size_t)qb * 256 * 128; r.K = qkv + 1 * QKV_T + hq; r.V = qkv + 2 * QKV_T + hv;
        r.O = (bf16_t*)(ws + WS_OD) + ((size_t)vp * S + (size_t)qb * 256) * 128; r.L = nullptr;
        r.P0 = qb * 256; r.W = S; r.skv = S; r.rs = 128;
    } else {
        const int b_ = it.L & 255, j_ = it.L >> 8;
        const int g = remap ? (j_ % 3) : (it.L >> 9), h = remap ? (2 * (b_ & 7) + (j_ >= 3 ? 1 : 0)) : ((it.L & 511) >> 5), blk = remap ? (b_ >> 3) : (it.L & 31);
        const int dil = (g == 0) ? 1 : (g == 1 ? 4 : 16), bpr = 32 / dil, res = blk / bpr, qb = blk % bpr;
        const bf16_t* tb = qkv + 3 * QKV_T;
        const size_t hb = ((size_t)h * S + (size_t)res * (S / dil)) * 128, hn = ((size_t)h * S + (size_t)res) * 128;
        r.skv = S / dil; r.P0 = qb * 256; r.W = 129; r.rs = 128 * dil;
        r.Q = tb + 0 * QKV_T + hn + (size_t)qb * 256 * 128 * dil; r.K = tb + 1 * QKV_T + hn; r.V = tb + 2 * QKV_T + hn;
        r.O = (bf16_t*)(ws + WS_OS) + ((size_t)(g * 16 + h) * S + (size_t)res * (S / dil) + (size_t)qb * 256) * 128;
        r.L = (float*)(ws + WS_LSE) + (size_t)(g * 16 + h) * S + (size_t)res * (S / dil) + (size_t)qb * 256;
    }
    return r;
}
__device__ __forceinline__ AttIt att_next(const AttIt& it, int G, int bid) {
    AttIt n = it;
    if (it.kind == 0) {
        if (it.pass == 0) { n.pass = 1; return n; }
        n.pass = 0; n.L = it.L + G;
        if (n.L < 512) return n;
        n.kind = 1; n.L = bid; if (n.L >= 1536) n.kind = 2;
        return n;
    }
    n.L = it.L + G; if (n.L >= 1536) n.kind = 2;
    return n;
}
__device__ __forceinline__ void attn_phase(const Args& A, char* lds, int G, int bid) {
    AttIt it; it.kind = 0; it.L = bid; it.pass = 0;
    if (it.L >= 512) { it.kind = 1; it.L = bid; if (it.L >= 1536) it.kind = 2; }
    const bool remap = (G == 256);
    at::Svc sv; sv.tu = A.peer_u; sv.tv = A.peer_v; sv.du = A.ws + WS_UB; sv.dv = A.ws + WS_VB; sv.next = 0; sv.p_old = -1; sv.p_new = -1; sv.par = 0; sv.G = G; sv.bid = bid;
    if (it.kind != 2) {
        at::BlockRef cur = att_ref(it, A.ws, remap);
        at::Seam Sm;
        at::causal_swa_prime(cur, lds, Sm);
        while (it.kind != 2) {
            const AttIt itn = att_next(it, G, bid);
            const at::BlockRef nxt = (itn.kind == 2) ? cur : att_ref(itn, A.ws, remap);
            at::causal_swa_block<false>(cur, nxt, lds, Sm, sv);
            cur = nxt; it = itn;
        }
    }
    while (at::svc_busy(sv)) { asm volatile("s_waitcnt vmcnt(0)" ::: "memory"); at::svc_top(sv, lds); at::svc_dma(sv, lds); }
    asm volatile("s_waitcnt vmcnt(0)" ::: "memory");
}

__device__ __forceinline__ void ld16bf(const bf16_t* p, f32x4 (&o)[4]) { const u32x4 a = *(const u32x4*)p, b = *(const u32x4*)(p + 8);
    o[0] = (f32x4){bf_lo(a.x), bf_hi(a.x), bf_lo(a.y), bf_hi(a.y)}; o[1] = (f32x4){bf_lo(a.z), bf_hi(a.z), bf_lo(a.w), bf_hi(a.w)};
    o[2] = (f32x4){bf_lo(b.x), bf_hi(b.x), bf_lo(b.y), bf_hi(b.y)}; o[3] = (f32x4){bf_lo(b.z), bf_hi(b.z), bf_lo(b.w), bf_hi(b.w)}; }
__device__ __forceinline__ float sq16(const f32x4 (&v)[4]) { float s = 0.f;
#pragma unroll
    for (int i = 0; i < 4; ++i) s += (v[i].x * v[i].x + v[i].y * v[i].y) + (v[i].z * v[i].z + v[i].w * v[i].w);
    return s; }
__device__ __forceinline__ void combine_phase(const Args& A, int gw, int ngw, int lane) {
    unsigned char* ws = A.ws;
    const float lam = *(const float*)(ws + WS_LAM);
    const bf16_t* OD = (const bf16_t*)(ws + WS_OD); const bf16_t* OS = (const bf16_t*)(ws + WS_OS); const float* LSE = (const float*)(ws + WS_LSE);
    unsigned char* Y = (unsigned char*)(ws + WS_Y);
    for (int t = gw; t < S; t += ngw) {
#pragma unroll
        for (int hq = 0; hq < 2; ++hq) {
            const int h = 4 * hq + (lane >> 4), e0 = 16 * (lane & 15), hf = e0 >> 7, d0 = e0 & 127;
            f32x4 a[4], b[4], v[4];
            ld16bf(OD + ((size_t)(h * 4 + 0 + hf) * S + t) * 128 + d0, a); ld16bf(OD + ((size_t)(h * 4 + 2 + hf) * S + t) * 128 + d0, b);
#pragma unroll
            for (int i = 0; i < 4; ++i) v[i] = a[i] - lam * b[i];
            float ss = sq16(v);
            ss += __shfl_xor(ss, 1); ss += __shfl_xor(ss, 2); ss += __shfl_xor(ss, 4); ss += __shfl_xor(ss, 8);
            const float rstd = 16.0f * (1.0f - LAM_INIT) / sqrtf(ss * (1.0f / 256.0f) + NORM_EPS);
            u32x4 w;
            w.x = pk_fp8(v[0] * rstd * *(const f32x4*)(A.diff_subln_g + e0)); w.y = pk_fp8(v[1] * rstd * *(const f32x4*)(A.diff_subln_g + e0 + 4));
            w.z = pk_fp8(v[2] * rstd * *(const f32x4*)(A.diff_subln_g + e0 + 8)); w.w = pk_fp8(v[3] * rstd * *(const f32x4*)(A.diff_subln_g + e0 + 12));
            *(u32x4*)(Y + (size_t)t * DM + h * 256 + e0) = w;
        }
        const int r1 = (t & 3) * (S / 4) + (t >> 2), r2 = (t & 15) * (S / 16) + (t >> 4);
#pragma unroll
        for (int hq = 0; hq < 2; ++hq) {
            const int h = 8 * hq + (lane >> 3), d0 = 16 * (lane & 7);
            const float l0 = LSE[(size_t)(0 * 16 + h) * S + t], l1 = LSE[(size_t)(1 * 16 + h) * S + r1], l2 = LSE[(size_t)(2 * 16 + h) * S + r2];
            const float mx = fmaxf(l0, fmaxf(l1, l2));
            const float e0 = __expf(l0 - mx), e1 = __expf(l1 - mx), e2 = __expf(l2 - mx), inv = 1.0f / (e0 + e1 + e2);
            f32x4 o0[4], o1[4], o2[4], v[4];
            ld16bf(OS + ((size_t)(0 * 16 + h) * S + t) * 128 + d0, o0); ld16bf(OS + ((size_t)(1 * 16 + h) * S + r1) * 128 + d0, o1); ld16bf(OS + ((size_t)(2 * 16 + h) * S + r2) * 128 + d0, o2);
#pragma unroll
            for (int i = 0; i < 4; ++i) v[i] = (e0 * inv) * o0[i] + (e1 * inv) * o1[i] + (e2 * inv) * o2[i];
            float ss = sq16(v);
            ss += __shfl_xor(ss, 1); ss += __shfl_xor(ss, 2); ss += __shfl_xor(ss, 4);
            const float rstd = 16.0f / sqrtf(ss * (1.0f / 128.0f) + NORM_EPS);
            const float* gp = A.dil_out_g + h * 128 + d0;
            u32x4 w;
            w.x = pk_fp8(v[0] * rstd * *(const f32x4*)gp); w.y = pk_fp8(v[1] * rstd * *(const f32x4*)(gp + 4));
            w.z = pk_fp8(v[2] * rstd * *(const f32x4*)(gp + 8)); w.w = pk_fp8(v[3] * rstd * *(const f32x4*)(gp + 12));
            *(u32x4*)(Y + (size_t)t * DM + 2048 + h * 128 + d0) = w;
        }
    }
}

__device__ __forceinline__ unsigned fkey(float f) { const unsigned b = __float_as_uint(f); return b ^ ((b >> 31) ? 0xFFFFFFFFu : 0x80000000u); }
__device__ __forceinline__ int mbcnt64(unsigned long long m) { return (int)__builtin_amdgcn_mbcnt_hi((unsigned)(m >> 32), __builtin_amdgcn_mbcnt_lo((unsigned)m, 0u)); }
template <int NR> __device__ __forceinline__ unsigned kth16_key(const unsigned (&key)[NR]) {
    unsigned T = 0u;
    for (int bit = 31; bit >= 0; --bit) {
        const unsigned cand = T | (1u << bit); int cnt = 0;
#pragma unroll
        for (int r = 0; r < NR; ++r) cnt += __builtin_popcountll(__ballot(key[r] >= cand));
        if (cnt >= 16) T = cand;
    }
    return T;
}
template <int NR> __device__ __forceinline__ void select16(const unsigned (&key)[NR], bool (&sel)[NR], int (&pos)[NR]) {
    const unsigned T = kth16_key<NR>(key);
    int cgt = 0;
#pragma unroll
    for (int r = 0; r < NR; ++r) cgt += __builtin_popcountll(__ballot(key[r] > T));
    const int need = 16 - cgt; int eqb = 0, selb = 0;
#pragma unroll
    for (int r = 0; r < NR; ++r) {
        const bool gt = key[r] > T, eq = key[r] == T;
        const unsigned long long beq = __ballot(eq);
        const bool s = gt || (eq && (eqb + mbcnt64(beq)) < need);
        const unsigned long long bs = __ballot(s);
        sel[r] = s; pos[r] = selb + mbcnt64(bs);
        selb += __builtin_popcountll(bs); eqb += __builtin_popcountll(beq);
    }
}
__device__ __forceinline__ float funkey(unsigned k) { return __uint_as_float((k & 0x80000000u) ? (k ^ 0x80000000u) : ~k); }
__device__ __forceinline__ void ins16(unsigned (&L)[16], unsigned x) {
#pragma unroll
    for (int i = 0; i < 16; ++i) { const unsigned hi = L[i] > x ? L[i] : x, lo = L[i] > x ? x : L[i]; L[i] = hi; x = lo; }
}
__device__ __forceinline__ void topk_phase(const Args& A, LAS unsigned char* lds, int gw, int ngw, int wave, int lane, int nwb = S * 16 / 64) {
    unsigned char* ws = A.ws;
    const float* SC = (const float*)(ws + WS_SC); int* IDX = (int*)(ws + WS_IDX); float* GATE = (float*)(ws + WS_GATE);
    LAS float* scr = (LAS float*)(lds + wave * 8448);
    LAS int* tab = (LAS int*)scr;
    for (int wb = gw; wb < nwb; wb += ngw) {
        const float* base = SC + (size_t)wb * 64 * 128;
        unsigned L[16];
#pragma unroll
        for (int i = 0; i < 16; ++i) L[i] = 0u;
        f32x4 ld[8], ln[8];
        const int lr = lane >> 3, lc = lane & 7;
#pragma unroll
        for (int i = 0; i < 8; ++i) ld[i] = *(const f32x4*)(base + (size_t)(8 * i + lr) * 128 + 4 * lc);
#pragma unroll
        for (int c = 0; c < 4; ++c) {
            if (c < 3) {
#pragma unroll
                for (int i = 0; i < 8; ++i) ln[i] = *(const f32x4*)(base + (size_t)(8 * i + lr) * 128 + 32 * (c + 1) + 4 * lc);
            }
#pragma unroll
            for (int i = 0; i < 8; ++i) { LAS float* d = scr + (8 * i + lr) * 33 + 4 * lc; d[0] = ld[i].x; d[1] = ld[i].y; d[2] = ld[i].z; d[3] = ld[i].w; }
            LDS_WAIT(); __builtin_amdgcn_wave_barrier();
#pragma unroll
            for (int j = 0; j < 32; ++j) { const float v = scr[lane * 33 + j]; ins16(L, (fkey(v) & ~127u) | (unsigned)(127 - (32 * c + j))); }
            LDS_WAIT(); __builtin_amdgcn_wave_barrier();
#pragma unroll
            for (int i = 0; i < 8; ++i) ld[i] = ln[i];
        }
        unsigned M[16];
#pragma unroll
        for (int i = 0; i < 16; ++i) M[i] = (unsigned)__shfl_down((int)L[i], 1);
        float av[16], bv[16];
#pragma unroll
        for (int i = 0; i < 16; ++i) { av[i] = funkey((L[i] & ~127u) | 64u); bv[i] = funkey((M[i] & ~127u) | 64u);
            tab[lane * 33 + i] = 127 - (int)(L[i] & 127u); tab[lane * 33 + 16 + i] = 127 - (int)(M[i] & 127u); }
        unsigned K2[16];
#pragma unroll
        for (int i = 0; i < 16; ++i) K2[i] = 0u;
#pragma unroll
        for (int i = 0; i < 16; ++i)
#pragma unroll
            for (int j = 0; j < 16; ++j)
                if ((i + 1) * (j + 1) <= 16) ins16(K2, (fkey(av[i] + bv[j]) & ~255u) | (unsigned)(255 - (i * 16 + j)));
        LDS_WAIT(); __builtin_amdgcn_wave_barrier();
        float fv[16]; int fe[16]; float sm = 0.f;
        const float mx = funkey((K2[0] & ~255u) | 128u);
#pragma unroll
        for (int q = 0; q < 16; ++q) { const int cid = 255 - (int)(K2[q] & 255u);
            fe[q] = tab[lane * 33 + (cid >> 4)] * 128 + tab[lane * 33 + 16 + (cid & 15)];
            fv[q] = __expf(funkey((K2[q] & ~255u) | 128u) - mx); sm += fv[q]; }
        const float inv = 1.0f / sm;
        if ((lane & 1) == 0) {
            const size_t o = ((size_t)wb * 32 + (lane >> 1)) * 16;
#pragma unroll
            for (int q = 0; q < 4; ++q) {
                *(u32x4*)(IDX + o + 4 * q) = (u32x4){(unsigned)fe[4 * q], (unsigned)fe[4 * q + 1], (unsigned)fe[4 * q + 2], (unsigned)fe[4 * q + 3]};
                *(f32x4*)(GATE + o + 4 * q) = (f32x4){fv[4 * q] * inv, fv[4 * q + 1] * inv, fv[4 * q + 2] * inv, fv[4 * q + 3] * inv};
            }
        }
        LDS_WAIT(); __builtin_amdgcn_wave_barrier();
    }
}

__device__ __forceinline__ float gelu_erf(float x) { return 0.5f * x * (1.0f + erff(x * 0.70710678118654752f)); }
__device__ __forceinline__ f32x2 fp8lo(unsigned w) { return __builtin_amdgcn_cvt_pk_f32_fp8((int)w, false); }
__device__ __forceinline__ f32x2 fp8hi(unsigned w) { return __builtin_amdgcn_cvt_pk_f32_fp8((int)w, true); }
__device__ __forceinline__ float dot16_fp8(const u32x4 w, const f32x2 (&hp)[8]) {
    f32x2 t = fp8lo(w.x) * hp[0];
    t = __builtin_elementwise_fma(fp8hi(w.x), hp[1], t); t = __builtin_elementwise_fma(fp8lo(w.y), hp[2], t); t = __builtin_elementwise_fma(fp8hi(w.y), hp[3], t);
    t = __builtin_elementwise_fma(fp8lo(w.z), hp[4], t); t = __builtin_elementwise_fma(fp8hi(w.z), hp[5], t); t = __builtin_elementwise_fma(fp8lo(w.w), hp[6], t);
    t = __builtin_elementwise_fma(fp8hi(w.w), hp[7], t);
    return t.x + t.y;
}
__device__ __forceinline__ float d2cv(unsigned w, bool hi, unsigned hpair, float acc) {
    return __builtin_amdgcn_fdot2_f32_bf16(hi ? __builtin_amdgcn_cvt_scalef32_pk_bf16_fp8(w, 1.0f, true) : __builtin_amdgcn_cvt_scalef32_pk_bf16_fp8(w, 1.0f, false), __builtin_bit_cast(bf16v2, hpair), acc, false); }
__device__ __forceinline__ float dot16_fp8_bf(const u32x4 w, const u32x4 h0, const u32x4 h1, float acc) {
    acc = d2cv(w.x, false, h0.x, acc); acc = d2cv(w.x, true, h0.y, acc); acc = d2cv(w.y, false, h0.z, acc); acc = d2cv(w.y, true, h0.w, acc);
    acc = d2cv(w.z, false, h1.x, acc); acc = d2cv(w.z, true, h1.y, acc); acc = d2cv(w.w, false, h1.z, acc); return d2cv(w.w, true, h1.w, acc);
}
__device__ __forceinline__ void axpy16_fp8(const u32x4 w, const float a, f32x2 (&o)[8]) {
    const f32x2 av = {a, a};
    o[0] = __builtin_elementwise_fma(fp8lo(w.x), av, o[0]); o[1] = __builtin_elementwise_fma(fp8hi(w.x), av, o[1]);
    o[2] = __builtin_elementwise_fma(fp8lo(w.y), av, o[2]); o[3] = __builtin_elementwise_fma(fp8hi(w.y), av, o[3]);
    o[4] = __builtin_elementwise_fma(fp8lo(w.z), av, o[4]); o[5] = __builtin_elementwise_fma(fp8hi(w.z), av, o[5]);
    o[6] = __builtin_elementwise_fma(fp8lo(w.w), av, o[6]); o[7] = __builtin_elementwise_fma(fp8hi(w.w), av, o[7]);
}
__device__ __forceinline__ void peer_phase(const Args& A, LAS unsigned char* lds, int G, int bid, int tid) {
    unsigned char* ws = A.ws;
    const bf16_t* H2 = (const bf16_t*)(ws + WS_H2);
    const int* IDX = (const int*)(ws + WS_IDX); const float* GATE = (const float*)(ws + WS_GATE);
    bf16_t* X1 = (bf16_t*)(ws + WS_X1); const float* g2 = (const float*)(ws + WS_MOD) + 5 * DM;
    const int grp = tid >> 3, sub = tid & 7, tok = grp >> 1, eh = grp & 1;
    const int srot = 4 * (int)(xb_xcc_id() & 7u);
    const unsigned so = (unsigned)sub * 16u;
    LAS int* lidx = (LAS int*)lds; LAS float* lact = (LAS float*)(lds + 16384); LAS float* lrs = (LAS float*)(lds + 32768);
    const LAS int* myidx = lidx + tok * 128 + eh * 64; const LAS float* myact = lact + tok * 128 + eh * 64;
    for (int tt = bid; tt < S / 32; tt += G) {
        const int t0 = tt * 32;
        topk_phase(A, lds + 40960, tt * 8 + (tid >> 6), 1 << 30, tid >> 6, tid & 63, tt * 8 + (tid >> 6) + 1);
        asm volatile("s_waitcnt vmcnt(0)" ::: "memory"); __syncthreads();
        for (int i = tid; i < 1024; i += 512) ((LAS u32x4*)lidx)[i] = ((const u32x4*)(IDX + (size_t)t0 * 128))[i];
        __syncthreads();
        float acc[64];
#pragma unroll
        for (int j = 0; j < 64; ++j) acc[j] = 0.f;
        for (int si = 0; si < 32; ++si) {
            const int s = (si + srot) & 31;
            const u32x4 h0 = *(const u32x4*)(H2 + (size_t)(t0 + tok) * DM + s * 128 + sub * 16), h1 = *(const u32x4*)(H2 + (size_t)(t0 + tok) * DM + s * 128 + sub * 16 + 8);
            const char* ub = (const char*)(ws + WS_UB) + (size_t)s * ((size_t)NEXP * 128);
#pragma unroll
            for (int eb = 0; eb < 64; eb += 16) {
                u32x4 id4[4];
#pragma unroll
                for (int k = 0; k < 4; ++k) id4[k] = *(const LAS u32x4*)(myidx + eb + 4 * k);
                u32x4 uv[16];
#pragma unroll
                for (int k = 0; k < 4; ++k) { uv[4 * k + 0] = *(const u32x4*)(ub + (id4[k].x * 128u + so)); uv[4 * k + 1] = *(const u32x4*)(ub + (id4[k].y * 128u + so));
                                              uv[4 * k + 2] = *(const u32x4*)(ub + (id4[k].z * 128u + so)); uv[4 * k + 3] = *(const u32x4*)(ub + (id4[k].w * 128u + so)); }
#pragma unroll
                for (int i = 0; i < 16; ++i) acc[eb + i] = dot16_fp8_bf(uv[i], h0, h1, acc[eb + i]);
                asm volatile("" ::: "memory");
            }
        }
        {
            float g8[8];
#pragma unroll
            for (int k = 0; k < 8; ++k) g8[k] = GATE[(size_t)(t0 + tok) * 128 + eh * 64 + 8 * k + sub];
            const bool b4 = (sub & 4) != 0, b2 = (sub & 2) != 0, b1 = (sub & 1) != 0;
            float a32[32], a16[16], a8[8];
#pragma unroll
            for (int p = 0; p < 32; ++p) { const int jl = (p >> 2) * 8 + (p & 3), jh = jl + 4;
                float x0 = acc[jl], x1 = acc[jh]; asm volatile("" : "+v"(x0), "+v"(x1));
                const float keep = b4 ? x1 : x0, send = b4 ? x0 : x1; a32[p] = keep + __shfl_xor(send, 4); }
#pragma unroll
            for (int p = 0; p < 16; ++p) { const int il = (p >> 1) * 4 + (p & 1), ih = il + 2;
                float x0 = a32[il], x1 = a32[ih]; asm volatile("" : "+v"(x0), "+v"(x1));
                const float keep = b2 ? x1 : x0, send = b2 ? x0 : x1; a16[p] = keep + __shfl_xor(send, 2); }
#pragma unroll
            for (int k = 0; k < 8; ++k) { float x0 = a16[2 * k], x1 = a16[2 * k + 1]; asm volatile("" : "+v"(x0), "+v"(x1));
                const float keep = b1 ? x1 : x0, send = b1 ? x0 : x1; a8[k] = keep + __shfl_xor(send, 1); }
#pragma unroll
            for (int k = 0; k < 8; ++k) lact[tok * 128 + eh * 64 + 8 * k + sub] = g8[k] * gelu_erf(a8[k] * (1.0f / 256.0f));
        }
        __syncthreads();
        float ssq = 0.f;
        for (int si = 0; si < 32; ++si) {
            const int s = (si + srot) & 31;
            const char* vb = (const char*)(ws + WS_VB) + (size_t)s * ((size_t)NEXP * 128);
            f32x2 o[8];
#pragma unroll
            for (int i = 0; i < 8; ++i) o[i] = (f32x2){0.f, 0.f};
#pragma unroll
            for (int eb = 0; eb < 64; eb += 16) {
                u32x4 id4[4]; f32x4 a4[4];
#pragma unroll
                for (int k = 0; k < 4; ++k) { id4[k] = *(const LAS u32x4*)(myidx + eb + 4 * k); a4[k] = *(const LAS f32x4*)(myact + eb + 4 * k); }
                u32x4 vv[16];
#pragma unroll
                for (int k = 0; k < 4; ++k) { vv[4 * k + 0] = *(const u32x4*)(vb + (id4[k].x * 128u + so)); vv[4 * k + 1] = *(const u32x4*)(vb + (id4[k].y * 128u + so));
                                              vv[4 * k + 2] = *(const u32x4*)(vb + (id4[k].z * 128u + so)); vv[4 * k + 3] = *(const u32x4*)(vb + (id4[k].w * 128u + so)); }
#pragma unroll
                for (int k = 0; k < 4; ++k) { axpy16_fp8(vv[4 * k + 0], a4[k].x, o); axpy16_fp8(vv[4 * k + 1], a4[k].y, o); axpy16_fp8(vv[4 * k + 2], a4[k].z, o); axpy16_fp8(vv[4 * k + 3], a4[k].w, o); }
                asm volatile("" ::: "memory");
            }
#pragma unroll
            for (int i = 0; i < 8; ++i) { o[i].x += __shfl_xor(o[i].x, 8); o[i].y += __shfl_xor(o[i].y, 8); }
            if (eh == 0) {
                const size_t off = (size_t)(t0 + tok) * DM + s * 128 + sub * 16;
#pragma unroll
                for (int q = 0; q < 4; ++q) {
                    const f32x4 xv = ld4bf(X1 + off + 4 * q); const f32x4 gv = *(const f32x4*)(g2 + s * 128 + sub * 16 + 4 * q) * (1.0f / 16.0f);
                    f32x4 r; r.x = xv.x + gv.x * o[2 * q].x; r.y = xv.y + gv.y * o[2 * q].y; r.z = xv.z + gv.z * o[2 * q + 1].x; r.w = xv.w + gv.w * o[2 * q + 1].y;
                    ssq += (r.x * r.x + r.y * r.y) + (r.z * r.z + r.w * r.w);
                    u32x2 w; w.x = cvt_pk(r.x, r.y); w.y = cvt_pk(r.z, r.w); *(u32x2*)(X1 + off + 4 * q) = w;
                }
            }
        }
        ssq += __shfl_xor(ssq, 1); ssq += __shfl_xor(ssq, 2); ssq += __shfl_xor(ssq, 4);
        if (eh == 0 && sub == 0) lrs[tok] = 1.0f / sqrtf(ssq * (1.0f / DM) + NORM_EPS);
        __syncthreads();
        for (int i0 = tid; i0 < 32 * 1024; i0 += 512 * 8) {
            u32x2 pv[8];
#pragma unroll
            for (int k = 0; k < 8; ++k) { const int i = i0 + 512 * k, tn = i >> 10, c4 = i & 1023; pv[k] = *((const u32x2*)(X1 + (size_t)(t0 + tn) * DM) + c4); }
#pragma unroll
            for (int k = 0; k < 8; ++k) { const int i = i0 + 512 * k, tn = i >> 10, c4 = i & 1023;
                const f32x4 xv = (f32x4){bf_lo(pv[k].x), bf_hi(pv[k].x), bf_lo(pv[k].y), bf_hi(pv[k].y)};
                *((f32x4*)(A.out + (size_t)(t0 + tn) * DM) + c4) = xv * lrs[tn] * ((const f32x4*)A.final_g)[c4]; }
        }
        __syncthreads();
    }
}

#ifdef DBG_CHECK
__device__ __forceinline__ void dbg_flag(unsigned char* ws, int bit) { atomicOr((unsigned*)(ws + WS_CTL + 65536), 1u << bit); }
__device__ __forceinline__ void dbg_phase(const Args& A, LAS unsigned char* lds, int bid, int tid) {
    unsigned char* ws = A.ws;
    const int lane = tid & 63, wave = __builtin_amdgcn_readfirstlane(tid >> 6);
    const bf16_t* H2 = (const bf16_t*)(ws + WS_H2); const float* SC = (const float*)(ws + WS_SC);
    const int* IDX = (const int*)(ws + WS_IDX); const float* GATE = (const float*)(ws + WS_GATE);
    const float* X1 = (const float*)(ws + WS_X1); const float* mod = (const float*)(ws + WS_MOD);
    if (wave != 0) return;
    if (bid < 4) {
        const int t = bid == 0 ? 5 : (bid == 1 ? 1234 : (bid == 2 ? 4097 : 8191)), g = (3 * bid + 5) & 15;
        LAS float* q = (LAS float*)lds;
        float q0 = 0.f, q1 = 0.f;
        for (int d = 0; d < DM; ++d) { const float hv = __uint_as_float(((unsigned)H2[(size_t)t * DM + d]) << 16);
            q0 += hv * A.peer_wq[(size_t)d * 2048 + g * 128 + lane]; q1 += hv * A.peer_wq[(size_t)d * 2048 + g * 128 + 64 + lane]; }
        q[lane] = q0; q[lane + 64] = q1; LDS_WAIT(); __builtin_amdgcn_wave_barrier();
        bool bad = false;
        for (int r = 0; r < 2; ++r) { const int n = lane + 64 * r; float s = 0.f;
            for (int k = 0; k < 128; ++k) s += q[k] * A.peer_subkeys[(size_t)g * 16384 + n * 128 + k];
            const float got = SC[(size_t)t * 2048 + g * 128 + n];
            if (!(fabsf(got - s) <= 0.03f * fabsf(s) + 0.03f)) bad = true; }
        if (__any(bad) && lane == 0) dbg_flag(ws, 0);
    } else if (bid < 8) {
        const int b = bid - 4, t = b == 0 ? 5 : (b == 1 ? 1234 : (b == 2 ? 4097 : 8191)), h = (2 * b + 1) & 7;
        LAS float* sv = (LAS float*)lds;
        LAS int* si = (LAS int*)(lds + 2048);
        LAS float* fv = (LAS float*)(lds + 4096);
        for (int i = lane; i < 256; i += 64) sv[i] = SC[(size_t)t * 2048 + h * 256 + i];
        LDS_WAIT(); __builtin_amdgcn_wave_barrier();
        if (lane == 0) {
            for (int p = 0; p < 2; ++p) for (int k = 0; k < 16; ++k) { float best = -3e38f; int bi = 0;
                for (int n = 0; n < 128; ++n) { const float x = sv[p * 128 + n]; if (x > best) { best = x; bi = n; } }
                sv[256 + p * 16 + k] = best; si[p * 16 + k] = bi; sv[p * 128 + bi] = -3e38f; }
            for (int a = 0; a < 16; ++a) for (int c = 0; c < 16; ++c) fv[16 + a * 16 + c] = sv[256 + a] + sv[272 + c];
            float mx = -3e38f;
            for (int k = 0; k < 16; ++k) { float best = -3e38f; int bi = 0;
                for (int c = 0; c < 256; ++c) { const float x = fv[16 + c]; if (x > best) { best = x; bi = c; } }
                fv[k] = best; si[32 + k] = si[bi >> 4] * 128 + si[16 + (bi & 15)]; fv[16 + bi] = -3e38f; if (best > mx) mx = best; }
            float sm = 0.f; for (int k = 0; k < 16; ++k) sm += __expf(fv[k] - mx);
            bool bad = false;
            for (int k = 0; k < 16; ++k) { const float gk = __expf(fv[k] - mx) / sm; bool found = false;
                for (int j = 0; j < 16; ++j) if (IDX[(size_t)t * 128 + h * 16 + j] == si[32 + k]) { found = true; if (fabsf(GATE[(size_t)t * 128 + h * 16 + j] - gk) > 2e-3f) bad = true; }
                if (!found && gk > 0.02f) bad = true; }
            if (bad) dbg_flag(ws, 1);
        }
    } else if (bid < 12) {
        const int b = bid - 8, t = b == 0 ? 5 : (b == 1 ? 1234 : (b == 2 ? 4097 : 8191));
        LAS float* av = (LAS float*)lds;
        for (int j = 0; j < 128; ++j) { const int e = IDX[(size_t)t * 128 + j]; float s = 0.f;
            for (int d = lane; d < DM; d += 64) s += __uint_as_float(((unsigned)H2[(size_t)t * DM + d]) << 16) * A.peer_u[(size_t)e * DM + d];
            s = wave_sum(s); if (lane == 0) av[j] = GATE[(size_t)t * 128 + j] * gelu_erf(s); }
        LDS_WAIT(); __builtin_amdgcn_wave_barrier();
        float ss = 0.f;
        for (int d = lane; d < DM; d += 64) { float o = 0.f;
            for (int j = 0; j < 128; ++j) o += av[j] * A.peer_v[(size_t)IDX[(size_t)t * 128 + j] * DM + d];
            const float x2 = X1[(size_t)t * DM + d] + mod[5 * DM + d] * o; ss += x2 * x2; }
        ss = wave_sum(ss); const float rstd = 1.0f / sqrtf(ss / DM + NORM_EPS);
        bool bad = false;
        for (int d = lane; d < DM; d += 64) { float o = 0.f;
            for (int j = 0; j < 128; ++j) o += av[j] * A.peer_v[(size_t)IDX[(size_t)t * 128 + j] * DM + d];
            const float ref = (X1[(size_t)t * DM + d] + mod[5 * DM + d] * o) * rstd * A.final_g[d];
            if (!(fabsf(A.out[(size_t)t * DM + d] - ref) <= 0.02f * fabsf(ref) + 0.02f)) bad = true; }
        if (__any(bad) && lane == 0) dbg_flag(ws, 2);
    } else if (bid < 16) {
        const int b = bid - 12, t = b == 0 ? 5 : (b == 1 ? 1234 : (b == 2 ? 4097 : 8191));
        float ss = 0.f; for (int d = lane; d < DM; d += 64) { const float x = X1[(size_t)t * DM + d]; ss += x * x; }
        ss = wave_sum(ss); const float rstd = 1.0f / sqrtf(ss / DM + NORM_EPS); bool bad = false;
        for (int d = lane; d < DM; d += 64) { const float ref = X1[(size_t)t * DM + d] * rstd * A.norm2_g[d] * (1.0f + mod[4 * DM + d]) + mod[3 * DM + d];
            const float got = __uint_as_float(((unsigned)H2[(size_t)t * DM + d]) << 16);
            if (!(fabsf(got - ref) <= 0.01f * fabsf(ref) + 0.01f)) bad = true; }
        if (__any(bad) && lane == 0) dbg_flag(ws, 3);
    } else if (bid < 20) {
        const int b = bid - 16; bool bad = false;
        for (int r = 0; r < 6; ++r) { const int n = r * DM + 37 * lane + 500 * b; float s = 0.f;
            for (int k = 0; k < DM; ++k) { const float cv = A.c[k]; s += cv / (1.0f + __expf(-cv)) * A.w_ada[(size_t)k * NADA + n]; }
            s += A.b_ada[n]; if (!(fabsf(mod[n] - s) <= 1e-3f * fabsf(s) + 1e-3f)) bad = true; }
        if (__any(bad) && lane == 0) dbg_flag(ws, 4);
    } else if (bid < 24) {
        const int b = bid - 20, g = (5 * b + 2) & 15, n = 17 * b + 3; bool bad = false;
        const bf16_t* wsc = (const bf16_t*)(ws + WS_WSC);
        for (int d = lane; d < DM; d += 64) { float s = 0.f;
            for (int k = 0; k < 128; ++k) s += A.peer_subkeys[(size_t)g * 16384 + n * 128 + k] * A.peer_wq[(size_t)d * 2048 + g * 128 + k];
            const float got = __uint_as_float(((unsigned)wsc[(size_t)(g * 128 + n) * DM + d]) << 16);
            if (!(fabsf(got - s) <= 0.01f * fabsf(s) + 2e-4f)) bad = true; }
        if (__any(bad) && lane == 0) dbg_flag(ws, 5);
    }
}
__device__ __forceinline__ void dbg_emit(const Args& A, int bid, int tid, int G) {
    const unsigned mask = *(const unsigned*)(A.ws + WS_CTL + 65536);
    const float cval = sqrtf((float)mask + 1.0f);
    for (size_t i = (size_t)bid * 512 + tid; i < (size_t)S * DM; i += (size_t)G * 512) A.out[i] = cval;
}
#endif
__global__ void __launch_bounds__(512, 2) hymba_fwd(Args A) {
    extern __shared__ __attribute__((aligned(16))) unsigned char lds_raw[];
    LAS unsigned char* lds = (LAS unsigned char*)lds_raw;
    const int tid = threadIdx.x, lane = tid & 63, wave = __builtin_amdgcn_readfirstlane(tid >> 6);
    const int G = gridDim.x, bid = blockIdx.x;
    const int gw = bid * 8 + wave, ngw = G * 8;
    unsigned char* ws = A.ws;
    for (int u = tid; u < (LDS_BYTES - RING_BYTES) / 4; u += 512) ((LAS unsigned*)(lds + RING_BYTES))[u] = 0u;
    __syncthreads();
    XcdBarrier bar; bar.bar = (unsigned*)(ws + WS_CTL) + CW_BAR; bar.x = 0; bar.st = nullptr;
    if (MK_N_LAUNCHES == 1) bar = xcd_barrier_post((unsigned*)(ws + WS_CTL) + CW_BAR, (volatile LAS unsigned*)(lds + MISC_OFF + 32));
    const int lo = A.ph_lo, hi = A.ph_hi;
#ifndef PH_MASK
#define PH_MASK 0xfff
#endif
#define IN(k) (((PH_MASK >> (k)) & 1) && lo <= (k) && (k) < hi)
#define REP(k) (((REP_MASK >> (k)) & 1) ? 2 : 1)
#ifdef DBG_TIME
#define SEAM(k) do { if (IN(k) && IN((k) + 1)) xcd_barrier(bar); if (bid == 0 && tid == 0) ((unsigned long long*)(ws + WS_CTL + 32768))[(k) + 1] = __builtin_amdgcn_s_memrealtime(); } while (0)
#else
#define SEAM(k) do { if (IN(k) && IN((k) + 1)) xcd_barrier(bar); } while (0)
#endif
    float* mod = (float*)(ws + WS_MOD);
#ifdef DBG_TIME
    if (bid == 0 && tid == 0) ((unsigned long long*)(ws + WS_CTL + 32768))[0] = __builtin_amdgcn_s_memrealtime();
#endif

    if (IN(0)) for (int rep_ = 0; rep_ < REP(0); ++rep_) { p0_prologue(A, lds, G, bid, tid); }
    SEAM(0);
    if (IN(1)) for (int rep_ = 0; rep_ < REP(1); ++rep_) { row_modulate<false, true>(A.x, A.norm1_g, mod + 0 * DM, mod + 1 * DM, (bf16_t*)(ws + WS_H1), ws + WS_H1F8, (LAS float*)lds, tid, gw, ngw, lane); }
    SEAM(1);
    if (IN(2)) for (int rep_ = 0; rep_ < REP(2); ++rep_) {
        {
            pg8::Gemm g{(const bf16_t*)(ws + WS_H1), (const bf16_t*)(ws + WS_WIN), S, 8192, DM}; pg8::StaticOrder So; So.init(S, 8192, G, bid);
            EpiQKV E{(bf16_t*)(ws + WS_QKV), (bf16_t*)(ws + WS_QKV2), (const float*)(ws + WS_ROPE), 0};
            pg8::gemm_phase<EpiQKV, pg8::StaticOrder, false>(lds, g, So, E, nullptr);
        }
        __syncthreads();
        {
            pg8::Gemm g{(const bf16_t*)(ws + WS_H1F8), (const bf16_t*)(ws + WS_WIN + WIN8_OFF), S, 4096, DM / 2}; pg8::StaticOrder So; So.init(S, 4096, G, bid);
            EpiSV E{(bf16_t*)(ws + WS_QKV), (bf16_t*)(ws + WS_QKV2)};
            pg8::gemm_phase<EpiSV, pg8::StaticOrder, false, true>(lds, g, So, E, nullptr);
        }
    }
    SEAM(2);
    if (IN(3)) for (int rep_ = 0; rep_ < REP(3); ++rep_) { attn_phase(A, (char*)lds_raw, G, bid); }
    SEAM(3);
    if (IN(4)) for (int rep_ = 0; rep_ < REP(4); ++rep_) { combine_phase(A, gw, ngw, lane); }
    SEAM(4);
    if (IN(5)) for (int rep_ = 0; rep_ < REP(5); ++rep_) {
        pg8::Gemm g{(const bf16_t*)(ws + WS_Y), (const bf16_t*)(ws + WS_WOUT), S, DM, DM / 2}; pg8::StaticOrder So; So.init(S, DM, G, bid);
        EpiResid E{A.x, mod + 2 * DM, (bf16_t*)(ws + WS_X1)};
        pg8::gemm_phase<EpiResid, pg8::StaticOrder, false, true>(lds, g, So, E, nullptr);
    }
    SEAM(5);
    if (IN(6)) for (int rep_ = 0; rep_ < REP(6); ++rep_) { row_modulate<true, false>(ws + WS_X1, A.norm2_g, mod + 3 * DM, mod + 4 * DM, (bf16_t*)(ws + WS_H2), nullptr, (LAS float*)lds, tid, gw, ngw, lane); }
    SEAM(6);
    if (IN(7)) for (int rep_ = 0; rep_ < REP(7); ++rep_) {
        pg8::Gemm g{(const bf16_t*)(ws + WS_H2), (const bf16_t*)(ws + WS_WSC), S, 2048, DM}; pg8::StaticOrder So; So.init(S, 2048, G, bid);
#ifdef PROBE_FLAGS
        if (A.flag & 2) g.K = DM / 2;
        if (A.flag & 4) g.K = 256;
#endif
        pg8::EpiF32 E{(float*)(ws + WS_SC), 2048, nullptr};
        pg8::gemm_phase<pg8::EpiF32, pg8::StaticOrder, false>(lds, g, So, E, nullptr);
    }
    SEAM(7);
    if (IN(9)) for (int rep_ = 0; rep_ < REP(9); ++rep_) { peer_phase(A, lds, G, bid, tid); }
#ifdef DBG_TIME
    xcd_barrier(bar);
    if (bid == 0 && tid == 0) ((unsigned long long*)(ws + WS_CTL + 32768))[10] = __builtin_amdgcn_s_memrealtime();
    xcd_barrier(bar);
    {
        const unsigned long long* ts = (const unsigned long long*)(ws + WS_CTL + 32768);
        const float d1 = (float)(ts[DBG_T1 + 1] - ts[DBG_T1]) * 0.01f, d2 = (float)(ts[DBG_T2 + 1] - ts[DBG_T2]) * 0.01f;
        const float cval = sqrtf(fmaxf(d1 * 0.1f, 0.f));
        for (size_t i = (size_t)bid * 512 + tid; i < (size_t)S * DM; i += (size_t)G * 512) A.out[i] = (i == 0) ? 10.0f * d2 : cval;
    }
#endif
#undef IN
#undef SEAM
}

#ifdef DBG_CHECK
__global__ void __launch_bounds__(512) dbg_kernel(Args A, int which) {
    __shared__ __attribute__((aligned(16))) unsigned char dl[8192];
    if (which == 0) dbg_phase(A, (LAS unsigned char*)dl, blockIdx.x, threadIdx.x);
    else dbg_emit(A, blockIdx.x, threadIdx.x, gridDim.x);
}
#endif
extern "C" void kernel_launch(void* const* d_in, const int* in_sizes, int n_in, void* d_out, int out_size, void* d_ws, size_t ws_size, hipStream_t stream) {
    static int grid = 0;
    if (grid == 0) {
        if (n_in != 20 || out_size != S * DM || ws_size < WS_END) { fprintf(stderr, "kernel_launch: unexpected shapes (n_in %d out %d ws %zu)\n", n_in, out_size, ws_size); grid = -1; return; }
        int dev = 0, cus = 0, per_cu = 0;
        if (hipGetDevice(&dev) != hipSuccess || hipDeviceGetAttribute(&cus, hipDeviceAttributeMultiprocessorCount, dev) != hipSuccess) { grid = -1; return; }
        if (hipFuncSetAttribute((const void*)hymba_fwd, hipFuncAttributeMaxDynamicSharedMemorySize, LDS_BYTES) != hipSuccess) { fprintf(stderr, "kernel_launch: hipFuncSetAttribute failed\n"); grid = -1; return; }
        if (hipOccupancyMaxActiveBlocksPerMultiprocessor(&per_cu, (const void*)hymba_fwd, 512, LDS_BYTES) != hipSuccess || per_cu < 1) fprintf(stderr, "kernel_launch: occupancy query reports %d\n", per_cu);
        (void)hipGetLastError();
        grid = cus;
    }
    if (grid < 0) return;
    (void)hipMemsetAsync((char*)d_ws + WS_CTL, 0, CTL_ZERO_BYTES, stream);
    Args a{};
    a.x = (const float*)d_in[0]; a.c = (const float*)d_in[1]; a.positions = (const int*)d_in[2]; a.norm1_g = (const float*)d_in[3]; a.norm2_g = (const float*)d_in[4];
    a.w_ada = (const float*)d_in[5]; a.b_ada = (const float*)d_in[6]; a.w_in = (const float*)d_in[7]; a.lam_q1 = (const float*)d_in[8]; a.lam_k1 = (const float*)d_in[9];
    a.lam_q2 = (const float*)d_in[10]; a.lam_k2 = (const float*)d_in[11]; a.diff_subln_g = (const float*)d_in[12]; a.dil_out_g = (const float*)d_in[13];
    a.w_out = (const float*)d_in[14]; a.peer_wq = (const float*)d_in[15]; a.peer_subkeys = (const float*)d_in[16]; a.peer_u = (const float*)d_in[17]; a.peer_v = (const float*)d_in[18];
    a.final_g = (const float*)d_in[19];
    a.out = (float*)d_out; a.ws = (unsigned char*)d_ws;
    if (MK_N_LAUNCHES == 1) { a.ph_lo = 0; a.ph_hi = NPHASE; hipLaunchKernelGGL(hymba_fwd, dim3(grid), dim3(512), LDS_BYTES, stream, a); }
    else { for (int p = 0; p < NPHASE; ++p) { a.ph_lo = p; a.ph_hi = p + 1; const int nr = ((REP_MASK >> p) & 1) ? 2 : 1;
            for (int r = 0; r < nr; ++r) { a.flag = (nr == 2 && r == 0) ? PROBE_FLAG_VAL : 0; hipLaunchKernelGGL(hymba_fwd, dim3(grid), dim3(512), LDS_BYTES, stream, a); } } }
#ifdef DBG_CHECK
    hipLaunchKernelGGL(dbg_kernel, dim3(grid), dim3(512), 0, stream, a, 0);
    hipLaunchKernelGGL(dbg_kernel, dim3(grid), dim3(512), 0, stream, a, 1);
#endif
}
```

```cpp
#include <hip/hip_runtime.h>
#include <cstdint>
#include <cstdio>

#define REP_MASK 0x000
#define PROBE_FLAG_VAL 0
#ifndef MK_N_LAUNCHES
#define MK_N_LAUNCHES 1
#endif
constexpr int NPHASE = 10;

constexpr int S = 8192, DM = 4096, NIN = 12288, NADA = 24576, NEXP = 16384;
constexpr float NORM_EPS = 1e-6f;
constexpr float LAM_INIT = 0.2f;

constexpr size_t MiB = 1u << 20;
constexpr size_t WS_CTL = 0, CTL_ZERO_BYTES = 128 * 1024;
constexpr size_t WS_MOD = 1 * MiB;
constexpr size_t WS_LAM = 1 * MiB + 128 * 1024;
constexpr size_t WS_ROPE = 2 * MiB;
constexpr size_t WS_WIN = 4 * MiB;
constexpr size_t WS_WOUT = 100 * MiB;
constexpr size_t WS_WSC = 132 * MiB;
constexpr size_t WS_UB = 148 * MiB;
constexpr size_t WS_VB = 276 * MiB;
constexpr size_t WS_H1 = 404 * MiB;
constexpr size_t WS_Y = 468 * MiB;
constexpr size_t WS_H2 = 532 * MiB;
constexpr size_t WS_QKV = 596 * MiB;
constexpr size_t QKV_T = (size_t)16 * S * 128;
constexpr size_t WS_OD = 788 * MiB;
constexpr size_t WS_OS = 916 * MiB;
constexpr size_t WS_H1F8 = 1012 * MiB;
constexpr size_t WIN8_OFF = 64 * MiB;
constexpr size_t WS_LSE = 1108 * MiB;
constexpr size_t WS_X1 = 1110 * MiB;
constexpr size_t WS_SC = 1238 * MiB;
constexpr size_t WS_IDX = 1302 * MiB;
constexpr size_t WS_GATE = 1306 * MiB;
constexpr size_t WS_QKV2 = 1310 * MiB;
constexpr size_t WS_END = 1502 * MiB;
constexpr int CW_BAR = 4096;

constexpr int RING_BYTES = 131072;
constexpr int MISC_OFF = RING_BYTES + 320;
constexpr int LDS_BYTES = 147456;

namespace pg8 {
#define PG8_LAS __attribute__((address_space(3)))
typedef unsigned short bf16_t;
typedef short bf16x8 __attribute__((ext_vector_type(8)));
typedef float f32x4 __attribute__((ext_vector_type(4)));
typedef unsigned u32x4 __attribute__((ext_vector_type(4)));
constexpr int BM = 256, BK = 64, HALF = 128, HTB = HALF * BK * 2  , STAGE_BYTES = 8 * HTB, NXCD = 8, WGM = 8;

__host__ __device__ __forceinline__ int lds_byte(int r, int c) { const int st = (r >> 4) * 2 + (c >> 5), rr = r & 15, cc = c & 31, ob = rr * 64 + cc * 2; return st * 1024 + (ob ^ (((ob >> 9) & 1) << 5)); }
__host__ __device__ __forceinline__ void stage_rc(int b, int& R, int& C) { const int st = b / 1024, sb = b % 1024, swz = sb ^ (((sb >> 9) & 1) << 5); R = (st >> 1) * 16 + swz / 64; C = (st & 1) * 32 + (swz % 64) / 2; }
__host__ __device__ __forceinline__ int perm32(int rho) { const int n = rho >> 4, i = rho & 15; return 8 * (i >> 2) + 4 * n + (i & 3); }

struct Unit { int pm, pn; };
struct Gemm { const bf16_t* A; const bf16_t* Bt; int M, N, K; };

struct StaticOrder {
    int nM, nN, nwg, G, c;
    __host__ __device__ void init(int M, int N, int G_, int c_) { nM = M / BM; nN = N / BM; nwg = nM * nN; G = G_; c = c_; }
    __host__ __device__ bool next(int i, Unit& u) const {
        const long L = (long)i * G + c; if (L >= nwg) return false;
        int wgid = (int)L; { const int q = nwg / NXCD, r = nwg % NXCD, xcd = wgid % NXCD, off = wgid / NXCD; wgid = (xcd < r ? xcd * (q + 1) : r * (q + 1) + (xcd - r) * q) + off; }
        const int nig = WGM * nN, gid = wgid / nig, fm = gid * WGM, gsz = (nM - fm) < WGM ? (nM - fm) : WGM;
        u.pm = fm + ((wgid % nig) % gsz); u.pn = (wgid % nig) / gsz; return true;
    }
    __device__ __forceinline__ void a_ready(const Unit&) const {}
    __device__ __forceinline__ void done(const Unit&) const {}
};
struct CountedOrder : StaticOrder {
    const unsigned* ready; unsigned need; unsigned* tmo;
    __device__ __forceinline__ void a_ready(const Unit& u) const {
        if (threadIdx.x < 64) {
            const unsigned long long t0 = __builtin_amdgcn_s_memrealtime(); unsigned polls = 0;
            while ((unsigned)__builtin_amdgcn_readfirstlane(__hip_atomic_load(ready + 64 * u.pm, __ATOMIC_RELAXED, __HIP_MEMORY_SCOPE_AGENT)) < need) {
                if ((++polls & 255u) == 0u && __builtin_amdgcn_readfirstlane(__hip_atomic_load(tmo, __ATOMIC_RELAXED, __HIP_MEMORY_SCOPE_AGENT)) != 0u) break;
                if (__builtin_amdgcn_s_memrealtime() - t0 > 2000000ull) {
                    if (threadIdx.x == 0) { unsigned expect = 0u; __hip_atomic_compare_exchange_strong(tmo + 1, &expect, 0x600u | (unsigned)(u.pm & 0xff), __ATOMIC_RELAXED, __ATOMIC_RELAXED, __HIP_MEMORY_SCOPE_AGENT); __hip_atomic_store(tmo, 1u, __ATOMIC_RELAXED, __HIP_MEMORY_SCOPE_AGENT); }
                    break; }
                __builtin_amdgcn_s_sleep(2); }
            __builtin_amdgcn_fence(__ATOMIC_ACQUIRE, "agent");
            asm volatile("s_waitcnt vmcnt(0)" ::: "memory");
        }
#if !defined(BROKEN_HOOK_NO_BARRIER)
        asm volatile("" ::: "memory"); __builtin_amdgcn_s_barrier(); asm volatile("" ::: "memory");
#endif
    }
};

__device__ __forceinline__ unsigned cvt_pk_bf16(float lo, float hi) { unsigned r; asm volatile("v_cvt_pk_bf16_f32 %0, %1, %2" : "=v"(r) : "v"(lo), "v"(hi)); return r; }
typedef float f32x2 __attribute__((ext_vector_type(2)));
__device__ __forceinline__ f32x2 gelu_pk(f32x2 v) {
    const f32x2 av = __builtin_elementwise_abs(v), d = av * 0.2316418882f + 1.0f;
    f32x2 t; t.x = __builtin_amdgcn_rcpf(d.x); t.y = __builtin_amdgcn_rcpf(d.y);
    f32x2 q = t * 0.5307027145f + (-0.7265760135f); q = q * t + 0.7107068705f; q = q * t + (-0.142248368f); q = q * t + 0.127414796f; q = q * t;
    const f32x2 s = (v * v) * (-0.72134752044f);
    f32x2 e; e.x = __builtin_amdgcn_exp2f(s.x); e.y = __builtin_amdgcn_exp2f(s.y);
    const f32x2 m = v * (q * e), r = v - m;
    f32x2 o; o.x = v.x < 0.f ? m.x : r.x; o.y = v.y < 0.f ? m.y : r.y; return o;
}

struct EpiF32 {
    static constexpr bool PERM = false, AFTER_DRAIN = false;
    float* C; int ldc; const float* bias;
    __device__ __forceinline__ void operator()(const f32x4 (&acc)[2][2][4][2], const Unit& u, int wr, int wc, int fr, int fq) const {
        const int row0 = u.pm * BM + wr * 64 + fr, col0 = u.pn * BM + wc * 32 + 4 * fq;
        f32x4 bv[2][2];
#pragma unroll
        for (int bj = 0; bj < 2; ++bj)
#pragma unroll
            for (int n = 0; n < 2; ++n) bv[bj][n] = bias ? *(const f32x4*)(bias + col0 + bj * HALF + n * 16) : (f32x4){0.f, 0.f, 0.f, 0.f};
#pragma unroll
        for (int ai = 0; ai < 2; ++ai)
#pragma unroll
            for (int m = 0; m < 4; ++m) { float* rowp = C + (size_t)(row0 + ai * HALF + m * 16) * ldc + col0;
#pragma unroll
                for (int bj = 0; bj < 2; ++bj)
#pragma unroll
                    for (int n = 0; n < 2; ++n) *(f32x4*)(rowp + bj * HALF + n * 16) = acc[ai][bj][m][n] + bv[bj][n]; }
    }
};
template <int ACT  > struct EpiBf16 {
    static constexpr bool PERM = true, AFTER_DRAIN = false;
    bf16_t* O; int ldc; const float* bias; int split_cols; size_t split_stride;
    __device__ __forceinline__ void operator()(const f32x4 (&acc)[2][2][4][2], const Unit& u, int wr, int wc, int fr, int fq) const {
        const int row0 = u.pm * BM + wr * 64 + fr; int colt = u.pn * BM; bf16_t* base = O;
        if (split_cols) { const int t = colt / split_cols; base += (size_t)t * split_stride; colt -= t * split_cols; }
        const int col0 = colt + wc * 32 + 8 * fq, bcol0 = u.pn * BM + wc * 32 + 8 * fq;
        f32x4 bv[2][2];
#pragma unroll
        for (int bj = 0; bj < 2; ++bj)
#pragma unroll
            for (int n = 0; n < 2; ++n) bv[bj][n] = bias ? *(const f32x4*)(bias + bcol0 + bj * HALF + 4 * n) : (f32x4){0.f, 0.f, 0.f, 0.f};
#pragma unroll
        for (int ai = 0; ai < 2; ++ai)
#pragma unroll
            for (int m = 0; m < 4; ++m) { bf16_t* rowp = base + (size_t)(row0 + ai * HALF + m * 16) * ldc + col0;
#pragma unroll
                for (int bj = 0; bj < 2; ++bj) { f32x4 v0 = acc[ai][bj][m][0] + bv[bj][0], v1 = acc[ai][bj][m][1] + bv[bj][1];
                    if (ACT == 1) { f32x2 a = gelu_pk((f32x2){v0[0], v0[1]}), b = gelu_pk((f32x2){v0[2], v0[3]}), c = gelu_pk((f32x2){v1[0], v1[1]}), d = gelu_pk((f32x2){v1[2], v1[3]});
                        v0 = (f32x4){a.x, a.y, b.x, b.y}; v1 = (f32x4){c.x, c.y, d.x, d.y}; }
                    if (ACT == 2) {
#pragma unroll
                        for (int j = 0; j < 4; ++j) { v0[j] = 0.5f * v0[j] * (1.0f + erff(v0[j] * 0.70710678f)); v1[j] = 0.5f * v1[j] * (1.0f + erff(v1[j] * 0.70710678f)); } }
                    u32x4 w; w.x = cvt_pk_bf16(v0[0], v0[1]); w.y = cvt_pk_bf16(v0[2], v0[3]); w.z = cvt_pk_bf16(v1[0], v1[1]); w.w = cvt_pk_bf16(v1[2], v1[3]);
                    *(u32x4*)(rowp + bj * HALF) = w; } }
    }
};
template <class Epi, class Sched, bool STAMP = false, bool F8 = false>
__device__ __forceinline__ void gemm_phase(PG8_LAS unsigned char* lds, const Gemm g, const Sched& S, const Epi& E, unsigned long long* stamps) {
    const int tid = threadIdx.x, wid = __builtin_amdgcn_readfirstlane(tid >> 6), lane = tid & 63, wr = wid >> 2, wc = wid & 3, fr = lane & 15, fq = lane >> 4;
    const int K = g.K, nt = K / BK;
    int ts_lo = 0, ts_hi = 0, nts = 0; const unsigned long long rt_entry = STAMP ? (unsigned long long)wall_clock64() : 0ull;
#define PG8_STAMP() do { if (STAMP && wid == 0 && nts < 64) { const unsigned long long _c = (unsigned long long)clock64(); \
        ts_lo = (lane == nts) ? (int)(unsigned)_c : ts_lo; ts_hi = (lane == nts) ? (int)(unsigned)(_c >> 32) : ts_hi; ++nts; } } while (0)
    PG8_STAMP();
    unsigned voffA[2], voffB[2];
#pragma unroll
    for (int i = 0; i < 2; ++i) { int R, C; stage_rc(tid * 16 + i * 8192, R, C); const int Rb = Epi::PERM ? ((R & ~31) + perm32(R & 31)) : R;
        voffA[i] = (unsigned)(R * K + C) * 2u; voffB[i] = (unsigned)(Rb * K + C) * 2u; }
    const size_t kstep = (size_t)(BK * 2);
    const size_t hstep = (size_t)HALF * K * 2;
    const size_t tstep = 2 * hstep;
    const unsigned ldsw = (unsigned)wid * 1024u;
    const int aoff = lds_byte(wr * 64 + fr, fq * 8), boff = lds_byte(wc * 32 + fr, fq * 8);
#define PG8_SA(b, h) (((b) * 2 + (h)) * HTB)
#define PG8_SB(b, h) ((4 + (b) * 2 + (h)) * HTB)
#define PG8_STAGE(bufoff, gbase, voff) do { _Pragma("unroll") for (int _i = 0; _i < 2; ++_i) \
        __builtin_amdgcn_global_load_lds((const unsigned*)((const char*)(gbase) + (voff)[_i]), (PG8_LAS unsigned*)(lds + (bufoff) + ldsw + _i * 8192), 16, 0, 0); } while (0)
typedef int pg8_i32x4 __attribute__((ext_vector_type(4))); typedef int pg8_i32x8 __attribute__((ext_vector_type(8)));
#define PG8_LD8(addr) __builtin_shufflevector(*(const PG8_LAS pg8_i32x4*)(addr), *(const PG8_LAS pg8_i32x4*)((addr) + 1024), 0, 1, 2, 3, 4, 5, 6, 7)
#define PG8_LDA(dst, b, h) do { if constexpr (F8) { _Pragma("unroll") for (int m = 0; m < 4; ++m) dst##8[m] = PG8_LD8(lds + PG8_SA(b, h) + aoff + m * 2048); } \
        else { _Pragma("unroll") for (int m = 0; m < 4; ++m) _Pragma("unroll") for (int k = 0; k < 2; ++k) dst[m][k] = *(const PG8_LAS bf16x8*)(lds + PG8_SA(b, h) + aoff + m * 2048 + k * 1024); } } while (0)
#define PG8_LDB(dst, b, h) do { if constexpr (F8) { _Pragma("unroll") for (int n = 0; n < 2; ++n) dst##8[n] = PG8_LD8(lds + PG8_SB(b, h) + boff + n * 2048); } \
        else { _Pragma("unroll") for (int n = 0; n < 2; ++n) _Pragma("unroll") for (int k = 0; k < 2; ++k) dst[n][k] = *(const PG8_LAS bf16x8*)(lds + PG8_SB(b, h) + boff + n * 2048 + k * 1024); } } while (0)
#define PG8_MMA(ai, bj, At, Bt) do { __builtin_amdgcn_s_setprio(1); _Pragma("unroll") for (int m = 0; m < 4; ++m) _Pragma("unroll") for (int n = 0; n < 2; ++n) { \
        if constexpr (F8) { asm volatile("v_mfma_scale_f32_16x16x128_f8f6f4 %0, %1, %2, %0, %3, %3 op_sel_hi:[0,0,0]" : "+v"(acc[ai][bj][m][n]) : "v"(Bt##8[n]), "v"(At##8[m]), "v"(sc1_)); } \
        else { _Pragma("unroll") for (int k = 0; k < 2; ++k) acc[ai][bj][m][n] = __builtin_amdgcn_mfma_f32_16x16x32_bf16(Bt[n][k], At[m][k], acc[ai][bj][m][n], 0, 0, 0); } } \
        __builtin_amdgcn_s_setprio(0); } while (0)
#define PG8_WAIT_V(n) asm volatile("s_waitcnt vmcnt(" #n ")" ::: "memory")
#define PG8_WAIT_L(n) asm volatile("s_waitcnt lgkmcnt(" #n ")" ::: "memory")
#define PG8_BAR __builtin_amdgcn_s_barrier()
#define PG8_SCHED __builtin_amdgcn_sched_barrier(0)
    Unit cur, nxt; int ui = 0;
    if (!S.next(0, cur)) return;
    f32x4 acc[2][2][4][2];
#pragma unroll
    for (int a = 0; a < 2; ++a)
#pragma unroll
        for (int b = 0; b < 2; ++b)
#pragma unroll
            for (int m = 0; m < 4; ++m)
#pragma unroll
                for (int n = 0; n < 2; ++n) acc[a][b][m][n] = (f32x4){0.f, 0.f, 0.f, 0.f};
    const int sc1_ = 0x7f7f7f7f;
    bf16x8 At[4][2], B0[2][2], B1[2][2]; pg8_i32x8 At8[4], B08[2], B18[2];
    const char* cA = (const char*)g.A + (size_t)cur.pm * tstep; const char* cB = (const char*)g.Bt + (size_t)cur.pn * tstep;
    S.a_ready(cur);
    PG8_STAGE(PG8_SB(0, 0), cB, voffB); PG8_STAGE(PG8_SA(0, 0), cA, voffA); PG8_STAGE(PG8_SB(0, 1), cB + hstep, voffB); PG8_STAGE(PG8_SA(0, 1), cA + hstep, voffA);
    if (wr == 1) PG8_BAR;
    PG8_WAIT_V(4); PG8_BAR;
    PG8_STAGE(PG8_SB(1, 0), cB + kstep, voffB); PG8_STAGE(PG8_SA(1, 0), cA + kstep, voffA); PG8_STAGE(PG8_SB(1, 1), cB + hstep + kstep, voffB);
    PG8_WAIT_V(6); PG8_BAR;
    PG8_STAMP();
    for (;;) {
        const bool has_next = S.next(ui + 1, nxt);
        const char* nA = has_next ? (const char*)g.A + (size_t)nxt.pm * tstep : cA; const char* nB = has_next ? (const char*)g.Bt + (size_t)nxt.pn * tstep : cB;
        for (int t = 0; t < nt; t += 2) {
            const bool last = (t == nt - 2);
            const char* a1 = cA + (size_t)(t + 1) * kstep;
            const char* a2 = last ? nA : cA + (size_t)(t + 2) * kstep; const char* b2 = last ? nB : cB + (size_t)(t + 2) * kstep;
            const char* a3 = a2 + kstep; const char* b3 = b2 + kstep;
            if (last && has_next) S.a_ready(nxt);
            PG8_LDB(B0, 0, 0); PG8_SCHED; PG8_LDA(At, 0, 0); PG8_STAGE(PG8_SA(1, 1), a1 + hstep, voffA);
            PG8_WAIT_L(8); PG8_BAR; PG8_WAIT_L(0); PG8_MMA(0, 0, At, B0); PG8_BAR; PG8_SCHED;
            PG8_LDB(B1, 0, 1); PG8_STAGE(PG8_SB(0, 0), b2, voffB);
            PG8_BAR; PG8_WAIT_L(0); PG8_MMA(0, 1, At, B1); PG8_BAR;
            PG8_LDA(At, 0, 1); PG8_STAGE(PG8_SA(0, 0), a2, voffA);
            PG8_BAR; PG8_WAIT_L(0); PG8_MMA(1, 0, At, B0); PG8_BAR; PG8_SCHED;
            PG8_STAGE(PG8_SB(0, 1), b2 + hstep, voffB);
            PG8_WAIT_V(6); PG8_BAR; PG8_MMA(1, 1, At, B1); PG8_BAR;
            PG8_LDB(B0, 1, 0); PG8_SCHED; PG8_LDA(At, 1, 0); PG8_STAGE(PG8_SA(0, 1), a2 + hstep, voffA);
            PG8_WAIT_L(8); PG8_BAR; PG8_WAIT_L(0); PG8_MMA(0, 0, At, B0); PG8_BAR; PG8_SCHED;
            PG8_LDB(B1, 1, 1); PG8_STAGE(PG8_SB(1, 0), b3, voffB);
            PG8_BAR; PG8_WAIT_L(0); PG8_MMA(0, 1, At, B1); PG8_BAR;
            PG8_LDA(At, 1, 1); PG8_STAGE(PG8_SA(1, 0), a3, voffA);
            PG8_BAR; PG8_WAIT_L(0); PG8_MMA(1, 0, At, B0); PG8_BAR; PG8_SCHED;
            PG8_STAGE(PG8_SB(1, 1), b3 + hstep, voffB);
            PG8_WAIT_V(6); PG8_BAR; PG8_MMA(1, 1, At, B1); PG8_BAR;
        }
        PG8_STAMP();
        if constexpr (!Epi::AFTER_DRAIN) { E(acc, cur, wr, wc, fr, fq); S.done(cur); }
        PG8_STAMP();
        if (!has_next) break;
#pragma unroll
        for (int a = 0; a < 2; ++a)
#pragma unroll
            for (int b = 0; b < 2; ++b)
#pragma unroll
                for (int m = 0; m < 4; ++m)
#pragma unroll
                    for (int n = 0; n < 2; ++n) acc[a][b][m][n] = (f32x4){0.f, 0.f, 0.f, 0.f};
        cur = nxt; cA = nA; cB = nB; ++ui;
    }
    PG8_WAIT_V(0);
    if (wr == 0) PG8_BAR;
    PG8_BAR;
    if constexpr (Epi::AFTER_DRAIN) { E.fused(acc, cur, wr, wc, fr, fq, lds, wid, lane); S.done(cur); }
    PG8_STAMP();
    if (STAMP && wid == 0) { stamps[lane] = lane < nts ? (((unsigned long long)(unsigned)ts_hi << 32) | (unsigned)ts_lo) : 0ull;
        if (lane == 62) stamps[62] = rt_entry; if (lane == 63) stamps[63] = (unsigned long long)wall_clock64(); }
#undef PG8_STAMP
#undef PG8_SA
#undef PG8_SB
#undef PG8_STAGE
#undef PG8_LDA
#undef PG8_LD8
#undef PG8_LDB
#undef PG8_MMA
#undef PG8_WAIT_V
#undef PG8_WAIT_L
#undef PG8_BAR
#undef PG8_SCHED
}
}
namespace at {
constexpr int D = 128;
constexpr float THR = 8.f;
constexpr float SCALE = 0.08838834764831845f;
constexpr int NW = 8, QBLK = 32, KVBLK = 64, QB = NW * QBLK;
constexpr int SHM_V = KVBLK * D * 2, SHM_K = KVBLK * D * 2;
constexpr int LDS_BYTES = 2 * SHM_V + 2 * SHM_K + NW * 64 * 4;

typedef unsigned short bf16;
typedef short bf16x8 __attribute__((ext_vector_type(8)));
typedef short s16x4 __attribute__((ext_vector_type(4)));
typedef float f32x16 __attribute__((ext_vector_type(16)));
typedef float f32x4 __attribute__((ext_vector_type(4)));
typedef unsigned u32x4 __attribute__((ext_vector_type(4)));
template <class A, class Bt> struct same_t { static constexpr bool v = false; };
template <class A> struct same_t<A, A> { static constexpr bool v = true; };

#define KSWZ(row, colB) ((row) * 256 + ((colB) ^ (((row) & 7) << 4)))
#define SBAR() __builtin_amdgcn_sched_barrier(0)
__device__ __forceinline__ int v_st(int k, int c) { const int kk = (k & ~0xC) | ((k & 4) << 1) | ((k & 8) >> 1); return ((kk >> 3) * 4 + (c >> 5)) * 512 + ((kk & 7) * 32 + (c & 31)) * 2; }
__device__ __forceinline__ int v_rd_base(int lane) { return ((lane & 3) << 3) | (((lane >> 2) & 3) << 6) | (((lane >> 4) & 1) << 5) | (((lane >> 5) & 1) << 8); }
constexpr int v_rd_off(int d0, int ks, int half) { return d0 * 512 + ks * 4096 + half * 2048; }
__device__ __forceinline__ int crow(int r, int hi) { return (r & 3) + 8 * (r >> 2) + 4 * hi; }
__device__ __forceinline__ unsigned cvtpk(float lo, float hi) {
    unsigned r; asm volatile("v_cvt_pk_bf16_f32 %0, %1, %2" : "=v"(r) : "v"(lo), "v"(hi)); return r;
}
__device__ __forceinline__ bf16x8 pack8(f32x4 a, f32x4 b) {
    u32x4 w = {cvtpk(a[0], a[1]), cvtpk(a[2], a[3]), cvtpk(b[0], b[1]), cvtpk(b[2], b[3])};
    return *reinterpret_cast<bf16x8*>(&w);
}
template <class T> __device__ __forceinline__ bf16x8 load8(const T* p) {
    if constexpr (same_t<T, float>::v) { return pack8(*(const f32x4*)p, *(const f32x4*)(p + 4)); }
    else { return *reinterpret_cast<const bf16x8*>(p); }
}
__device__ __forceinline__ void mask_tile(f32x16& p0, f32x16& p1, int dq, unsigned W) {
    const float NEG = -__builtin_inff();
#pragma unroll
    for (int r = 0; r < 16; ++r) {
        const int c = (r & 3) + 8 * (r >> 2);
        if ((unsigned)(dq - c) >= W) p0[r] = NEG;
        if ((unsigned)(dq - c - 32) >= W) p1[r] = NEG;
    }
}
__device__ __forceinline__ void partialSM(f32x16& p0, f32x16& p1, float& m_reg, float& mn, float& alpha) {
    float pmax = p0[0]; for (int r = 1; r < 16; ++r) pmax = fmaxf(pmax, p0[r]); for (int r = 0; r < 16; ++r) pmax = fmaxf(pmax, p1[r]);
    { auto rr = __builtin_amdgcn_permlane32_swap(__float_as_uint(pmax), __float_as_uint(pmax), false, false);
      pmax = fmaxf(__uint_as_float(rr[0]), __uint_as_float(rr[1])); }
    constexpr float C2 = 1.4426950408889634f * SCALE;
    if (__builtin_expect(__all((pmax - m_reg) * SCALE <= THR), 1)) { mn = m_reg; alpha = 1.f; }
    else { mn = fmaxf(m_reg, pmax); alpha = __builtin_amdgcn_exp2f((m_reg - mn) * C2); m_reg = mn; }
    const float mnL = -mn * C2;
    for (int r = 0; r < 16; ++r) p0[r] = fmaf(p0[r], C2, mnL); for (int r = 0; r < 16; ++r) p1[r] = fmaf(p1[r], C2, mnL);
    for (int r = 0; r < 16; ++r) p0[r] = __builtin_amdgcn_exp2f(p0[r]);
}
__device__ __forceinline__ void finishSM(f32x16& p0, f32x16& p1, float alpha, float& l_reg, bf16x8& pa0, bf16x8& pa1, bf16x8& pa2, bf16x8& pa3) {
    for (int r = 0; r < 16; ++r) p1[r] = __builtin_amdgcn_exp2f(p1[r]);
    float ps = 0; for (int r = 0; r < 16; ++r) ps += p0[r]; for (int r = 0; r < 16; ++r) ps += p1[r];
    { auto rr = __builtin_amdgcn_permlane32_swap(__float_as_uint(ps), __float_as_uint(ps), false, false);
      ps = __uint_as_float(rr[0]) + __uint_as_float(rr[1]); }
    l_reg = l_reg * alpha + ps;
#define PK4(P, B_, OUT) do { unsigned a0 = cvtpk(P[B_+0], P[B_+1]), a1 = cvtpk(P[B_+2], P[B_+3]);                          \
        unsigned b0 = cvtpk(P[B_+4], P[B_+5]), b1 = cvtpk(P[B_+6], P[B_+7]);                                             \
        auto r0 = __builtin_amdgcn_permlane32_swap(a0, b0, false, false); auto r1 = __builtin_amdgcn_permlane32_swap(a1, b1, false, false); \
        u32x4 w = {r0[0], r1[0], r0[1], r1[1]}; OUT = *reinterpret_cast<bf16x8*>(&w); } while (0)
    PK4(p0, 0, pa0); PK4(p0, 8, pa1); PK4(p1, 0, pa2); PK4(p1, 8, pa3);
#undef PK4
}
template <int KB, bool SK>
__device__ __forceinline__ void qkt(f32x16& p0, f32x16& p1, const char* K_lds, int r32, int hi, const bf16x8* qr, bool act) {
    if (SK && !act) { const float NEG = -__builtin_inff();
#pragma unroll
        for (int r = 0; r < 16; ++r) { p0[r] = NEG; p1[r] = NEG; } return; }
    p0 = f32x16{}; p1 = f32x16{};
    const char* kb[4];
#pragma unroll
    for (int dd = 0; dd < 4; ++dd) kb[dd] = K_lds + KB * SHM_K + KSWZ(r32, (dd * 16 + hi * 8) * 2);
#pragma unroll
    for (int d0 = 0; d0 < 8; ++d0) { const char* a = kb[d0 & 3] + (d0 >> 2) * 128;
        bf16x8 b0 = *reinterpret_cast<const bf16x8*>(a);
        bf16x8 b1 = *reinterpret_cast<const bf16x8*>(a + 32 * 256);
        p0 = __builtin_amdgcn_mfma_f32_32x32x16_bf16(b0, qr[d0], p0, 0, 0, 0);
        p1 = __builtin_amdgcn_mfma_f32_32x32x16_bf16(b1, qr[d0], p1, 0, 0, 0); }
}
template <int VB, bool SK>
__device__ __forceinline__ void pv_tile(f32x16* o, int vb0, bf16x8 pa0, bf16x8 pa1, bf16x8 pa2, bf16x8 pa3, bool act) {
    if (SK && !act) return;
#define TRRD(dst, off) asm volatile("ds_read_b64_tr_b16 %0, %1 offset:%2" : "=&v"(dst) : "v"(vb0), "i"(off) : "memory")
#define PV_D0(d0) do { s16x4 l0, l1, l2, l3, h0, h1, h2, h3; constexpr int b_ = VB * SHM_V + v_rd_off(d0, 0, 0);     \
        TRRD(l0, b_); TRRD(h0, b_ + 2048); TRRD(l1, b_ + 4096); TRRD(h1, b_ + 6144); TRRD(l2, b_ + 8192); TRRD(h2, b_ + 10240); TRRD(l3, b_ + 12288); TRRD(h3, b_ + 14336); \
        asm volatile("s_waitcnt lgkmcnt(0)" ::: "memory"); SBAR();                 \
        o[d0] = __builtin_amdgcn_mfma_f32_32x32x16_bf16(pa0, (bf16x8){l0[0], l0[1], l0[2], l0[3], h0[0], h0[1], h0[2], h0[3]}, o[d0], 0, 0, 0);   \
        o[d0] = __builtin_amdgcn_mfma_f32_32x32x16_bf16(pa1, (bf16x8){l1[0], l1[1], l1[2], l1[3], h1[0], h1[1], h1[2], h1[3]}, o[d0], 0, 0, 0);   \
        o[d0] = __builtin_amdgcn_mfma_f32_32x32x16_bf16(pa2, (bf16x8){l2[0], l2[1], l2[2], l2[3], h2[0], h2[1], h2[2], h2[3]}, o[d0], 0, 0, 0);   \
        o[d0] = __builtin_amdgcn_mfma_f32_32x32x16_bf16(pa3, (bf16x8){l3[0], l3[1], l3[2], l3[3], h3[0], h3[1], h3[2], h3[3]}, o[d0], 0, 0, 0); } while (0)
    PV_D0(0); PV_D0(1); PV_D0(2); PV_D0(3);
#undef PV_D0
#undef TRRD
}

struct BlockRef { const bf16* Q; const bf16* K; const bf16* V; bf16* O; float* L; int P0, W, skv, rs; };
struct Seam { bf16x8 qr[8]; bf16x8 st_v0, st_v1, st_k0, st_k1; };
__device__ __forceinline__ int swa_jlo(int P0, int W) { const int lowk = P0 - W + 1; return lowk > 0 ? lowk / KVBLK : 0; }
#define VMW() asm volatile("s_waitcnt vmcnt(0)" ::: "memory")
#define VMWN(n) asm volatile("s_waitcnt vmcnt(%0)" :: "i"(n) : "memory")
#define ROW(p, k0, rr) ((p) + (size_t)(unsigned)(((k0) + (rr)) * RS_) + sc)
#define RS_OF(ref) ({ int rs__ = (ref).rs; asm volatile("" : "+s"(rs__)); rs__; })
#define SLOAD_H(Kp, Vp, k0) do { S.st_v0 = load8<bf16>(ROW(Vp, k0, sr)); S.st_v1 = load8<bf16>(ROW(Vp, k0, 32 + sr));              \
                         S.st_k0 = load8<bf16>(ROW(Kp, k0, sr)); S.st_k1 = load8<bf16>(ROW(Kp, k0, 32 + sr)); } while (0)
#define SWRITE_HK(bf) do { *(bf16x8*)(K_lds + (bf) * SHM_K + kws) = S.st_k0; *(bf16x8*)(K_lds + (bf) * SHM_K + kws + 32 * 256) = S.st_k1; } while (0)
#define SWRITE_HV(bf) do { *(bf16x8*)(V_lds + (bf) * SHM_V + vst0) = S.st_v0; *(bf16x8*)(V_lds + (bf) * SHM_V + vst1) = S.st_v1; } while (0)
#define SWRITE_H(bf) do { SWRITE_HV(bf); SWRITE_HK(bf); } while (0)
__device__ __forceinline__ void causal_swa_prime(const BlockRef& cur, char* lds, Seam& S) {
    const int tid = threadIdx.x, wid = __builtin_amdgcn_readfirstlane(tid >> 6), lane = tid & 63, r32 = lane & 31, hi = lane >> 5;
    const int sr = tid >> 4, sc = (tid & 15) * 8, kws = KSWZ(sr, sc * 2); char* K_lds = lds + 2 * SHM_V;
    const int kb0 = swa_jlo(cur.P0, cur.W) * KVBLK;
    { const int RS_ = RS_OF(cur);
    for (int d0 = 0; d0 < 8; ++d0) S.qr[d0] = load8<bf16>(cur.Q + (size_t)(unsigned)((wid * QBLK + r32) * RS_) + d0 * 16 + hi * 8);
    SLOAD_H(cur.K, cur.V, kb0); } VMW(); SWRITE_HK(0);
    __syncthreads();
}
struct Svc { const float* tu; const float* tv; unsigned char* du; unsigned char* dv; int next, p_old, p_new, par, G, bid; };
constexpr int SVC_OFF = 73728, SVC_NCH = 65536;
typedef float svc_f4 __attribute__((ext_vector_type(4)));
__device__ __forceinline__ void svc_top(Svc& sv, char* lds) {
    if (sv.p_old < 0) return;
    int tid; asm volatile("v_mov_b32 %0, %1" : "=v"(tid) : "v"(threadIdx.x));
    const int g = sv.p_old, e = (g >> 1) & 16383;
    svc_f4 x = *(const svc_f4*)(lds + SVC_OFF + sv.par * 8192 + tid * 16);
    x *= (g >> 15) ? 16.0f : 256.0f;
    int w = __builtin_amdgcn_cvt_pk_fp8_f32(x.x, x.y, 0, false); w = __builtin_amdgcn_cvt_pk_fp8_f32(x.z, x.w, w, true);
    unsigned char* d = ((g >> 15) ? sv.dv : sv.du) + (size_t)e * 128 + ((size_t)(g & 1) << 25);
    __builtin_nontemporal_store(w, (int*)(d + (((tid >> 5) << 21) | ((tid & 31) << 2))));
}
__device__ __forceinline__ void svc_dma(Svc& sv, char* lds) {
    int tid; asm volatile("v_mov_b32 %0, %1" : "=v"(tid) : "v"(threadIdx.x));
    const int g = sv.next * sv.G + sv.bid;
    const bool live = sv.next >= 0 && g < SVC_NCH;
    const float* src = live ? ((g >> 15) ? sv.tv : sv.tu) + (size_t)((g >> 1) & 16383) * 4096 + (g & 1) * 2048 : sv.tu;
    const unsigned ldsa = __builtin_amdgcn_readfirstlane((unsigned)(uintptr_t)lds + SVC_OFF + sv.par * 8192 + (tid >> 6) * 1024);
    asm volatile("s_mov_b32 m0, %0\n\ts_nop 0\n\tglobal_load_lds_dwordx4 %1, %2 nt" :: "s"(ldsa), "v"(tid * 16), "s"(src) : "memory", "m0");
    sv.p_old = sv.p_new; sv.p_new = live ? g : -1; sv.next = live ? sv.next + 1 : -1; sv.par ^= 1;
}
__device__ __forceinline__ bool svc_busy(const Svc& sv) { return sv.next >= 0 || sv.p_old >= 0 || sv.p_new >= 0; }
template <bool SK>
__device__ __forceinline__ void causal_swa_block(const BlockRef& cur, const BlockRef& nxt, char* lds, Seam& S, Svc& sv) {
    const int tid = threadIdx.x, wid = __builtin_amdgcn_readfirstlane(tid >> 6), lane = tid & 63, r32 = lane & 31, hi = lane >> 5;
    const int W = cur.W, skv = cur.skv;
    const int j_lo = swa_jlo(cur.P0, W);
    int j_hi = (cur.P0 + QB - 1) / KVBLK + 1; if (j_hi > skv / KVBLK) j_hi = skv / KVBLK;
    const int NT = j_hi - j_lo;
    const int kbn = swa_jlo(nxt.P0, nxt.W) * KVBLK;
    const int qlo = cur.P0 + wid * QBLK, qm = qlo + r32 - 4 * hi;
    char* V_lds = lds; char* K_lds = lds + 2 * SHM_V;
    float* ws = (float*)(lds + 2 * SHM_V + 2 * SHM_K) + wid * 64; float* li_l = ws, * al_l = ws + 32;
    float m_reg = -1e30f, l_reg = 0; f32x16 o[4] = {};
    const int sr = tid >> 4, sc = (tid & 15) * 8, vst0 = v_st(sr, sc), vst1 = v_st(32 + sr, sc), kws = KSWZ(sr, sc * 2);
    const int vb0 = (int)(uintptr_t)V_lds + v_rd_base(lane);
    const bf16* Kh = cur.K; const bf16* Vh = cur.V;
#define RESC(a) do { if (__any((a) < 1.f)) { if (hi == 0) al_l[r32] = (a); asm volatile("s_waitcnt lgkmcnt(0)" ::: "memory");              \
                     for (int d_ = 0; d_ < 4; ++d_) for (int r = 0; r < 16; ++r) o[d_][r] *= al_l[crow(r, hi)]; } } while (0)
#define KBASE(t) ((j_lo + (t)) * KVBLK)
#define ACT(t) (KBASE(t) <= qlo + QBLK - 1 && KBASE(t) + KVBLK - 1 >= qlo - W + 1)
#define MASKT(P0_, P1_, t) do { const int kb_ = KBASE(t); if ((!SK || ACT(t)) && (kb_ + KVBLK - 1 > qlo || kb_ <= qlo + QBLK - 1 - W)) mask_tile(P0_, P1_, qm - kb_, (unsigned)W); } while (0)
    constexpr int NQL = 8;
#define SEAM_K0() do { VMWN(NQL); SWRITE_HK(0); SBAR(); } while (0)
    f32x16 pA0, pA1, pB0, pB1; float mnA, mnB, alA, alB; bf16x8 pa0, pa1, pa2, pa3;
    SWRITE_HV(0); SBAR();
    if (NT > 1) { const int RS_ = RS_OF(cur); SLOAD_H(Kh, Vh, KBASE(1)); }
    SBAR(); qkt<0, SK>(pA0, pA1, K_lds, r32, hi, S.qr, ACT(0));
    MASKT(pA0, pA1, 0); partialSM(pA0, pA1, m_reg, mnA, alA);
    if (NT > 1) { VMW(); SWRITE_H(1); }
    __syncthreads();
#define HALF_STEP(PX0, PX1, mnX, alX, PY0, PY1, alY, t, KB, VB, SB) do {                                                      \
        svc_top(sv, lds);                                                                                                     \
        SBAR(); qkt<KB, SK>(PX0, PX1, K_lds, r32, hi, S.qr, ACT(t));                                             \
        finishSM(PY0, PY1, alY, l_reg, pa0, pa1, pa2, pa3); SBAR();                                                           \
        if ((t) + 1 < NT) { const int RS_ = RS_OF(cur); SLOAD_H(Kh, Vh, KBASE((t) + 1)); } svc_dma(sv, lds); SBAR();                              \
        pv_tile<VB, SK>(o, vb0, pa0, pa1, pa2, pa3, ACT((t) - 1)); MASKT(PX0, PX1, (t)); partialSM(PX0, PX1, m_reg, mnX, alX);                                        \
        __syncthreads();                                                                                                      \
        if ((t) + 1 < NT) { VMWN(1); SWRITE_H(SB); }                                                                        \
        RESC(alX); __syncthreads(); } while (0)
    for (int t = 1; t + 1 < NT; t += 2) {
        HALF_STEP(pB0, pB1, mnB, alB, pA0, pA1, alA, t, 1, 0, 0);
        HALF_STEP(pA0, pA1, mnA, alA, pB0, pB1, alB, t + 1, 0, 1, 1);
    }
    const bool even = (NT & 1) == 0;
    if (even) { SBAR(); qkt<1, SK>(pB0, pB1, K_lds, r32, hi, S.qr, ACT(NT - 1)); SBAR(); }
    { const int RS_ = RS_OF(nxt); SLOAD_H(nxt.K, nxt.V, kbn); SBAR();
#pragma unroll
      for (int d0 = 0; d0 < 8; ++d0) S.qr[d0] = load8<bf16>(nxt.Q + (size_t)(unsigned)((wid * QBLK + r32) * RS_) + d0 * 16 + hi * 8); }
    SBAR();
    finishSM(pA0, pA1, alA, l_reg, pa0, pa1, pa2, pa3); SBAR();
    pv_tile<0, SK>(o, vb0, pa0, pa1, pa2, pa3, ACT(even ? NT - 2 : NT - 1));
    if (even) { MASKT(pB0, pB1, NT - 1); partialSM(pB0, pB1, m_reg, mnB, alB); __syncthreads(); RESC(alB);
        finishSM(pB0, pB1, alB, l_reg, pa0, pa1, pa2, pa3); SBAR(); pv_tile<1, SK>(o, vb0, pa0, pa1, pa2, pa3, ACT(NT - 1)); }
    SBAR(); SEAM_K0();
    if (hi == 0) li_l[r32] = l_reg; asm volatile("s_waitcnt lgkmcnt(0)" ::: "memory");
    if (cur.L != nullptr && hi == 0) cur.L[wid * QBLK + r32] = m_reg * SCALE + __logf(l_reg);
    float rli[16];
#pragma unroll
    for (int r = 0; r < 16; ++r) rli[r] = __builtin_amdgcn_rcpf(li_l[crow(r, hi)]);
    bf16* Ow = cur.O + (size_t)(wid * QBLK) * D;
#pragma unroll
    for (int r = 0; r < 16; ++r) { const int orow = crow(r, hi);
#pragma unroll
        for (int d0 = 0; d0 < 4; ++d0) { const float v = o[d0][r] * rli[r]; const float vn = __shfl_xor(v, 1);
            if ((r32 & 1) == 0) *(unsigned*)(Ow + (size_t)orow * D + d0 * 32 + r32) = cvtpk(v, vn); } }
    __syncthreads();
#undef RESC
#undef KBASE
#undef ACT
#undef MASKT
#undef SEAM_K0
#undef HALF_STEP
}
#undef ROW
#undef RS_OF
#undef VMW
#undef VMWN
#undef SLOAD_H
#undef SWRITE_HK
#undef SWRITE_HV
#undef SWRITE_H
#undef KSWZ
#undef SBAR
}
#define XB_TMO      128
#define XB_XCNT(j)  (256  + 64 * (j))
#define XB_XSUB(j)  (1280 + 64 * (j))
#define XB_XGEN(j)  (2304 + 64 * (j))
#define XB_TOP      3328
#define XB_TOPGEN   3392
#define XCD_BAR_WORDS 3456
#define XB_SPIN_CAP (1u << 18)
#define LAS __attribute__((address_space(3)))

__device__ __forceinline__ unsigned xb_ld(unsigned* p)              { return __hip_atomic_load(p, __ATOMIC_RELAXED, __HIP_MEMORY_SCOPE_AGENT); }
__device__ __forceinline__ unsigned xb_add(unsigned* p, unsigned v) { return __hip_atomic_fetch_add(p, v, __ATOMIC_RELAXED, __HIP_MEMORY_SCOPE_AGENT); }
__device__ __forceinline__ unsigned xb_xcc_id() { return (unsigned)__builtin_amdgcn_s_getreg((3 << 11) | 20) & 0xFu; }
#define XB_SPIN(cond, bar) do { unsigned _sp = 0; while (cond) { __builtin_amdgcn_s_sleep(1); \
    if ((++_sp & 255u) == 0u) { if (xb_ld(&(bar)[XB_TMO])) break; if (_sp > XB_SPIN_CAP) { atomicAdd(&(bar)[XB_TMO], 1u); break; } } } } while (0)

struct XcdBarrier {
    unsigned* bar; unsigned x;
    volatile LAS unsigned* st;
};

__device__ __forceinline__ XcdBarrier xcd_barrier_post(unsigned* bar, volatile LAS unsigned* st) {
    XcdBarrier b; b.bar = bar; b.x = xb_xcc_id(); b.st = st;
    if (threadIdx.x == 0) (void)xb_add(&bar[XB_XCNT(b.x)], 1u);
    return b;
}
__device__ __forceinline__ void xcd_barrier_complete(unsigned* bar, unsigned x, unsigned& nloc, unsigned& nx) {
    const unsigned G = gridDim.x * gridDim.y * gridDim.z;
    unsigned sum, cnt, mine, sp = 0u;
    for (;;) {
        sum = 0u; cnt = 0u; mine = 0u;
#pragma unroll
        for (unsigned j = 0; j < 16; ++j) { const unsigned c = xb_ld(&bar[XB_XCNT(j)]); sum += c; cnt += (c > 0u) ? 1u : 0u; mine = (j == x) ? c : mine; }
        if (sum == G) break;
        __builtin_amdgcn_s_sleep(1);
        if ((++sp & 255u) == 0u) { if (xb_ld(&bar[XB_TMO])) break; if (sp > XB_SPIN_CAP) { atomicAdd(&bar[XB_TMO], 1u); break; } }
    }
    nloc = mine > 0u ? mine : 1u; nx = cnt > 0u ? cnt : 1u;
}

__device__ __forceinline__ void xcd_barrier(const XcdBarrier& b) {
    asm volatile("s_waitcnt vmcnt(0)" ::: "memory");
    __syncthreads();
    if (threadIdx.x == 0) {
        unsigned* bar = b.bar;
        __builtin_amdgcn_s_waitcnt(0);
        unsigned nloc = b.st[0], nx = b.st[1];
        if (nloc == 0u) { xcd_barrier_complete(bar, b.x, nloc, nx); b.st[0] = nloc; b.st[1] = nx; }
        const unsigned old = xb_add(&bar[XB_XSUB(b.x)], 1u);
        const unsigned gen = old / nloc;
        if (old + 1u == (gen + 1u) * nloc) {
            __builtin_amdgcn_fence(__ATOMIC_RELEASE, "agent");
            asm volatile("s_waitcnt vmcnt(0)" ::: "memory");
            const unsigned og = xb_add(&bar[XB_TOP], 1u);
            const unsigned tg = og / nx;
            if (og + 1u == (tg + 1u) * nx) xb_add(&bar[XB_TOPGEN], 1u);
            else XB_SPIN(xb_ld(&bar[XB_TOPGEN]) == tg, bar);
            __builtin_amdgcn_fence(__ATOMIC_ACQUIRE, "agent");
            xb_add(&bar[XB_XGEN(b.x)], 1u);
            asm volatile("s_waitcnt vmcnt(0)" ::: "memory");
        } else {
            XB_SPIN(xb_ld(&bar[XB_XGEN(b.x)]) == gen, bar);
            __builtin_amdgcn_fence(__ATOMIC_ACQUIRE, "agent");
            asm volatile("s_waitcnt vmcnt(0)" ::: "memory");
        }
    }
    __syncthreads();
}
typedef unsigned short bf16_t;
typedef float f32x4 __attribute__((ext_vector_type(4)));
typedef float f32x2 __attribute__((ext_vector_type(2)));
typedef unsigned u32x4 __attribute__((ext_vector_type(4)));
typedef unsigned u32x2 __attribute__((ext_vector_type(2)));
typedef __bf16 bf16v2 __attribute__((ext_vector_type(2)));
#define LDS_WAIT() asm volatile("s_waitcnt lgkmcnt(0)" ::: "memory")

struct Args {
    const float* x; const float* c; const int* positions; const float* norm1_g; const float* norm2_g; const float* w_ada; const float* b_ada;
    const float* w_in; const float* lam_q1; const float* lam_k1; const float* lam_q2; const float* lam_k2; const float* diff_subln_g; const float* dil_out_g;
    const float* w_out; const float* peer_wq; const float* peer_subkeys; const float* peer_u; const float* peer_v; const float* final_g;
    float* out; unsigned char* ws; int ph_lo, ph_hi, flag, pad;
};

__device__ __forceinline__ unsigned cvt_pk(float lo, float hi) { unsigned r; asm volatile("v_cvt_pk_bf16_f32 %0, %1, %2" : "=v"(r) : "v"(lo), "v"(hi)); return r; }
__device__ __forceinline__ float bf_lo(unsigned u) { return __uint_as_float(u << 16); }
__device__ __forceinline__ float bf_hi(unsigned u) { return __uint_as_float(u & 0xffff0000u); }
__device__ __forceinline__ float dot2bf(unsigned a, unsigned b, float c) { return __builtin_amdgcn_fdot2_f32_bf16(__builtin_bit_cast(bf16v2, a), __builtin_bit_cast(bf16v2, b), c, false); }
__device__ __forceinline__ unsigned pk_fp8(const f32x4 v) { int r = __builtin_amdgcn_cvt_pk_fp8_f32(v.x, v.y, 0, false); r = __builtin_amdgcn_cvt_pk_fp8_f32(v.z, v.w, r, true); return (unsigned)r; }
__device__ __forceinline__ f32x4 ld4bf(const bf16_t* p) { const u32x2 w = *(const u32x2*)p; return (f32x4){bf_lo(w.x), bf_hi(w.x), bf_lo(w.y), bf_hi(w.y)}; }
__device__ __forceinline__ float wave_sum(float v) {
#pragma unroll
    for (int o = 1; o < 64; o <<= 1) v += __shfl_xor(v, o);
    return v;
}
__device__ __forceinline__ float half_sum(float v) {
#pragma unroll
    for (int o = 1; o < 32; o <<= 1) v += __shfl_xor(v, o);
    return v;
}

#ifdef PROBE_FLAGS
#define P0SEL(b) (!(A.flag & 0xf00) || (A.flag & (0x100 << (b))))
#else
#define P0SEL(b) true
#endif
__device__ __forceinline__ void p0_gemv_unit(const Args& A, float* mod, LAS float* red, int unit, int tid) {
    LAS float* sc = red + 2048;
    for (int i = tid; i < DM; i += 512) { const float cv = A.c[i]; sc[i] = cv / (1.0f + __expf(-cv)); }
    __syncthreads();
    const int rl = tid / 24, c4 = tid - rl * 24;
    if (tid < 384) {
        const float* wp = A.w_ada + (size_t)rl * NADA + unit * 96 + c4 * 4;
        const LAS float* cp = sc + rl;
        f32x4 acc = {0.f, 0.f, 0.f, 0.f};
        f32x4 w0[8], w1[8];
#pragma unroll
        for (int i = 0; i < 8; ++i) w0[i] = *(const f32x4*)(wp + (size_t)(16 * i) * NADA);
        for (int k0 = 0; k0 < DM; k0 += 256) {
#pragma unroll
            for (int i = 0; i < 8; ++i) w1[i] = *(const f32x4*)(wp + (size_t)(k0 + 128 + 16 * i) * NADA);
#pragma unroll
            for (int i = 0; i < 8; ++i) acc += cp[k0 + 16 * i] * w0[i];
            if (k0 + 256 < DM) {
#pragma unroll
                for (int i = 0; i < 8; ++i) w0[i] = *(const f32x4*)(wp + (size_t)(k0 + 256 + 16 * i) * NADA);
            }
#pragma unroll
            for (int i = 0; i < 8; ++i) acc += cp[k0 + 128 + 16 * i] * w1[i];
        }
        *(LAS f32x4*)(red + rl * 96 + c4 * 4) = acc;
    }
    __syncthreads();
    if (tid < 96) { float s = 0.f;
#pragma unroll
        for (int r = 0; r < 16; ++r) s += red[r * 96 + tid];
        mod[unit * 96 + tid] = s + A.b_ada[unit * 96 + tid]; }
    __syncthreads();
}
__device__ __forceinline__ void p0_tr_load(const float* W, int N, int item, int lane, f32x4 (&ld)[8]) {
    const int nblk = N / 32, kb = item / nblk, nb = item - kb * nblk;
    const float* p = W + (size_t)(64 * kb + (lane >> 3)) * N + 32 * nb + 4 * (lane & 7);
#pragma unroll
    for (int i = 0; i < 8; ++i) ld[i] = *(const f32x4*)(p + (size_t)(8 * i) * N);
}
template <bool F8>
__device__ __forceinline__ void p0_tr_store(const f32x4 (&ld)[8], int K, int N, bf16_t* WT, LAS float* scr, int item, int lane) {
    const int nblk = N / 32, kb = item / nblk, nb = item - kb * nblk, k0 = 64 * kb, n0 = 32 * nb;
#pragma unroll
    for (int i = 0; i < 8; ++i) { LAS float* d = scr + (8 * i + (lane >> 3)) * 33 + 4 * (lane & 7); d[0] = ld[i].x; d[1] = ld[i].y; d[2] = ld[i].z; d[3] = ld[i].w; }
    LDS_WAIT(); asm volatile("" ::: "memory");
    const int c = lane & 7;
#pragma unroll
    for (int j = 0; j < 4; ++j) { const int n = (lane >> 3) + 8 * j; const LAS float* s = scr + (8 * c) * 33 + n;
        if (F8) { u32x2 o8; o8.x = pk_fp8((f32x4){s[0 * 33], s[1 * 33], s[2 * 33], s[3 * 33]} * 1024.0f); o8.y = pk_fp8((f32x4){s[4 * 33], s[5 * 33], s[6 * 33], s[7 * 33]} * 1024.0f);
            *(u32x2*)((unsigned char*)WT + (size_t)(n0 + n) * K + k0 + 8 * c) = o8; }
        else { u32x4 o; o.x = cvt_pk(s[0 * 33], s[1 * 33]); o.y = cvt_pk(s[2 * 33], s[3 * 33]); o.z = cvt_pk(s[4 * 33], s[5 * 33]); o.w = cvt_pk(s[6 * 33], s[7 * 33]);
            *(u32x4*)(WT + (size_t)(n0 + n) * K + k0 + 8 * c) = o; } }
    LDS_WAIT(); asm volatile("" ::: "memory");
}
typedef __bf16 bf16v8_t __attribute__((ext_vector_type(8))); typedef float f32x8_t __attribute__((ext_vector_type(8)));
__device__ __forceinline__ pg8::bf16x8 pack8f(const f32x4 a, const f32x4 b) { const f32x8_t v = {a.x, a.y, a.z, a.w, b.x, b.y, b.z, b.w}; return __builtin_bit_cast(pg8::bf16x8, __builtin_convertvector(v, bf16v8_t)); }
__device__ __forceinline__ void p0_fold_item(const Args& A, bf16_t* wsc, int item, int lane) {
    const int g = item >> 7, d0 = (item & 127) * 32, r = lane & 15, kg = lane >> 4;
    pg8::bf16x8 af[2][4];
#pragma unroll
    for (int mt = 0; mt < 2; ++mt)
#pragma unroll
        for (int ks = 0; ks < 4; ++ks) { const float* p = A.peer_wq + (size_t)(d0 + 16 * mt + r) * 2048 + g * 128 + 32 * ks + 8 * kg; af[mt][ks] = pack8f(*(const f32x4*)p, *(const f32x4*)(p + 4)); }
    const float* skp = A.peer_subkeys + (size_t)g * 16384 + 8 * kg;
#pragma unroll 2
    for (int nt = 0; nt < 8; ++nt) {
        pg8::bf16x8 bfr[4];
#pragma unroll
        for (int ks = 0; ks < 4; ++ks) { const float* p = skp + (size_t)(16 * nt + r) * 128 + 32 * ks; bfr[ks] = pack8f(*(const f32x4*)p, *(const f32x4*)(p + 4)); }
#pragma unroll
        for (int mt = 0; mt < 2; ++mt) {
            f32x4 c = {0.f, 0.f, 0.f, 0.f};
#pragma unroll
            for (int ks = 0; ks < 4; ++ks) c = __builtin_amdgcn_mfma_f32_16x16x32_bf16(af[mt][ks], bfr[ks], c, 0, 0, 0);
            typedef __bf16 bf16v4_t __attribute__((ext_vector_type(4)));
            const u32x2 w = __builtin_bit_cast(u32x2, __builtin_convertvector(c, bf16v4_t));
            *(u32x2*)(wsc + (size_t)(g * 128 + 16 * nt + r) * DM + d0 + 16 * mt + 4 * kg) = w;
        }
    }
}
__device__ __forceinline__ void p0_cv_load(const Args& A, int item, int lane, f32x4 (&lu)[4], f32x4 (&lv)[4]) {
    const int eb = item >> 5, s = item & 31;
    const size_t off = (size_t)(eb * 8 + (lane >> 3)) * DM + s * 128 + 16 * (lane & 7);
#pragma unroll
    for (int i = 0; i < 4; ++i) { lu[i] = *(const f32x4*)(A.peer_u + off + 4 * i); lv[i] = *(const f32x4*)(A.peer_v + off + 4 * i); }
}
__device__ __forceinline__ void p0_cv_store(unsigned char* ws, int item, int lane, const f32x4 (&lu)[4], const f32x4 (&lv)[4]) {
    const int eb = item >> 5, s = item & 31;
    const size_t dst = ((size_t)s * NEXP + (size_t)eb * 8) * 8 + lane;
    u32x4 o, p;
    o.x = pk_fp8(lu[0] * 256.0f); o.y = pk_fp8(lu[1] * 256.0f); o.z = pk_fp8(lu[2] * 256.0f); o.w = pk_fp8(lu[3] * 256.0f);
    p.x = pk_fp8(lv[0] * 16.0f); p.y = pk_fp8(lv[1] * 16.0f); p.z = pk_fp8(lv[2] * 16.0f); p.w = pk_fp8(lv[3] * 16.0f);
    ((u32x4*)(ws + WS_UB))[dst] = o; ((u32x4*)(ws + WS_VB))[dst] = p;
}
__device__ __forceinline__ void p0_fold_item_old(const Args& A, bf16_t* wsc, LAS float* lds, int item, int tid) {
    const int g = item >> 6, d0 = (item & 63) * 64;
    LAS float* SK = lds;
    LAS float* WQ = lds + 128 * 132;
    const float* skp = A.peer_subkeys + (size_t)g * 16384;
    for (int i = tid; i < 128 * 32; i += 512) { const int n = i >> 5, k4 = i & 31; *(LAS f32x4*)(SK + n * 132 + 4 * k4) = *(const f32x4*)(skp + n * 128 + 4 * k4); }
    for (int i = tid; i < 64 * 32; i += 512) { const int d = i >> 5, k4 = i & 31; *(LAS f32x4*)(WQ + d * 132 + 4 * k4) = *(const f32x4*)(A.peer_wq + (size_t)(d0 + d) * 2048 + g * 128 + 4 * k4); }
    __syncthreads();
    const int n = tid & 127, dg = tid >> 7;
    float acc[16];
#pragma unroll
    for (int j = 0; j < 16; ++j) acc[j] = 0.f;
    for (int k4 = 0; k4 < 32; ++k4) {
        const f32x4 a = *(const LAS f32x4*)(SK + n * 132 + 4 * k4);
#pragma unroll
        for (int j = 0; j < 16; ++j) { const f32x4 b = *(const LAS f32x4*)(WQ + (dg * 16 + j) * 132 + 4 * k4); acc[j] += a.x * b.x + a.y * b.y + a.z * b.z + a.w * b.w; }
    }
    u32x4 o0, o1;
    o0.x = cvt_pk(acc[0], acc[1]); o0.y = cvt_pk(acc[2], acc[3]); o0.z = cvt_pk(acc[4], acc[5]); o0.w = cvt_pk(acc[6], acc[7]);
    o1.x = cvt_pk(acc[8], acc[9]); o1.y = cvt_pk(acc[10], acc[11]); o1.z = cvt_pk(acc[12], acc[13]); o1.w = cvt_pk(acc[14], acc[15]);
    bf16_t* op = wsc + (size_t)(g * 128 + n) * DM + d0 + dg * 16;
    *(u32x4*)op = o0; *(u32x4*)(op + 8) = o1;
    __syncthreads();
}
__device__ __forceinline__ void p0_prologue(const Args& A, LAS unsigned char* lds, int G, int bid, int tid) {
    const int lane = tid & 63, wave = __builtin_amdgcn_readfirstlane(tid >> 6);
    unsigned char* ws = A.ws;
    float* mod = (float*)(ws + WS_MOD);
    const int gw = bid * 8 + wave, NGW = G * 8;
    if (P0SEL(0)) for (int u = bid; u < NADA / 96; u += G) p0_gemv_unit(A, mod, (LAS float*)lds, u, tid);
    if (bid == G - 1 && wave == 0) {
        float a = 0.f, b = 0.f;
        for (int i = lane; i < 128; i += 64) { a += A.lam_q1[i] * A.lam_k1[i]; b += A.lam_q2[i] * A.lam_k2[i]; }
        a = wave_sum(a); b = wave_sum(b);
        if (lane == 0) *(float*)(ws + WS_LAM) = expf(a) - expf(b) + LAM_INIT;
    }
    {
        float* rope = (float*)(ws + WS_ROPE);
        for (int i = bid * 512 + tid; i < S * 16; i += G * 512) {
            const int s = i >> 4, f = i & 15;
            const float inv = powf(500000.0f, -(float)(2 * f) / 32.0f);
            const float ang = (float)A.positions[s] * inv;
            double rev = (double)ang * 0.15915494309189535; rev -= rint(rev);
            const float fr = (float)rev;
            rope[s * 32 + f] = __builtin_amdgcn_cosf(fr);
            rope[s * 32 + 16 + f] = __builtin_amdgcn_sinf(fr);
        }
    }
    if (P0SEL(1)) {
        LAS float* scr = (LAS float*)(lds + wave * 16384);
        constexpr int I_IN = (DM / 64) * (NIN / 32), I_OUT = (DM / 64) * (DM / 32);
        bf16_t* win = (bf16_t*)(ws + WS_WIN); bf16_t* wout = (bf16_t*)(ws + WS_WOUT);
        f32x4 cur[8], nxt[8];
        int it = gw;
        if (it < I_IN + I_OUT) { if (it < I_IN) p0_tr_load(A.w_in, NIN, it, lane, cur); else p0_tr_load(A.w_out, DM, it - I_IN, lane, cur); }
        for (; it < I_IN + I_OUT; it += NGW) {
            const int itn = it + NGW;
            if (itn < I_IN + I_OUT) { if (itn < I_IN) p0_tr_load(A.w_in, NIN, itn, lane, nxt); else p0_tr_load(A.w_out, DM, itn - I_IN, lane, nxt); }
            if (it < I_IN) { const int T_ = ((it % (NIN / 32)) * 32) >> 11;
                if (T_ == 2 || T_ == 5) p0_tr_store<true>(cur, DM, NIN, (bf16_t*)((unsigned char*)win + WIN8_OFF + ((ptrdiff_t)(T_ == 2 ? -4096 : -8192)) * DM), scr, it, lane);
                else p0_tr_store<false>(cur, DM, NIN, win + ((ptrdiff_t)(T_ > 2 ? -2048 : 0)) * DM, scr, it, lane); }
            else p0_tr_store<true>(cur, DM, DM, wout, scr, it - I_IN, lane);
#pragma unroll
            for (int i = 0; i < 8; ++i) cur[i] = nxt[i];
        }
    }
#ifdef OLD_FOLD
    __syncthreads();
    if (P0SEL(2)) for (int it = bid; it < 16 * 64; it += G) p0_fold_item_old(A, (bf16_t*)(ws + WS_WSC), (LAS float*)lds, it, tid);
#else
    if (P0SEL(2)) for (int it = gw; it < 16 * 128; it += NGW) p0_fold_item(A, (bf16_t*)(ws + WS_WSC), it, lane);
#endif
    if (false) {
        constexpr int NIT = (NEXP / 8) * 32;
        f32x4 cu[4], cv[4], nu[4], nv[4];
        int it = gw;
        if (it < NIT) p0_cv_load(A, it, lane, cu, cv);
        for (; it < NIT; it += NGW) {
            const int itn = it + NGW;
            if (itn < NIT) p0_cv_load(A, itn, lane, nu, nv);
            p0_cv_store(ws, it, lane, cu, cv);
#pragma unroll
            for (int i = 0; i < 4; ++i) { cu[i] = nu[i]; cv[i] = nv[i]; }
        }
    }
    __syncthreads();
}

template <bool INBF, bool F8OUT>
__device__ __forceinline__ void row_modulate(const void* xin_, const float* g, const float* sh, const float* sc, bf16_t* out, unsigned char* out8, LAS float* lv, int tid, int gw, int ngw, int lane) {
    for (int i = tid; i < DM / 4; i += 512) { const f32x4 gv = ((const f32x4*)g)[i], sv = ((const f32x4*)sc)[i]; ((LAS f32x4*)lv)[i] = gv * (1.0f + sv); ((LAS f32x4*)(lv + DM))[i] = ((const f32x4*)sh)[i]; }
    __syncthreads();
    for (int r = gw; r < S; r += ngw) {
        f32x4 v[16]; float ss = 0.f;
        if (INBF) { const bf16_t* xr = (const bf16_t*)xin_ + (size_t)r * DM + 8 * lane;
#pragma unroll
            for (int j = 0; j < 8; ++j) { const u32x4 w = *(const u32x4*)(xr + 512 * j);
                v[2 * j] = (f32x4){bf_lo(w.x), bf_hi(w.x), bf_lo(w.y), bf_hi(w.y)}; v[2 * j + 1] = (f32x4){bf_lo(w.z), bf_hi(w.z), bf_lo(w.w), bf_hi(w.w)}; }
        } else { const float* xr = (const float*)xin_ + (size_t)r * DM + 8 * lane;
#pragma unroll
            for (int j = 0; j < 8; ++j) { v[2 * j] = *(const f32x4*)(xr + 512 * j); v[2 * j + 1] = *(const f32x4*)(xr + 512 * j + 4); }
        }
#pragma unroll
        for (int j = 0; j < 16; ++j) ss += (v[j].x * v[j].x + v[j].y * v[j].y) + (v[j].z * v[j].z + v[j].w * v[j].w);
        ss = wave_sum(ss);
        const float rstd = 1.0f / sqrtf(ss * (1.0f / DM) + NORM_EPS);
        bf16_t* orow = out + (size_t)r * DM + 8 * lane;
#pragma unroll
        for (int j = 0; j < 8; ++j) { const int c = 8 * lane + 512 * j;
            const f32x4 a0 = *(const LAS f32x4*)(lv + c), a1 = *(const LAS f32x4*)(lv + c + 4), h0 = *(const LAS f32x4*)(lv + DM + c), h1 = *(const LAS f32x4*)(lv + DM + c + 4);
            const f32x4 y0 = v[2 * j] * rstd * a0 + h0, y1 = v[2 * j + 1] * rstd * a1 + h1;
            u32x4 w; w.x = cvt_pk(y0.x, y0.y); w.y = cvt_pk(y0.z, y0.w); w.z = cvt_pk(y1.x, y1.y); w.w = cvt_pk(y1.z, y1.w);
            *(u32x4*)(orow + 512 * j) = w;
            if (F8OUT) { u32x2 w8; w8.x = pk_fp8(y0 * 16.0f); w8.y = pk_fp8(y1 * 16.0f); *(u32x2*)(out8 + (size_t)r * DM + c) = w8; }
            if ((j & 3) == 3) __builtin_amdgcn_sched_barrier(0); }
    }
    __syncthreads();
}

struct EpiQKV {
    static constexpr bool PERM = true, AFTER_DRAIN = false;
    bf16_t* qkv; bf16_t* qkv2; const float* rope; int skip;
    __device__ __forceinline__ void operator()(const pg8::f32x4 (&acc)[2][2][4][2], const pg8::Unit& u, int wr, int wc, int fr, int fq) const {
        if (skip) return;
        const int tt_ = u.pn >> 3, T = tt_ + (tt_ >= 2 ? 1 : 0), hh0 = 2 * (u.pn & 7);
        const bool rot = (wc == 0);
        const int d0 = wc * 32 + 8 * fq;
        const float sgn = (fq < 2) ? -1.0f : 1.0f;
        bf16_t* base = qkv + (size_t)T * QKV_T + d0;
        const int rowb = u.pm * 256 + wr * 64 + fr;
        f32x4 cs0 = {1.f, 1.f, 1.f, 1.f}, cs1 = cs0, sn0 = {0.f, 0.f, 0.f, 0.f}, sn1 = sn0, ncs0 = cs0, ncs1 = cs0, nsn0 = sn0, nsn1 = sn0;
        if (rot) { const float* rp = rope + (size_t)rowb * 32 + 8 * (fq & 1);
            cs0 = *(const f32x4*)rp; cs1 = *(const f32x4*)(rp + 4); sn0 = *(const f32x4*)(rp + 16); sn1 = *(const f32x4*)(rp + 20); }
#pragma unroll
        for (int gi = 0; gi < 8; ++gi) {
            const int ai = gi >> 2, m = gi & 3;
            const int row = rowb + ai * 128 + m * 16;
            if (rot && gi < 7) { const int nrow = rowb + ((gi + 1) >> 2) * 128 + ((gi + 1) & 3) * 16; const float* rp = rope + (size_t)nrow * 32 + 8 * (fq & 1);
                ncs0 = *(const f32x4*)rp; ncs1 = *(const f32x4*)(rp + 4); nsn0 = *(const f32x4*)(rp + 16); nsn1 = *(const f32x4*)(rp + 20); }
#pragma unroll
            for (int bj = 0; bj < 2; ++bj) {
                f32x4 v0 = acc[ai][bj][m][0], v1 = acc[ai][bj][m][1];
                if (rot) {
                    f32x4 o0, o1;
                    o0.x = __shfl_xor(v0.x, 32); o0.y = __shfl_xor(v0.y, 32); o0.z = __shfl_xor(v0.z, 32); o0.w = __shfl_xor(v0.w, 32);
                    o1.x = __shfl_xor(v1.x, 32); o1.y = __shfl_xor(v1.y, 32); o1.z = __shfl_xor(v1.z, 32); o1.w = __shfl_xor(v1.w, 32);
                    v0 = v0 * cs0 + sgn * o0 * sn0; v1 = v1 * cs1 + sgn * o1 * sn1;
                }
                u32x4 w; w.x = cvt_pk(v0[0], v0[1]); w.y = cvt_pk(v0[2], v0[3]); w.z = cvt_pk(v1[0], v1[1]); w.w = cvt_pk(v1[2], v1[3]);
                *(u32x4*)(base + ((size_t)(hh0 + bj) * S + row) * 128) = w;
            }
            cs0 = ncs0; cs1 = ncs1; sn0 = nsn0; sn1 = nsn1;
        }
    }
};
struct EpiSV {
    static constexpr bool PERM = true, AFTER_DRAIN = false;
    bf16_t* qkv; bf16_t* qkv2;
    __device__ __forceinline__ void operator()(const pg8::f32x4 (&acc)[2][2][4][2], const pg8::Unit& u, int wr, int wc, int fr, int fq) const {
        const bool dil = (u.pn >> 3) != 0; const int T = dil ? 5 : 2;
        const int hh0 = 2 * (u.pn & 7), d0 = wc * 32 + 8 * fq, rowb = u.pm * 256 + wr * 64 + fr;
        bf16_t* base = qkv + (size_t)T * QKV_T + d0;
#pragma unroll
        for (int gi = 0; gi < 8; ++gi) { const int ai = gi >> 2, m = gi & 3, row = rowb + ai * 128 + m * 16;
#pragma unroll
            for (int bj = 0; bj < 2; ++bj) {
                const f32x4 v0 = acc[ai][bj][m][0] * (1.0f / 16384.0f), v1 = acc[ai][bj][m][1] * (1.0f / 16384.0f);
                u32x4 w; w.x = cvt_pk(v0[0], v0[1]); w.y = cvt_pk(v0[2], v0[3]); w.z = cvt_pk(v1[0], v1[1]); w.w = cvt_pk(v1[2], v1[3]);
                *(u32x4*)(base + ((size_t)(hh0 + bj) * S + row) * 128) = w;
            } }
    }
};
struct EpiResid {
    static constexpr bool PERM = true, AFTER_DRAIN = false;
    const float* x; const float* gate; bf16_t* out;
    __device__ __forceinline__ void operator()(const pg8::f32x4 (&acc)[2][2][4][2], const pg8::Unit& u, int wr, int wc, int fr, int fq) const {
        const int row0 = u.pm * 256 + wr * 64 + fr, col0 = u.pn * 256 + wc * 32 + 8 * fq;
        f32x4 gv[2][2];
#pragma unroll
        for (int bj = 0; bj < 2; ++bj)
#pragma unroll
            for (int n = 0; n < 2; ++n) gv[bj][n] = *(const f32x4*)(gate + col0 + bj * 128 + n * 4) * (1.0f / 16384.0f);
        f32x4 xq[2][2][2];
#define ER_LOAD(slot, gi_) do { const size_t o_ = (size_t)(row0 + ((gi_) >> 2) * 128 + ((gi_) & 3) * 16) * DM + col0; \
            _Pragma("unroll") for (int bj = 0; bj < 2; ++bj) { xq[slot][bj][0] = *(const f32x4*)(x + o_ + bj * 128); xq[slot][bj][1] = *(const f32x4*)(x + o_ + bj * 128 + 4); } } while (0)
        ER_LOAD(0, 0); ER_LOAD(1, 1);
#pragma unroll
        for (int gi = 0; gi < 8; ++gi) { const int ai = gi >> 2, m = gi & 3;
            const size_t off = (size_t)(row0 + ai * 128 + m * 16) * DM + col0;
            f32x4 xc[2][2];
#pragma unroll
            for (int bj = 0; bj < 2; ++bj) { xc[bj][0] = xq[gi % 2][bj][0]; xc[bj][1] = xq[gi % 2][bj][1]; }
            if (gi + 2 < 8) ER_LOAD(gi % 2, gi + 2);
#pragma unroll
            for (int bj = 0; bj < 2; ++bj) {
#ifdef DBG_NO_MIXER
                const f32x4 r0 = xc[bj][0], r1 = xc[bj][1];
#else
                const f32x4 r0 = xc[bj][0] + gv[bj][0] * acc[ai][bj][m][0], r1 = xc[bj][1] + gv[bj][1] * acc[ai][bj][m][1];
#endif
                u32x4 w; w.x = cvt_pk(r0[0], r0[1]); w.y = cvt_pk(r0[2], r0[3]); w.z = cvt_pk(r1[0], r1[1]); w.w = cvt_pk(r1[2], r1[3]);
                *(u32x4*)(out + off + bj * 128) = w;
            }
            __builtin_amdgcn_sched_barrier(0);
        }
#undef ER_LOAD
    }
};

struct AttIt { int kind, L, pass; };
__device__ __forceinline__ at::BlockRef att_ref(const AttIt& it, unsigned char* ws, bool remap) {
    const bf16_t* qkv = (const bf16_t*)(ws + WS_QKV);
    at::BlockRef r;
    if (it.kind == 0) {
        const int b_ = it.L & 255, L_ = remap ? ((((it.L >> 8) * 16 + 2 * (b_ & 7) + (b_ >> 7)) << 4) + ((b_ >> 3) & 15)) : it.L;
        const int vp = L_ >> 4, x = L_ & 15, qb = it.pass ? 31 - x : x;
        const int h = vp >> 2, s = (vp >> 1) & 1, hf = vp & 1;
        const size_t hq = (size_t)(2 * h + s) * S * 128, hv = (size_t)(2 * h + hf) * S * 128;
        r.Q = qkv + 0 * QKV_T + hq + (size_t)qb * 256 * 128; r.K = qkv + 1 * QKV_T + hq; r.V = qkv + 2 * QKV_T + hv;
        r.O = (bf16_t*)(ws + WS_OD) + ((size_t)vp * S + (size_t)qb * 256) * 128; r.L = nullptr;
        r.P0 = qb * 256; r.W = S; r.skv = S; r.rs = 128;
    } else {
        const int b_ = it.L & 255, j_ = it.L >> 8;
        const int g = remap ? (j_ % 3) : (it.L >> 9), h = remap ? (2 * (b_ & 7) + (j_ >= 3 ? 1 : 0)) : ((it.L & 511) >> 5), blk = remap ? (((b_ >> 3) + ((0x524011 >> (4 * j_)) & 15)) & 31) : (it.L & 31);
        const int dil = (g == 0) ? 1 : (g == 1 ? 4 : 16), bpr = 32 / dil, res = blk / bpr, qb = blk % bpr;
        const bf16_t* tb = qkv + 3 * QKV_T;
        const size_t hb = ((size_t)h * S + (size_t)res * (S / dil)) * 128, hn = ((size_t)h * S + (size_t)res) * 128;
        r.skv = S / dil; r.P0 = qb * 256; r.W = 129; r.rs = 128 * dil;
        r.Q = tb + 0 * QKV_T + hn + (size_t)qb * 256 * 128 * dil; r.K = tb + 1 * QKV_T + hn; r.V = tb + 2 * QKV_T + hn;
        r.O = (bf16_t*)(ws + WS_OS) + ((size_t)(g * 16 + h) * S + (size_t)res * (S / dil) + (size_t)qb * 256) * 128;
        r.L = (float*)(ws + WS_LSE) + (size_t)(g * 16 + h) * S + (size_t)res * (S / dil) + (size_t)qb * 256;
    }
    return r;
}
__device__ __forceinline__ AttIt att_next(const AttIt& it, int G, int bid) {
    AttIt n = it;
    if (it.kind == 0) {
        if (it.pass == 0) { n.pass = 1; return n; }
        n.pass = 0; n.L = it.L + G;
        if (n.L < 512) return n;
        n.kind = 1; n.L = bid; if (n.L >= 1536) n.kind = 2;
        return n;
    }
    n.L = it.L + G; if (n.L >= 1536) n.kind = 2;
    return n;
}
__device__ __forceinline__ void attn_phase(const Args& A, char* lds, int G, int bid) {
    AttIt it; it.kind = 0; it.L = bid; it.pass = 0;
    if (it.L >= 512) { it.kind = 1; it.L = bid; if (it.L >= 1536) it.kind = 2; }
    const bool remap = (G == 256);
    at::Svc sv; sv.tu = A.peer_u; sv.tv = A.peer_v; sv.du = A.ws + WS_UB; sv.dv = A.ws + WS_VB; sv.next = 0; sv.p_old = -1; sv.p_new = -1; sv.par = 0; sv.G = G; sv.bid = bid;
    if (it.kind != 2) {
        at::BlockRef cur = att_ref(it, A.ws, remap);
        at::Seam Sm;
        at::causal_swa_prime(cur, lds, Sm);
        while (it.kind != 2) {
            const AttIt itn = att_next(it, G, bid);
            const at::BlockRef nxt = (itn.kind == 2) ? cur : att_ref(itn, A.ws, remap);
            at::causal_swa_block<false>(cur, nxt, lds, Sm, sv);
            cur = nxt; it = itn;
        }
    }
    while (at::svc_busy(sv)) { asm volatile("s_waitcnt vmcnt(0)" ::: "memory"); at::svc_top(sv, lds); at::svc_dma(sv, lds); }
    asm volatile("s_waitcnt vmcnt(0)" ::: "memory");
}

__device__ __forceinline__ void ld16bf(const bf16_t* p, f32x4 (&o)[4]) { const u32x4 a = *(const u32x4*)p, b = *(const u32x4*)(p + 8);
    o[0] = (f32x4){bf_lo(a.x), bf_hi(a.x), bf_lo(a.y), bf_hi(a.y)}; o[1] = (f32x4){bf_lo(a.z), bf_hi(a.z), bf_lo(a.w), bf_hi(a.w)};
    o[2] = (f32x4){bf_lo(b.x), bf_hi(b.x), bf_lo(b.y), bf_hi(b.y)}; o[3] = (f32x4){bf_lo(b.z), bf_hi(b.z), bf_lo(b.w), bf_hi(b.w)}; }
__device__ __forceinline__ float sq16(const f32x4 (&v)[4]) { float s = 0.f;
#pragma unroll
    for (int i = 0; i < 4; ++i) s += (v[i].x * v[i].x + v[i].y * v[i].y) + (v[i].z * v[i].z + v[i].w * v[i].w);
    return s; }
__device__ __forceinline__ void combine_phase(const Args& A, int gw, int ngw, int lane) {
    unsigned char* ws = A.ws;
    const float lam = *(const float*)(ws + WS_LAM);
    const bf16_t* OD = (const bf16_t*)(ws + WS_OD); const bf16_t* OS = (const bf16_t*)(ws + WS_OS); const float* LSE = (const float*)(ws + WS_LSE);
    unsigned char* Y = (unsigned char*)(ws + WS_Y);
    for (int t = gw; t < S; t += ngw) {
#pragma unroll
        for (int hq = 0; hq < 2; ++hq) {
            const int h = 4 * hq + (lane >> 4), e0 = 16 * (lane & 15), hf = e0 >> 7, d0 = e0 & 127;
            f32x4 a[4], b[4], v[4];
            ld16bf(OD + ((size_t)(h * 4 + 0 + hf) * S + t) * 128 + d0, a); ld16bf(OD + ((size_t)(h * 4 + 2 + hf) * S + t) * 128 + d0, b);
#pragma unroll
            for (int i = 0; i < 4; ++i) v[i] = a[i] - lam * b[i];
            float ss = sq16(v);
            ss += __shfl_xor(ss, 1); ss += __shfl_xor(ss, 2); ss += __shfl_xor(ss, 4); ss += __shfl_xor(ss, 8);
            const float rstd = 16.0f * (1.0f - LAM_INIT) / sqrtf(ss * (1.0f / 256.0f) + NORM_EPS);
            u32x4 w;
            w.x = pk_fp8(v[0] * rstd * *(const f32x4*)(A.diff_subln_g + e0)); w.y = pk_fp8(v[1] * rstd * *(const f32x4*)(A.diff_subln_g + e0 + 4));
            w.z = pk_fp8(v[2] * rstd * *(const f32x4*)(A.diff_subln_g + e0 + 8)); w.w = pk_fp8(v[3] * rstd * *(const f32x4*)(A.diff_subln_g + e0 + 12));
            *(u32x4*)(Y + (size_t)t * DM + h * 256 + e0) = w;
        }
        const int r1 = (t & 3) * (S / 4) + (t >> 2), r2 = (t & 15) * (S / 16) + (t >> 4);
#pragma unroll
        for (int hq = 0; hq < 2; ++hq) {
            const int h = 8 * hq + (lane >> 3), d0 = 16 * (lane & 7);
            const float l0 = LSE[(size_t)(0 * 16 + h) * S + t], l1 = LSE[(size_t)(1 * 16 + h) * S + r1], l2 = LSE[(size_t)(2 * 16 + h) * S + r2];
            const float mx = fmaxf(l0, fmaxf(l1, l2));
            const float e0 = __expf(l0 - mx), e1 = __expf(l1 - mx), e2 = __expf(l2 - mx), inv = 1.0f / (e0 + e1 + e2);
            f32x4 o0[4], o1[4], o2[4], v[4];
            ld16bf(OS + ((size_t)(0 * 16 + h) * S + t) * 128 + d0, o0); ld16bf(OS + ((size_t)(1 * 16 + h) * S + r1) * 128 + d0, o1); ld16bf(OS + ((size_t)(2 * 16 + h) * S + r2) * 128 + d0, o2);
#pragma unroll
            for (int i = 0; i < 4; ++i) v[i] = (e0 * inv) * o0[i] + (e1 * inv) * o1[i] + (e2 * inv) * o2[i];
            float ss = sq16(v);
            ss += __shfl_xor(ss, 1); ss += __shfl_xor(ss, 2); ss += __shfl_xor(ss, 4);
            const float rstd = 16.0f / sqrtf(ss * (1.0f / 128.0f) + NORM_EPS);
            const float* gp = A.dil_out_g + h * 128 + d0;
            u32x4 w;
            w.x = pk_fp8(v[0] * rstd * *(const f32x4*)gp); w.y = pk_fp8(v[1] * rstd * *(const f32x4*)(gp + 4));
            w.z = pk_fp8(v[2] * rstd * *(const f32x4*)(gp + 8)); w.w = pk_fp8(v[3] * rstd * *(const f32x4*)(gp + 12));
            *(u32x4*)(Y + (size_t)t * DM + 2048 + h * 128 + d0) = w;
        }
    }
}

__device__ __forceinline__ unsigned fkey(float f) { const unsigned b = __float_as_uint(f); return b ^ ((b >> 31) ? 0xFFFFFFFFu : 0x80000000u); }
__device__ __forceinline__ int mbcnt64(unsigned long long m) { return (int)__builtin_amdgcn_mbcnt_hi((unsigned)(m >> 32), __builtin_amdgcn_mbcnt_lo((unsigned)m, 0u)); }
template <int NR> __device__ __forceinline__ unsigned kth16_key(const unsigned (&key)[NR]) {
    unsigned T = 0u;
    for (int bit = 31; bit >= 0; --bit) {
        const unsigned cand = T | (1u << bit); int cnt = 0;
#pragma unroll
        for (int r = 0; r < NR; ++r) cnt += __builtin_popcountll(__ballot(key[r] >= cand));
        if (cnt >= 16) T = cand;
    }
    return T;
}
template <int NR> __device__ __forceinline__ void select16(const unsigned (&key)[NR], bool (&sel)[NR], int (&pos)[NR]) {
    const unsigned T = kth16_key<NR>(key);
    int cgt = 0;
#pragma unroll
    for (int r = 0; r < NR; ++r) cgt += __builtin_popcountll(__ballot(key[r] > T));
    const int need = 16 - cgt; int eqb = 0, selb = 0;
#pragma unroll
    for (int r = 0; r < NR; ++r) {
        const bool gt = key[r] > T, eq = key[r] == T;
        const unsigned long long beq = __ballot(eq);
        const bool s = gt || (eq && (eqb + mbcnt64(beq)) < need);
        const unsigned long long bs = __ballot(s);
        sel[r] = s; pos[r] = selb + mbcnt64(bs);
        selb += __builtin_popcountll(bs); eqb += __builtin_popcountll(beq);
    }
}
__device__ __forceinline__ float funkey(unsigned k) { return __uint_as_float((k & 0x80000000u) ? (k ^ 0x80000000u) : ~k); }
__device__ __forceinline__ void ins16(unsigned (&L)[16], unsigned x) {
#pragma unroll
    for (int i = 0; i < 16; ++i) { const unsigned hi = L[i] > x ? L[i] : x, lo = L[i] > x ? x : L[i]; L[i] = hi; x = lo; }
}
__device__ __forceinline__ void topk_phase(const Args& A, LAS unsigned char* lds, int gw, int ngw, int wave, int lane, int nwb = S * 16 / 64) {
    unsigned char* ws = A.ws;
    const float* SC = (const float*)(ws + WS_SC); int* IDX = (int*)(ws + WS_IDX); float* GATE = (float*)(ws + WS_GATE);
    LAS float* scr = (LAS float*)(lds + wave * 8448);
    LAS int* tab = (LAS int*)scr;
    for (int wb = gw; wb < nwb; wb += ngw) {
        const float* base = SC + (size_t)wb * 64 * 128;
        unsigned L[16];
#pragma unroll
        for (int i = 0; i < 16; ++i) L[i] = 0u;
        f32x4 ld[8], ln[8];
        const int lr = lane >> 3, lc = lane & 7;
#pragma unroll
        for (int i = 0; i < 8; ++i) ld[i] = *(const f32x4*)(base + (size_t)(8 * i + lr) * 128 + 4 * lc);
#pragma unroll
        for (int c = 0; c < 4; ++c) {
            if (c < 3) {
#pragma unroll
                for (int i = 0; i < 8; ++i) ln[i] = *(const f32x4*)(base + (size_t)(8 * i + lr) * 128 + 32 * (c + 1) + 4 * lc);
            }
#pragma unroll
            for (int i = 0; i < 8; ++i) { LAS float* d = scr + (8 * i + lr) * 33 + 4 * lc; d[0] = ld[i].x; d[1] = ld[i].y; d[2] = ld[i].z; d[3] = ld[i].w; }
            LDS_WAIT(); __builtin_amdgcn_wave_barrier();
#pragma unroll
            for (int j = 0; j < 32; ++j) { const float v = scr[lane * 33 + j]; ins16(L, (fkey(v) & ~127u) | (unsigned)(127 - (32 * c + j))); }
            LDS_WAIT(); __builtin_amdgcn_wave_barrier();
#pragma unroll
            for (int i = 0; i < 8; ++i) ld[i] = ln[i];
        }
        unsigned M[16];
#pragma unroll
        for (int i = 0; i < 16; ++i) M[i] = (unsigned)__shfl_down((int)L[i], 1);
        float av[16], bv[16];
#pragma unroll
        for (int i = 0; i < 16; ++i) { av[i] = funkey((L[i] & ~127u) | 64u); bv[i] = funkey((M[i] & ~127u) | 64u);
            tab[lane * 33 + i] = 127 - (int)(L[i] & 127u); tab[lane * 33 + 16 + i] = 127 - (int)(M[i] & 127u); }
        unsigned K2[16];
#pragma unroll
        for (int i = 0; i < 16; ++i) K2[i] = 0u;
#pragma unroll
        for (int i = 0; i < 16; ++i)
#pragma unroll
            for (int j = 0; j < 16; ++j)
                if ((i + 1) * (j + 1) <= 16) ins16(K2, (fkey(av[i] + bv[j]) & ~255u) | (unsigned)(255 - (i * 16 + j)));
        LDS_WAIT(); __builtin_amdgcn_wave_barrier();
        float fv[16]; int fe[16]; float sm = 0.f;
        const float mx = funkey((K2[0] & ~255u) | 128u);
#pragma unroll
        for (int q = 0; q < 16; ++q) { const int cid = 255 - (int)(K2[q] & 255u);
            fe[q] = tab[lane * 33 + (cid >> 4)] * 128 + tab[lane * 33 + 16 + (cid & 15)];
            fv[q] = __expf(funkey((K2[q] & ~255u) | 128u) - mx); sm += fv[q]; }
        const float inv = 1.0f / sm;
        if ((lane & 1) == 0) {
            const size_t o = ((size_t)wb * 32 + (lane >> 1)) * 16;
#pragma unroll
            for (int q = 0; q < 4; ++q) {
                *(u32x4*)(IDX + o + 4 * q) = (u32x4){(unsigned)fe[4 * q], (unsigned)fe[4 * q + 1], (unsigned)fe[4 * q + 2], (unsigned)fe[4 * q + 3]};
                *(f32x4*)(GATE + o + 4 * q) = (f32x4){fv[4 * q] * inv, fv[4 * q + 1] * inv, fv[4 * q + 2] * inv, fv[4 * q + 3] * inv};
            }
        }
        LDS_WAIT(); __builtin_amdgcn_wave_barrier();
    }
}

__device__ __forceinline__ float gelu_erf(float x) { return 0.5f * x * (1.0f + erff(x * 0.70710678118654752f)); }
__device__ __forceinline__ f32x2 fp8lo(unsigned w) { return __builtin_amdgcn_cvt_pk_f32_fp8((int)w, false); }
__device__ __forceinline__ f32x2 fp8hi(unsigned w) { return __builtin_amdgcn_cvt_pk_f32_fp8((int)w, true); }
__device__ __forceinline__ float dot16_fp8(const u32x4 w, const f32x2 (&hp)[8]) {
    f32x2 t = fp8lo(w.x) * hp[0];
    t = __builtin_elementwise_fma(fp8hi(w.x), hp[1], t); t = __builtin_elementwise_fma(fp8lo(w.y), hp[2], t); t = __builtin_elementwise_fma(fp8hi(w.y), hp[3], t);
    t = __builtin_elementwise_fma(fp8lo(w.z), hp[4], t); t = __builtin_elementwise_fma(fp8hi(w.z), hp[5], t); t = __builtin_elementwise_fma(fp8lo(w.w), hp[6], t);
    t = __builtin_elementwise_fma(fp8hi(w.w), hp[7], t);
    return t.x + t.y;
}
__device__ __forceinline__ float d2cv(unsigned w, bool hi, unsigned hpair, float acc) {
    return __builtin_amdgcn_fdot2_f32_bf16(hi ? __builtin_amdgcn_cvt_scalef32_pk_bf16_fp8(w, 1.0f, true) : __builtin_amdgcn_cvt_scalef32_pk_bf16_fp8(w, 1.0f, false), __builtin_bit_cast(bf16v2, hpair), acc, false); }
__device__ __forceinline__ float dot16_fp8_bf(const u32x4 w, const u32x4 h0, const u32x4 h1, float acc) {
    acc = d2cv(w.x, false, h0.x, acc); acc = d2cv(w.x, true, h0.y, acc); acc = d2cv(w.y, false, h0.z, acc); acc = d2cv(w.y, true, h0.w, acc);
    acc = d2cv(w.z, false, h1.x, acc); acc = d2cv(w.z, true, h1.y, acc); acc = d2cv(w.w, false, h1.z, acc); return d2cv(w.w, true, h1.w, acc);
}
__device__ __forceinline__ void axpy16_fp8(const u32x4 w, const float a, f32x2 (&o)[8]) {
    const f32x2 av = {a, a};
    o[0] = __builtin_elementwise_fma(fp8lo(w.x), av, o[0]); o[1] = __builtin_elementwise_fma(fp8hi(w.x), av, o[1]);
    o[2] = __builtin_elementwise_fma(fp8lo(w.y), av, o[2]); o[3] = __builtin_elementwise_fma(fp8hi(w.y), av, o[3]);
    o[4] = __builtin_elementwise_fma(fp8lo(w.z), av, o[4]); o[5] = __builtin_elementwise_fma(fp8hi(w.z), av, o[5]);
    o[6] = __builtin_elementwise_fma(fp8lo(w.w), av, o[6]); o[7] = __builtin_elementwise_fma(fp8hi(w.w), av, o[7]);
}
__device__ __forceinline__ void peer_phase(const Args& A, LAS unsigned char* lds, int G, int bid, int tid) {
    unsigned char* ws = A.ws;
    const bf16_t* H2 = (const bf16_t*)(ws + WS_H2);
    const int* IDX = (const int*)(ws + WS_IDX); const float* GATE = (const float*)(ws + WS_GATE);
    bf16_t* X1 = (bf16_t*)(ws + WS_X1); const float* g2 = (const float*)(ws + WS_MOD) + 5 * DM;
    const int grp = tid >> 3, sub = tid & 7, tok = grp >> 1, eh = grp & 1;
    const int srot = 4 * (int)(xb_xcc_id() & 7u);
    const unsigned so = (unsigned)sub * 16u;
    LAS int* lidx = (LAS int*)lds; LAS float* lact = (LAS float*)(lds + 16384); LAS float* lrs = (LAS float*)(lds + 32768);
    const LAS int* myidx = lidx + tok * 128 + eh * 64; const LAS float* myact = lact + tok * 128 + eh * 64;
    for (int tt = bid; tt < S / 32; tt += G) {
        const int t0 = tt * 32;
        topk_phase(A, lds + 40960, tt * 8 + (tid >> 6), 1 << 30, tid >> 6, tid & 63, tt * 8 + (tid >> 6) + 1);
        asm volatile("s_waitcnt vmcnt(0)" ::: "memory"); __syncthreads();
        for (int i = tid; i < 1024; i += 512) ((LAS u32x4*)lidx)[i] = ((const u32x4*)(IDX + (size_t)t0 * 128))[i];
        __syncthreads();
        float acc[64];
#pragma unroll
        for (int j = 0; j < 64; ++j) acc[j] = 0.f;
        for (int si = 0; si < 32; ++si) {
            const int s = (si + srot) & 31;
            const u32x4 h0 = *(const u32x4*)(H2 + (size_t)(t0 + tok) * DM + s * 128 + sub * 16), h1 = *(const u32x4*)(H2 + (size_t)(t0 + tok) * DM + s * 128 + sub * 16 + 8);
            const char* ub = (const char*)(ws + WS_UB) + (size_t)s * ((size_t)NEXP * 128);
#pragma unroll
            for (int eb = 0; eb < 64; eb += 16) {
                u32x4 id4[4];
#pragma unroll
                for (int k = 0; k < 4; ++k) id4[k] = *(const LAS u32x4*)(myidx + eb + 4 * k);
                u32x4 uv[16];
#pragma unroll
                for (int k = 0; k < 4; ++k) { uv[4 * k + 0] = *(const u32x4*)(ub + (id4[k].x * 128u + so)); uv[4 * k + 1] = *(const u32x4*)(ub + (id4[k].y * 128u + so));
                                              uv[4 * k + 2] = *(const u32x4*)(ub + (id4[k].z * 128u + so)); uv[4 * k + 3] = *(const u32x4*)(ub + (id4[k].w * 128u + so)); }
#pragma unroll
                for (int i = 0; i < 16; ++i) acc[eb + i] = dot16_fp8_bf(uv[i], h0, h1, acc[eb + i]);
                asm volatile("" ::: "memory");
            }
        }
        {
            float g8[8];
#pragma unroll
            for (int k = 0; k < 8; ++k) g8[k] = GATE[(size_t)(t0 + tok) * 128 + eh * 64 + 8 * k + sub];
            const bool b4 = (sub & 4) != 0, b2 = (sub & 2) != 0, b1 = (sub & 1) != 0;
            float a32[32], a16[16], a8[8];
#pragma unroll
            for (int p = 0; p < 32; ++p) { const int jl = (p >> 2) * 8 + (p & 3), jh = jl + 4;
                float x0 = acc[jl], x1 = acc[jh]; asm volatile("" : "+v"(x0), "+v"(x1));
                const float keep = b4 ? x1 : x0, send = b4 ? x0 : x1; a32[p] = keep + __shfl_xor(send, 4); }
#pragma unroll
            for (int p = 0; p < 16; ++p) { const int il = (p >> 1) * 4 + (p & 1), ih = il + 2;
                float x0 = a32[il], x1 = a32[ih]; asm volatile("" : "+v"(x0), "+v"(x1));
                const float keep = b2 ? x1 : x0, send = b2 ? x0 : x1; a16[p] = keep + __shfl_xor(send, 2); }
#pragma unroll
            for (int k = 0; k < 8; ++k) { float x0 = a16[2 * k], x1 = a16[2 * k + 1]; asm volatile("" : "+v"(x0), "+v"(x1));
                const float keep = b1 ? x1 : x0, send = b1 ? x0 : x1; a8[k] = keep + __shfl_xor(send, 1); }
#pragma unroll
            for (int k = 0; k < 8; ++k) lact[tok * 128 + eh * 64 + 8 * k + sub] = g8[k] * gelu_erf(a8[k] * (1.0f / 256.0f));
        }
        __syncthreads();
        float ssq = 0.f;
        for (int si = 0; si < 32; ++si) {
            const int s = (si + srot) & 31;
            const char* vb = (const char*)(ws + WS_VB) + (size_t)s * ((size_t)NEXP * 128);
            f32x2 o[8];
#pragma unroll
            for (int i = 0; i < 8; ++i) o[i] = (f32x2){0.f, 0.f};
#pragma unroll
            for (int eb = 0; eb < 64; eb += 16) {
                u32x4 id4[4]; f32x4 a4[4];
#pragma unroll
                for (int k = 0; k < 4; ++k) { id4[k] = *(const LAS u32x4*)(myidx + eb + 4 * k); a4[k] = *(const LAS f32x4*)(myact + eb + 4 * k); }
                u32x4 vv[16];
#pragma unroll
                for (int k = 0; k < 4; ++k) { vv[4 * k + 0] = *(const u32x4*)(vb + (id4[k].x * 128u + so)); vv[4 * k + 1] = *(const u32x4*)(vb + (id4[k].y * 128u + so));
                                              vv[4 * k + 2] = *(const u32x4*)(vb + (id4[k].z * 128u + so)); vv[4 * k + 3] = *(const u32x4*)(vb + (id4[k].w * 128u + so)); }
#pragma unroll
                for (int k = 0; k < 4; ++k) { axpy16_fp8(vv[4 * k + 0], a4[k].x, o); axpy16_fp8(vv[4 * k + 1], a4[k].y, o); axpy16_fp8(vv[4 * k + 2], a4[k].z, o); axpy16_fp8(vv[4 * k + 3], a4[k].w, o); }
                asm volatile("" ::: "memory");
            }
#pragma unroll
            for (int i = 0; i < 8; ++i) { o[i].x += __shfl_xor(o[i].x, 8); o[i].y += __shfl_xor(o[i].y, 8); }
            if (eh == 0) {
                const size_t off = (size_t)(t0 + tok) * DM + s * 128 + sub * 16;
#pragma unroll
                for (int q = 0; q < 4; ++q) {
                    const f32x4 xv = ld4bf(X1 + off + 4 * q); const f32x4 gv = *(const f32x4*)(g2 + s * 128 + sub * 16 + 4 * q) * (1.0f / 16.0f);
                    f32x4 r; r.x = xv.x + gv.x * o[2 * q].x; r.y = xv.y + gv.y * o[2 * q].y; r.z = xv.z + gv.z * o[2 * q + 1].x; r.w = xv.w + gv.w * o[2 * q + 1].y;
                    ssq += (r.x * r.x + r.y * r.y) + (r.z * r.z + r.w * r.w);
                    u32x2 w; w.x = cvt_pk(r.x, r.y); w.y = cvt_pk(r.z, r.w); *(u32x2*)(X1 + off + 4 * q) = w;
                }
            }
        }
        ssq += __shfl_xor(ssq, 1); ssq += __shfl_xor(ssq, 2); ssq += __shfl_xor(ssq, 4);
        if (eh == 0 && sub == 0) lrs[tok] = 1.0f / sqrtf(ssq * (1.0f / DM) + NORM_EPS);
        __syncthreads();
        for (int i0 = tid; i0 < 32 * 1024; i0 += 512 * 8) {
            u32x2 pv[8];
#pragma unroll
            for (int k = 0; k < 8; ++k) { const int i = i0 + 512 * k, tn = i >> 10, c4 = i & 1023; pv[k] = *((const u32x2*)(X1 + (size_t)(t0 + tn) * DM) + c4); }
#pragma unroll
            for (int k = 0; k < 8; ++k) { const int i = i0 + 512 * k, tn = i >> 10, c4 = i & 1023;
                const f32x4 xv = (f32x4){bf_lo(pv[k].x), bf_hi(pv[k].x), bf_lo(pv[k].y), bf_hi(pv[k].y)};
                *((f32x4*)(A.out + (size_t)(t0 + tn) * DM) + c4) = xv * lrs[tn] * ((const f32x4*)A.final_g)[c4]; }
        }
        __syncthreads();
    }
}

#ifdef DBG_CHECK
__device__ __forceinline__ void dbg_flag(unsigned char* ws, int bit) { atomicOr((unsigned*)(ws + WS_CTL + 65536), 1u << bit); }
__device__ __forceinline__ void dbg_phase(const Args& A, LAS unsigned char* lds, int bid, int tid) {
    unsigned char* ws = A.ws;
    const int lane = tid & 63, wave = __builtin_amdgcn_readfirstlane(tid >> 6);
    const bf16_t* H2 = (const bf16_t*)(ws + WS_H2); const float* SC = (const float*)(ws + WS_SC);
    const int* IDX = (const int*)(ws + WS_IDX); const float* GATE = (const float*)(ws + WS_GATE);
    const float* X1 = (const float*)(ws + WS_X1); const float* mod = (const float*)(ws + WS_MOD);
    if (wave != 0) return;
    if (bid < 4) {
        const int t = bid == 0 ? 5 : (bid == 1 ? 1234 : (bid == 2 ? 4097 : 8191)), g = (3 * bid + 5) & 15;
        LAS float* q = (LAS float*)lds;
        float q0 = 0.f, q1 = 0.f;
        for (int d = 0; d < DM; ++d) { const float hv = __uint_as_float(((unsigned)H2[(size_t)t * DM + d]) << 16);
            q0 += hv * A.peer_wq[(size_t)d * 2048 + g * 128 + lane]; q1 += hv * A.peer_wq[(size_t)d * 2048 + g * 128 + 64 + lane]; }
        q[lane] = q0; q[lane + 64] = q1; LDS_WAIT(); __builtin_amdgcn_wave_barrier();
        bool bad = false;
        for (int r = 0; r < 2; ++r) { const int n = lane + 64 * r; float s = 0.f;
            for (int k = 0; k < 128; ++k) s += q[k] * A.peer_subkeys[(size_t)g * 16384 + n * 128 + k];
            const float got = SC[(size_t)t * 2048 + g * 128 + n];
            if (!(fabsf(got - s) <= 0.03f * fabsf(s) + 0.03f)) bad = true; }
        if (__any(bad) && lane == 0) dbg_flag(ws, 0);
    } else if (bid < 8) {
        const int b = bid - 4, t = b == 0 ? 5 : (b == 1 ? 1234 : (b == 2 ? 4097 : 8191)), h = (2 * b + 1) & 7;
        LAS float* sv = (LAS float*)lds;
        LAS int* si = (LAS int*)(lds + 2048);
        LAS float* fv = (LAS float*)(lds + 4096);
        for (int i = lane; i < 256; i += 64) sv[i] = SC[(size_t)t * 2048 + h * 256 + i];
        LDS_WAIT(); __builtin_amdgcn_wave_barrier();
        if (lane == 0) {
            for (int p = 0; p < 2; ++p) for (int k = 0; k < 16; ++k) { float best = -3e38f; int bi = 0;
                for (int n = 0; n < 128; ++n) { const float x = sv[p * 128 + n]; if (x > best) { best = x; bi = n; } }
                sv[256 + p * 16 + k] = best; si[p * 16 + k] = bi; sv[p * 128 + bi] = -3e38f; }
            for (int a = 0; a < 16; ++a) for (int c = 0; c < 16; ++c) fv[16 + a * 16 + c] = sv[256 + a] + sv[272 + c];
            float mx = -3e38f;
            for (int k = 0; k < 16; ++k) { float best = -3e38f; int bi = 0;
                for (int c = 0; c < 256; ++c) { const float x = fv[16 + c]; if (x > best) { best = x; bi = c; } }
                fv[k] = best; si[32 + k] = si[bi >> 4] * 128 + si[16 + (bi & 15)]; fv[16 + bi] = -3e38f; if (best > mx) mx = best; }
            float sm = 0.f; for (int k = 0; k < 16; ++k) sm += __expf(fv[k] - mx);
            bool bad = false;
            for (int k = 0; k < 16; ++k) { const float gk = __expf(fv[k] - mx) / sm; bool found = false;
                for (int j = 0; j < 16; ++j) if (IDX[(size_t)t * 128 + h * 16 + j] == si[32 + k]) { found = true; if (fabsf(GATE[(size_t)t * 128 + h * 16 + j] - gk) > 2e-3f) bad = true; }
                if (!found && gk > 0.02f) bad = true; }
            if (bad) dbg_flag(ws, 1);
        }
    } else if (bid < 12) {
        const int b = bid - 8, t = b == 0 ? 5 : (b == 1 ? 1234 : (b == 2 ? 4097 : 8191));
        LAS float* av = (LAS float*)lds;
        for (int j = 0; j < 128; ++j) { const int e = IDX[(size_t)t * 128 + j]; float s = 0.f;
            for (int d = lane; d < DM; d += 64) s += __uint_as_float(((unsigned)H2[(size_t)t * DM + d]) << 16) * A.peer_u[(size_t)e * DM + d];
            s = wave_sum(s); if (lane == 0) av[j] = GATE[(size_t)t * 128 + j] * gelu_erf(s); }
        LDS_WAIT(); __builtin_amdgcn_wave_barrier();
        float ss = 0.f;
        for (int d = lane; d < DM; d += 64) { float o = 0.f;
            for (int j = 0; j < 128; ++j) o += av[j] * A.peer_v[(size_t)IDX[(size_t)t * 128 + j] * DM + d];
            const float x2 = X1[(size_t)t * DM + d] + mod[5 * DM + d] * o; ss += x2 * x2; }
        ss = wave_sum(ss); const float rstd = 1.0f / sqrtf(ss / DM + NORM_EPS);
        bool bad = false;
        for (int d = lane; d < DM; d += 64) { float o = 0.f;
            for (int j = 0; j < 128; ++j) o += av[j] * A.peer_v[(size_t)IDX[(size_t)t * 128 + j] * DM + d];
            const float ref = (X1[(size_t)t * DM + d] + mod[5 * DM + d] * o) * rstd * A.final_g[d];
            if (!(fabsf(A.out[(size_t)t * DM + d] - ref) <= 0.02f * fabsf(ref) + 0.02f)) bad = true; }
        if (__any(bad) && lane == 0) dbg_flag(ws, 2);
    } else if (bid < 16) {
        const int b = bid - 12, t = b == 0 ? 5 : (b == 1 ? 1234 : (b == 2 ? 4097 : 8191));
        float ss = 0.f; for (int d = lane; d < DM; d += 64) { const float x = X1[(size_t)t * DM + d]; ss += x * x; }
        ss = wave_sum(ss); const float rstd = 1.0f / sqrtf(ss / DM + NORM_EPS); bool bad = false;
        for (int d = lane; d < DM; d += 64) { const float ref = X1[(size_t)t * DM + d] * rstd * A.norm2_g[d] * (1.0f + mod[4 * DM + d]) + mod[3 * DM + d];
            const float got = __uint_as_float(((unsigned)H2[(size_t)t * DM + d]) << 16);
            if (!(fabsf(got - ref) <= 0.01f * fabsf(ref) + 0.01f)) bad = true; }
        if (__any(bad) && lane == 0) dbg_flag(ws, 3);
    } else if (bid < 20) {
        const int b = bid - 16; bool bad = false;
        for (int r = 0; r < 6; ++r) { const int n = r * DM + 37 * lane + 500 * b; float s = 0.f;
            for (int k = 0; k < DM; ++k) { const float cv = A.c[k]; s += cv / (1.0f + __expf(-cv)) * A.w_ada[(size_t)k * NADA + n]; }
            s += A.b_ada[n]; if (!(fabsf(mod[n] - s) <= 1e-3f * fabsf(s) + 1e-3f)) bad = true; }
        if (__any(bad) && lane == 0) dbg_flag(ws, 4);
    } else if (bid < 24) {
        const int b = bid - 20, g = (5 * b + 2) & 15, n = 17 * b + 3; bool bad = false;
        const bf16_t* wsc = (const bf16_t*)(ws + WS_WSC);
        for (int d = lane; d < DM; d += 64) { float s = 0.f;
            for (int k = 0; k < 128; ++k) s += A.peer_subkeys[(size_t)g * 16384 + n * 128 + k] * A.peer_wq[(size_t)d * 2048 + g * 128 + k];
            const float got = __uint_as_float(((unsigned)wsc[(size_t)(g * 128 + n) * DM + d]) << 16);
            if (!(fabsf(got - s) <= 0.01f * fabsf(s) + 2e-4f)) bad = true; }
        if (__any(bad) && lane == 0) dbg_flag(ws, 5);
    }
}
__device__ __forceinline__ void dbg_emit(const Args& A, int bid, int tid, int G) {
    const unsigned mask = *(const unsigned*)(A.ws + WS_CTL + 65536);
    const float cval = sqrtf((float)mask + 1.0f);
    for (size_t i = (size_t)bid * 512 + tid; i < (size_t)S * DM; i += (size_t)G * 512) A.out[i] = cval;
}
#endif
__global__ void __launch_bounds__(512, 2) hymba_fwd(Args A) {
    extern __shared__ __attribute__((aligned(16))) unsigned char lds_raw[];
    LAS unsigned char* lds = (LAS unsigned char*)lds_raw;
    const int tid = threadIdx.x, lane = tid & 63, wave = __builtin_amdgcn_readfirstlane(tid >> 6);
    const int G = gridDim.x, bid = blockIdx.x;
    const int gw = bid * 8 + wave, ngw = G * 8;
    unsigned char* ws = A.ws;
    for (int u = tid; u < (LDS_BYTES - RING_BYTES) / 4; u += 512) ((LAS unsigned*)(lds + RING_BYTES))[u] = 0u;
    __syncthreads();
    XcdBarrier bar; bar.bar = (unsigned*)(ws + WS_CTL) + CW_BAR; bar.x = 0; bar.st = nullptr;
    if (MK_N_LAUNCHES == 1) bar = xcd_barrier_post((unsigned*)(ws + WS_CTL) + CW_BAR, (volatile LAS unsigned*)(lds + MISC_OFF + 32));
    const int lo = A.ph_lo, hi = A.ph_hi;
#ifndef PH_MASK
#define PH_MASK 0xfff
#endif
#define IN(k) (((PH_MASK >> (k)) & 1) && lo <= (k) && (k) < hi)
#define REP(k) (((REP_MASK >> (k)) & 1) ? 2 : 1)
#ifdef DBG_TIME
#define SEAM(k) do { if (IN(k) && IN((k) + 1)) xcd_barrier(bar); if (bid == 0 && tid == 0) ((unsigned long long*)(ws + WS_CTL + 32768))[(k) + 1] = __builtin_amdgcn_s_memrealtime(); } while (0)
#else
#define SEAM(k) do { if (IN(k) && IN((k) + 1)) xcd_barrier(bar); } while (0)
#endif
    float* mod = (float*)(ws + WS_MOD);
#ifdef DBG_TIME
    if (bid == 0 && tid == 0) ((unsigned long long*)(ws + WS_CTL + 32768))[0] = __builtin_amdgcn_s_memrealtime();
#endif

    if (IN(0)) for (int rep_ = 0; rep_ < REP(0); ++rep_) { p0_prologue(A, lds, G, bid, tid); }
    SEAM(0);
    if (IN(1)) for (int rep_ = 0; rep_ < REP(1); ++rep_) { row_modulate<false, true>(A.x, A.norm1_g, mod + 0 * DM, mod + 1 * DM, (bf16_t*)(ws + WS_H1), ws + WS_H1F8, (LAS float*)lds, tid, gw, ngw, lane); }
    SEAM(1);
    if (IN(2)) for (int rep_ = 0; rep_ < REP(2); ++rep_) {
        {
            pg8::Gemm g{(const bf16_t*)(ws + WS_H1), (const bf16_t*)(ws + WS_WIN), S, 8192, DM}; pg8::StaticOrder So; So.init(S, 8192, G, bid);
            EpiQKV E{(bf16_t*)(ws + WS_QKV), (bf16_t*)(ws + WS_QKV2), (const float*)(ws + WS_ROPE), 0};
            pg8::gemm_phase<EpiQKV, pg8::StaticOrder, false>(lds, g, So, E, nullptr);
        }
        __syncthreads();
        {
            pg8::Gemm g{(const bf16_t*)(ws + WS_H1F8), (const bf16_t*)(ws + WS_WIN + WIN8_OFF), S, 4096, DM / 2}; pg8::StaticOrder So; So.init(S, 4096, G, bid);
            EpiSV E{(bf16_t*)(ws + WS_QKV), (bf16_t*)(ws + WS_QKV2)};
            pg8::gemm_phase<EpiSV, pg8::StaticOrder, false, true>(lds, g, So, E, nullptr);
        }
    }
    SEAM(2);
    if (IN(3)) for (int rep_ = 0; rep_ < REP(3); ++rep_) { attn_phase(A, (char*)lds_raw, G, bid); }
    SEAM(3);
    if (IN(4)) for (int rep_ = 0; rep_ < REP(4); ++rep_) { combine_phase(A, gw, ngw, lane); }
    SEAM(4);
    if (IN(5)) for (int rep_ = 0; rep_ < REP(5); ++rep_) {
        pg8::Gemm g{(const bf16_t*)(ws + WS_Y), (const bf16_t*)(ws + WS_WOUT), S, DM, DM / 2}; pg8::StaticOrder So; So.init(S, DM, G, bid);
        EpiResid E{A.x, mod + 2 * DM, (bf16_t*)(ws + WS_X1)};
        pg8::gemm_phase<EpiResid, pg8::StaticOrder, false, true>(lds, g, So, E, nullptr);
    }
    SEAM(5);
    if (IN(6)) for (int rep_ = 0; rep_ < REP(6); ++rep_) { row_modulate<true, false>(ws + WS_X1, A.norm2_g, mod + 3 * DM, mod + 4 * DM, (bf16_t*)(ws + WS_H2), nullptr, (LAS float*)lds, tid, gw, ngw, lane); }
    SEAM(6);
    if (IN(7)) for (int rep_ = 0; rep_ < REP(7); ++rep_) {
        pg8::Gemm g{(const bf16_t*)(ws + WS_H2), (const bf16_t*)(ws + WS_WSC), S, 2048, DM}; pg8::StaticOrder So; So.init(S, 2048, G, bid);
#ifdef PROBE_FLAGS
        if (A.flag & 2) g.K = DM / 2;
        if (A.flag & 4) g.K = 256;
#endif
        pg8::EpiF32 E{(float*)(ws + WS_SC), 2048, nullptr};
        pg8::gemm_phase<pg8::EpiF32, pg8::StaticOrder, false>(lds, g, So, E, nullptr);
    }
    SEAM(7);
    if (IN(9)) for (int rep_ = 0; rep_ < REP(9); ++rep_) { peer_phase(A, lds, G, bid, tid); }
#ifdef DBG_TIME
    xcd_barrier(bar);
    if (bid == 0 && tid == 0) ((unsigned long long*)(ws + WS_CTL + 32768))[10] = __builtin_amdgcn_s_memrealtime();
    xcd_barrier(bar);
    {
        const unsigned long long* ts = (const unsigned long long*)(ws + WS_CTL + 32768);
        const float d1 = (float)(ts[DBG_T1 + 1] - ts[DBG_T1]) * 0.01f, d2 = (float)(ts[DBG_T2 + 1] - ts[DBG_T2]) * 0.01f;
        const float cval = sqrtf(fmaxf(d1 * 0.1f, 0.f));
        for (size_t i = (size_t)bid * 512 + tid; i < (size_t)S * DM; i += (size_t)G * 512) A.out[i] = (i == 0) ? 10.0f * d2 : cval;
    }
#endif
#undef IN
#undef SEAM
}

#ifdef DBG_CHECK
__global__ void __launch_bounds__(512) dbg_kernel(Args A, int which) {
    __shared__ __attribute__((aligned(16))) unsigned char dl[8192];
    if (which == 0) dbg_phase(A, (LAS unsigned char*)dl, blockIdx.x, threadIdx.x);
    else dbg_emit(A, blockIdx.x, threadIdx.x, gridDim.x);
}
#endif
extern "C" void kernel_launch(void* const* d_in, const int* in_sizes, int n_in, void* d_out, int out_size, void* d_ws, size_t ws_size, hipStream_t stream) {
    static int grid = 0;
    if (grid == 0) {
        if (n_in != 20 || out_size != S * DM || ws_size < WS_END) { fprintf(stderr, "kernel_launch: unexpected shapes (n_in %d out %d ws %zu)\n", n_in, out_size, ws_size); grid = -1; return; }
        int dev = 0, cus = 0, per_cu = 0;
        if (hipGetDevice(&dev) != hipSuccess || hipDeviceGetAttribute(&cus, hipDeviceAttributeMultiprocessorCount, dev) != hipSuccess) { grid = -1; return; }
        if (hipFuncSetAttribute((const void*)hymba_fwd, hipFuncAttributeMaxDynamicSharedMemorySize, LDS_BYTES) != hipSuccess) { fprintf(stderr, "kernel_launch: hipFuncSetAttribute failed\n"); grid = -1; return; }
        if (hipOccupancyMaxActiveBlocksPerMultiprocessor(&per_cu, (const void*)hymba_fwd, 512, LDS_BYTES) != hipSuccess || per_cu < 1) fprintf(stderr, "kernel_launch: occupancy query reports %d\n", per_cu);
        (void)hipGetLastError();
        grid = cus;
    }
    if (grid < 0) return;
    (void)hipMemsetAsync((char*)d_ws + WS_CTL, 0, CTL_ZERO_BYTES, stream);
    Args a{};
    a.x = (const float*)d_in[0]; a.c = (const float*)d_in[1]; a.positions = (const int*)d_in[2]; a.norm1_g = (const float*)d_in[3]; a.norm2_g = (const float*)d_in[4];
    a.w_ada = (const float*)d_in[5]; a.b_ada = (const float*)d_in[6]; a.w_in = (const float*)d_in[7]; a.lam_q1 = (const float*)d_in[8]; a.lam_k1 = (const float*)d_in[9];
    a.lam_q2 = (const float*)d_in[10]; a.lam_k2 = (const float*)d_in[11]; a.diff_subln_g = (const float*)d_in[12]; a.dil_out_g = (const float*)d_in[13];
    a.w_out = (const float*)d_in[14]; a.peer_wq = (const float*)d_in[15]; a.peer_subkeys = (const float*)d_in[16]; a.peer_u = (const float*)d_in[17]; a.peer_v = (const float*)d_in[18];
    a.final_g = (const float*)d_in[19];
    a.out = (float*)d_out; a.ws = (unsigned char*)d_ws;
    if (MK_N_LAUNCHES == 1) { a.ph_lo = 0; a.ph_hi = NPHASE; hipLaunchKernelGGL(hymba_fwd, dim3(grid), dim3(512), LDS_BYTES, stream, a); }
    else { for (int p = 0; p < NPHASE; ++p) { a.ph_lo = p; a.ph_hi = p + 1; const int nr = ((REP_MASK >> p) & 1) ? 2 : 1;
            for (int r = 0; r < nr; ++r) { a.flag = (nr == 2 && r == 0) ? PROBE_FLAG_VAL : 0; hipLaunchKernelGGL(hymba_fwd, dim3(grid), dim3(512), LDS_BYTES, stream, a); } } }
#ifdef DBG_CHECK
    hipLaunchKernelGGL(dbg_kernel, dim3(grid), dim3(512), 0, stream, a, 0);
    hipLaunchKernelGGL(dbg_kernel, dim3(grid), dim3(512), 0, stream, a, 1);
#endif
}
```

```cpp
#include <hip/hip_runtime.h>
#include <cstdint>
#include <cstdio>

#define REP_MASK 0x000
#define PROBE_FLAG_VAL 0
#ifndef MK_N_LAUNCHES
#define MK_N_LAUNCHES 1
#endif
constexpr int NPHASE = 10;

constexpr int S = 8192, DM = 4096, NIN = 12288, NADA = 24576, NEXP = 16384;
constexpr float NORM_EPS = 1e-6f;
constexpr float LAM_INIT = 0.2f;

constexpr size_t MiB = 1u << 20;
constexpr size_t WS_CTL = 0, CTL_ZERO_BYTES = 128 * 1024;
constexpr size_t WS_MOD = 1 * MiB;
constexpr size_t WS_LAM = 1 * MiB + 128 * 1024;
constexpr size_t WS_ROPE = 2 * MiB;
constexpr size_t WS_WIN = 4 * MiB;
constexpr size_t WS_WOUT = 100 * MiB;
constexpr size_t WS_WSC = 132 * MiB;
constexpr size_t WS_UB = 148 * MiB;
constexpr size_t WS_VB = 276 * MiB;
constexpr size_t WS_H1 = 404 * MiB;
constexpr size_t WS_Y = 468 * MiB;
constexpr size_t WS_H2 = 532 * MiB;
constexpr size_t WS_QKV = 596 * MiB;
constexpr size_t QKV_T = (size_t)16 * S * 128;
constexpr size_t WS_OD = 788 * MiB;
constexpr size_t WS_OS = 916 * MiB;
constexpr size_t WS_H1F8 = 1012 * MiB;
constexpr size_t WIN8_OFF = 64 * MiB;
constexpr size_t WS_LSE = 1108 * MiB;
constexpr size_t WS_X1 = 1110 * MiB;
constexpr size_t WS_SC = 1238 * MiB;
constexpr size_t WS_IDX = 1302 * MiB;
constexpr size_t WS_GATE = 1306 * MiB;
constexpr size_t WS_QKV2 = 1310 * MiB;
constexpr size_t WS_END = 1502 * MiB;
constexpr int CW_BAR = 4096;

constexpr int RING_BYTES = 131072;
constexpr int MISC_OFF = RING_BYTES + 320;
constexpr int LDS_BYTES = 147456;

namespace pg8 {
#define PG8_LAS __attribute__((address_space(3)))
typedef unsigned short bf16_t;
typedef short bf16x8 __attribute__((ext_vector_type(8)));
typedef float f32x4 __attribute__((ext_vector_type(4)));
typedef unsigned u32x4 __attribute__((ext_vector_type(4)));
constexpr int BM = 256, BK = 64, HALF = 128, HTB = HALF * BK * 2  , STAGE_BYTES = 8 * HTB, NXCD = 8, WGM = 8;

__host__ __device__ __forceinline__ int lds_byte(int r, int c) { const int st = (r >> 4) * 2 + (c >> 5), rr = r & 15, cc = c & 31, ob = rr * 64 + cc * 2; return st * 1024 + (ob ^ (((ob >> 9) & 1) << 5)); }
__host__ __device__ __forceinline__ void stage_rc(int b, int& R, int& C) { const int st = b / 1024, sb = b % 1024, swz = sb ^ (((sb >> 9) & 1) << 5); R = (st >> 1) * 16 + swz / 64; C = (st & 1) * 32 + (swz % 64) / 2; }
__host__ __device__ __forceinline__ int perm32(int rho) { const int n = rho >> 4, i = rho & 15; return 8 * (i >> 2) + 4 * n + (i & 3); }

struct Unit { int pm, pn; };
struct Gemm { const bf16_t* A; const bf16_t* Bt; int M, N, K; };

struct StaticOrder {
    int nM, nN, nwg, G, c;
    __host__ __device__ void init(int M, int N, int G_, int c_) { nM = M / BM; nN = N / BM; nwg = nM * nN; G = G_; c = c_; }
    __host__ __device__ bool next(int i, Unit& u) const {
        const long L = (long)i * G + c; if (L >= nwg) return false;
        int wgid = (int)L; { const int q = nwg / NXCD, r = nwg % NXCD, xcd = wgid % NXCD, off = wgid / NXCD; wgid = (xcd < r ? xcd * (q + 1) : r * (q + 1) + (xcd - r) * q) + off; }
        const int nig = WGM * nN, gid = wgid / nig, fm = gid * WGM, gsz = (nM - fm) < WGM ? (nM - fm) : WGM;
        u.pm = fm + ((wgid % nig) % gsz); u.pn = (wgid % nig) / gsz; return true;
    }
    __device__ __forceinline__ void a_ready(const Unit&) const {}
    __device__ __forceinline__ void done(const Unit&) const {}
};
struct CountedOrder : StaticOrder {
    const unsigned* ready; unsigned need; unsigned* tmo;
    __device__ __forceinline__ void a_ready(const Unit& u) const {
        if (threadIdx.x < 64) {
            const unsigned long long t0 = __builtin_amdgcn_s_memrealtime(); unsigned polls = 0;
            while ((unsigned)__builtin_amdgcn_readfirstlane(__hip_atomic_load(ready + 64 * u.pm, __ATOMIC_RELAXED, __HIP_MEMORY_SCOPE_AGENT)) < need) {
                if ((++polls & 255u) == 0u && __builtin_amdgcn_readfirstlane(__hip_atomic_load(tmo, __ATOMIC_RELAXED, __HIP_MEMORY_SCOPE_AGENT)) != 0u) break;
                if (__builtin_amdgcn_s_memrealtime() - t0 > 2000000ull) {
                    if (threadIdx.x == 0) { unsigned expect = 0u; __hip_atomic_compare_exchange_strong(tmo + 1, &expect, 0x600u | (unsigned)(u.pm & 0xff), __ATOMIC_RELAXED, __ATOMIC_RELAXED, __HIP_MEMORY_SCOPE_AGENT); __hip_atomic_store(tmo, 1u, __ATOMIC_RELAXED, __HIP_MEMORY_SCOPE_AGENT); }
                    break; }
                __builtin_amdgcn_s_sleep(2); }
            __builtin_amdgcn_fence(__ATOMIC_ACQUIRE, "agent");
            asm volatile("s_waitcnt vmcnt(0)" ::: "memory");
        }
#if !defined(BROKEN_HOOK_NO_BARRIER)
        asm volatile("" ::: "memory"); __builtin_amdgcn_s_barrier(); asm volatile("" ::: "memory");
#endif
    }
};

__device__ __forceinline__ unsigned cvt_pk_bf16(float lo, float hi) { unsigned r; asm volatile("v_cvt_pk_bf16_f32 %0, %1, %2" : "=v"(r) : "v"(lo), "v"(hi)); return r; }
typedef float f32x2 __attribute__((ext_vector_type(2)));
__device__ __forceinline__ f32x2 gelu_pk(f32x2 v) {
    const f32x2 av = __builtin_elementwise_abs(v), d = av * 0.2316418882f + 1.0f;
    f32x2 t; t.x = __builtin_amdgcn_rcpf(d.x); t.y = __builtin_amdgcn_rcpf(d.y);
    f32x2 q = t * 0.5307027145f + (-0.7265760135f); q = q * t + 0.7107068705f; q = q * t + (-0.142248368f); q = q * t + 0.127414796f; q = q * t;
    const f32x2 s = (v * v) * (-0.72134752044f);
    f32x2 e; e.x = __builtin_amdgcn_exp2f(s.x); e.y = __builtin_amdgcn_exp2f(s.y);
    const f32x2 m = v * (q * e), r = v - m;
    f32x2 o; o.x = v.x < 0.f ? m.x : r.x; o.y = v.y < 0.f ? m.y : r.y; return o;
}

struct EpiF32 {
    static constexpr bool PERM = false, AFTER_DRAIN = false;
    float* C; int ldc; const float* bias;
    __device__ __forceinline__ void operator()(const f32x4 (&acc)[2][2][4][2], const Unit& u, int wr, int wc, int fr, int fq) const {
        const int row0 = u.pm * BM + wr * 64 + fr, col0 = u.pn * BM + wc * 32 + 4 * fq;
        f32x4 bv[2][2];
#pragma unroll
        for (int bj = 0; bj < 2; ++bj)
#pragma unroll
            for (int n = 0; n < 2; ++n) bv[bj][n] = bias ? *(const f32x4*)(bias + col0 + bj * HALF + n * 16) : (f32x4){0.f, 0.f, 0.f, 0.f};
#pragma unroll
        for (int ai = 0; ai < 2; ++ai)
#pragma unroll
            for (int m = 0; m < 4; ++m) { float* rowp = C + (size_t)(row0 + ai * HALF + m * 16) * ldc + col0;
#pragma unroll
                for (int bj = 0; bj < 2; ++bj)
#pragma unroll
                    for (int n = 0; n < 2; ++n) *(f32x4*)(rowp + bj * HALF + n * 16) = acc[ai][bj][m][n] + bv[bj][n]; }
    }
};
template <int ACT  > struct EpiBf16 {
    static constexpr bool PERM = true, AFTER_DRAIN = false;
    bf16_t* O; int ldc; const float* bias; int split_cols; size_t split_stride;
    __device__ __forceinline__ void operator()(const f32x4 (&acc)[2][2][4][2], const Unit& u, int wr, int wc, int fr, int fq) const {
        const int row0 = u.pm * BM + wr * 64 + fr; int colt = u.pn * BM; bf16_t* base = O;
        if (split_cols) { const int t = colt / split_cols; base += (size_t)t * split_stride; colt -= t * split_cols; }
        const int col0 = colt + wc * 32 + 8 * fq, bcol0 = u.pn * BM + wc * 32 + 8 * fq;
        f32x4 bv[2][2];
#pragma unroll
        for (int bj = 0; bj < 2; ++bj)
#pragma unroll
            for (int n = 0; n < 2; ++n) bv[bj][n] = bias ? *(const f32x4*)(bias + bcol0 + bj * HALF + 4 * n) : (f32x4){0.f, 0.f, 0.f, 0.f};
#pragma unroll
        for (int ai = 0; ai < 2; ++ai)
#pragma unroll
            for (int m = 0; m < 4; ++m) { bf16_t* rowp = base + (size_t)(row0 + ai * HALF + m * 16) * ldc + col0;
#pragma unroll
                for (int bj = 0; bj < 2; ++bj) { f32x4 v0 = acc[ai][bj][m][0] + bv[bj][0], v1 = acc[ai][bj][m][1] + bv[bj][1];
                    if (ACT == 1) { f32x2 a = gelu_pk((f32x2){v0[0], v0[1]}), b = gelu_pk((f32x2){v0[2], v0[3]}), c = gelu_pk((f32x2){v1[0], v1[1]}), d = gelu_pk((f32x2){v1[2], v1[3]});
                        v0 = (f32x4){a.x, a.y, b.x, b.y}; v1 = (f32x4){c.x, c.y, d.x, d.y}; }
                    if (ACT == 2) {
#pragma unroll
                        for (int j = 0; j < 4; ++j) { v0[j] = 0.5f * v0[j] * (1.0f + erff(v0[j] * 0.70710678f)); v1[j] = 0.5f * v1[j] * (1.0f + erff(v1[j] * 0.70710678f)); } }
                    u32x4 w; w.x = cvt_pk_bf16(v0[0], v0[1]); w.y = cvt_pk_bf16(v0[2], v0[3]); w.z = cvt_pk_bf16(v1[0], v1[1]); w.w = cvt_pk_bf16(v1[2], v1[3]);
                    *(u32x4*)(rowp + bj * HALF) = w; } }
    }
};
template <class Epi, class Sched, bool STAMP = false, bool F8 = false>
__device__ __forceinline__ void gemm_phase(PG8_LAS unsigned char* lds, const Gemm g, const Sched& S, const Epi& E, unsigned long long* stamps) {
    const int tid = threadIdx.x, wid = __builtin_amdgcn_readfirstlane(tid >> 6), lane = tid & 63, wr = wid >> 2, wc = wid & 3, fr = lane & 15, fq = lane >> 4;
    const int K = g.K, nt = K / BK;
    int ts_lo = 0, ts_hi = 0, nts = 0; const unsigned long long rt_entry = STAMP ? (unsigned long long)wall_clock64() : 0ull;
#define PG8_STAMP() do { if (STAMP && wid == 0 && nts < 64) { const unsigned long long _c = (unsigned long long)clock64(); \
        ts_lo = (lane == nts) ? (int)(unsigned)_c : ts_lo; ts_hi = (lane == nts) ? (int)(unsigned)(_c >> 32) : ts_hi; ++nts; } } while (0)
    PG8_STAMP();
    unsigned voffA[2], voffB[2];
#pragma unroll
    for (int i = 0; i < 2; ++i) { int R, C; stage_rc(tid * 16 + i * 8192, R, C); const int Rb = Epi::PERM ? ((R & ~31) + perm32(R & 31)) : R;
        voffA[i] = (unsigned)(R * K + C) * 2u; voffB[i] = (unsigned)(Rb * K + C) * 2u; }
    const size_t kstep = (size_t)(BK * 2);
    const size_t hstep = (size_t)HALF * K * 2;
    const size_t tstep = 2 * hstep;
    const unsigned ldsw = (unsigned)wid * 1024u;
    const int aoff = lds_byte(wr * 64 + fr, fq * 8), boff = lds_byte(wc * 32 + fr, fq * 8);
#define PG8_SA(b, h) (((b) * 2 + (h)) * HTB)
#define PG8_SB(b, h) ((4 + (b) * 2 + (h)) * HTB)
#define PG8_STAGE(bufoff, gbase, voff) do { _Pragma("unroll") for (int _i = 0; _i < 2; ++_i) \
        __builtin_amdgcn_global_load_lds((const unsigned*)((const char*)(gbase) + (voff)[_i]), (PG8_LAS unsigned*)(lds + (bufoff) + ldsw + _i * 8192), 16, 0, 0); } while (0)
typedef int pg8_i32x4 __attribute__((ext_vector_type(4))); typedef int pg8_i32x8 __attribute__((ext_vector_type(8)));
#define PG8_LD8(addr) __builtin_shufflevector(*(const PG8_LAS pg8_i32x4*)(addr), *(const PG8_LAS pg8_i32x4*)((addr) + 1024), 0, 1, 2, 3, 4, 5, 6, 7)
#define PG8_LDA(dst, b, h) do { if constexpr (F8) { _Pragma("unroll") for (int m = 0; m < 4; ++m) dst##8[m] = PG8_LD8(lds + PG8_SA(b, h) + aoff + m * 2048); } \
        else { _Pragma("unroll") for (int m = 0; m < 4; ++m) _Pragma("unroll") for (int k = 0; k < 2; ++k) dst[m][k] = *(const PG8_LAS bf16x8*)(lds + PG8_SA(b, h) + aoff + m * 2048 + k * 1024); } } while (0)
#define PG8_LDB(dst, b, h) do { if constexpr (F8) { _Pragma("unroll") for (int n = 0; n < 2; ++n) dst##8[n] = PG8_LD8(lds + PG8_SB(b, h) + boff + n * 2048); } \
        else { _Pragma("unroll") for (int n = 0; n < 2; ++n) _Pragma("unroll") for (int k = 0; k < 2; ++k) dst[n][k] = *(const PG8_LAS bf16x8*)(lds + PG8_SB(b, h) + boff + n * 2048 + k * 1024); } } while (0)
#define PG8_MMA(ai, bj, At, Bt) do { __builtin_amdgcn_s_setprio(1); _Pragma("unroll") for (int m = 0; m < 4; ++m) _Pragma("unroll") for (int n = 0; n < 2; ++n) { \
        if constexpr (F8) { asm volatile("v_mfma_scale_f32_16x16x128_f8f6f4 %0, %1, %2, %0, %3, %3 op_sel_hi:[0,0,0]" : "+v"(acc[ai][bj][m][n]) : "v"(Bt##8[n]), "v"(At##8[m]), "v"(sc1_)); } \
        else { _Pragma("unroll") for (int k = 0; k < 2; ++k) acc[ai][bj][m][n] = __builtin_amdgcn_mfma_f32_16x16x32_bf16(Bt[n][k], At[m][k], acc[ai][bj][m][n], 0, 0, 0); } } \
        __builtin_amdgcn_s_setprio(0); } while (0)
#define PG8_WAIT_V(n) asm volatile("s_waitcnt vmcnt(" #n ")" ::: "memory")
#define PG8_WAIT_L(n) asm volatile("s_waitcnt lgkmcnt(" #n ")" ::: "memory")
#define PG8_BAR __builtin_amdgcn_s_barrier()
#define PG8_SCHED __builtin_amdgcn_sched_barrier(0)
    Unit cur, nxt; int ui = 0;
    if (!S.next(0, cur)) return;
    f32x4 acc[2][2][4][2];
#pragma unroll
    for (int a = 0; a < 2; ++a)
#pragma unroll
        for (int b = 0; b < 2; ++b)
#pragma unroll
            for (int m = 0; m < 4; ++m)
#pragma unroll
                for (int n = 0; n < 2; ++n) acc[a][b][m][n] = (f32x4){0.f, 0.f, 0.f, 0.f};
    const int sc1_ = 0x7f7f7f7f;
    bf16x8 At[4][2], B0[2][2], B1[2][2]; pg8_i32x8 At8[4], B08[2], B18[2];
    const char* cA = (const char*)g.A + (size_t)cur.pm * tstep; const char* cB = (const char*)g.Bt + (size_t)cur.pn * tstep;
    S.a_ready(cur);
    PG8_STAGE(PG8_SB(0, 0), cB, voffB); PG8_STAGE(PG8_SA(0, 0), cA, voffA); PG8_STAGE(PG8_SB(0, 1), cB + hstep, voffB); PG8_STAGE(PG8_SA(0, 1), cA + hstep, voffA);
    if (wr == 1) PG8_BAR;
    PG8_WAIT_V(4); PG8_BAR;
    PG8_STAGE(PG8_SB(1, 0), cB + kstep, voffB); PG8_STAGE(PG8_SA(1, 0), cA + kstep, voffA); PG8_STAGE(PG8_SB(1, 1), cB + hstep + kstep, voffB);
    PG8_WAIT_V(6); PG8_BAR;
    PG8_STAMP();
    for (;;) {
        const bool has_next = S.next(ui + 1, nxt);
        const char* nA = has_next ? (const char*)g.A + (size_t)nxt.pm * tstep : cA; const char* nB = has_next ? (const char*)g.Bt + (size_t)nxt.pn * tstep : cB;
        for (int t = 0; t < nt; t += 2) {
            const bool last = (t == nt - 2);
            const char* a1 = cA + (size_t)(t + 1) * kstep;
            const char* a2 = last ? nA : cA + (size_t)(t + 2) * kstep; const char* b2 = last ? nB : cB + (size_t)(t + 2) * kstep;
            const char* a3 = a2 + kstep; const char* b3 = b2 + kstep;
            if (last && has_next) S.a_ready(nxt);
            PG8_LDB(B0, 0, 0); PG8_SCHED; PG8_LDA(At, 0, 0); PG8_STAGE(PG8_SA(1, 1), a1 + hstep, voffA);
            PG8_WAIT_L(8); PG8_BAR; PG8_WAIT_L(0); PG8_MMA(0, 0, At, B0); PG8_BAR; PG8_SCHED;
            PG8_LDB(B1, 0, 1); PG8_STAGE(PG8_SB(0, 0), b2, voffB);
            PG8_BAR; PG8_WAIT_L(0); PG8_MMA(0, 1, At, B1); PG8_BAR;
            PG8_LDA(At, 0, 1); PG8_STAGE(PG8_SA(0, 0), a2, voffA);
            PG8_BAR; PG8_WAIT_L(0); PG8_MMA(1, 0, At, B0); PG8_BAR; PG8_SCHED;
            PG8_STAGE(PG8_SB(0, 1), b2 + hstep, voffB);
            PG8_WAIT_V(6); PG8_BAR; PG8_MMA(1, 1, At, B1); PG8_BAR;
            PG8_LDB(B0, 1, 0); PG8_SCHED; PG8_LDA(At, 1, 0); PG8_STAGE(PG8_SA(0, 1), a2 + hstep, voffA);
            PG8_WAIT_L(8); PG8_BAR; PG8_WAIT_L(0); PG8_MMA(0, 0, At, B0); PG8_BAR; PG8_SCHED;
            PG8_LDB(B1, 1, 1); PG8_STAGE(PG8_SB(1, 0), b3, voffB);
            PG8_BAR; PG8_WAIT_L(0); PG8_MMA(0, 1, At, B1); PG8_BAR;
            PG8_LDA(At, 1, 1); PG8_STAGE(PG8_SA(1, 0), a3, voffA);
            PG8_BAR; PG8_WAIT_L(0); PG8_MMA(1, 0, At, B0); PG8_BAR; PG8_SCHED;
            PG8_STAGE(PG8_SB(1, 1), b3 + hstep, voffB);
            PG8_WAIT_V(6); PG8_BAR; PG8_MMA(1, 1, At, B1); PG8_BAR;
        }
        PG8_STAMP();
        if constexpr (!Epi::AFTER_DRAIN) { E(acc, cur, wr, wc, fr, fq); S.done(cur); }
        PG8_STAMP();
        if (!has_next) break;
#pragma unroll
        for (int a = 0; a < 2; ++a)
#pragma unroll
            for (int b = 0; b < 2; ++b)
#pragma unroll
                for (int m = 0; m < 4; ++m)
#pragma unroll
                    for (int n = 0; n < 2; ++n) acc[a][b][m][n] = (f32x4){0.f, 0.f, 0.f, 0.f};
        cur = nxt; cA = nA; cB = nB; ++ui;
    }
    PG8_WAIT_V(0);
    if (wr == 0) PG8_BAR;
    PG8_BAR;
    if constexpr (Epi::AFTER_DRAIN) { E.fused(acc, cur, wr, wc, fr, fq, lds, wid, lane); S.done(cur); }
    PG8_STAMP();
    if (STAMP && wid == 0) { stamps[lane] = lane < nts ? (((unsigned long long)(unsigned)ts_hi << 32) | (unsigned)ts_lo) : 0ull;
        if (lane == 62) stamps[62] = rt_entry; if (lane == 63) stamps[63] = (unsigned long long)wall_clock64(); }
#undef PG8_STAMP
#undef PG8_SA
#undef PG8_SB
#undef PG8_STAGE
#undef PG8_LDA
#undef PG8_LD8
#undef PG8_LDB
#undef PG8_MMA
#undef PG8_WAIT_V
#undef PG8_WAIT_L
#undef PG8_BAR
#undef PG8_SCHED
}
}
namespace at {
constexpr int D = 128;
constexpr float THR = 8.f;
constexpr float SCALE = 0.08838834764831845f;
constexpr int NW = 8, QBLK = 32, KVBLK = 64, QB = NW * QBLK;
constexpr int SHM_V = KVBLK * D * 2, SHM_K = KVBLK * D * 2;
constexpr int LDS_BYTES = 2 * SHM_V + 2 * SHM_K + NW * 64 * 4;

typedef unsigned short bf16;
typedef short bf16x8 __attribute__((ext_vector_type(8)));
typedef short s16x4 __attribute__((ext_vector_type(4)));
typedef float f32x16 __attribute__((ext_vector_type(16)));
typedef float f32x4 __attribute__((ext_vector_type(4)));
typedef unsigned u32x4 __attribute__((ext_vector_type(4)));
template <class A, class Bt> struct same_t { static constexpr bool v = false; };
template <class A> struct same_t<A, A> { static constexpr bool v = true; };

#define KSWZ(row, colB) ((row) * 256 + ((colB) ^ (((row) & 7) << 4)))
#define SBAR() __builtin_amdgcn_sched_barrier(0)
__device__ __forceinline__ int v_st(int k, int c) { const int kk = (k & ~0xC) | ((k & 4) << 1) | ((k & 8) >> 1); return ((kk >> 3) * 4 + (c >> 5)) * 512 + ((kk & 7) * 32 + (c & 31)) * 2; }
__device__ __forceinline__ int v_rd_base(int lane) { return ((lane & 3) << 3) | (((lane >> 2) & 3) << 6) | (((lane >> 4) & 1) << 5) | (((lane >> 5) & 1) << 8); }
constexpr int v_rd_off(int d0, int ks, int half) { return d0 * 512 + ks * 4096 + half * 2048; }
__device__ __forceinline__ int crow(int r, int hi) { return (r & 3) + 8 * (r >> 2) + 4 * hi; }
__device__ __forceinline__ unsigned cvtpk(float lo, float hi) {
    unsigned r; asm volatile("v_cvt_pk_bf16_f32 %0, %1, %2" : "=v"(r) : "v"(lo), "v"(hi)); return r;
}
__device__ __forceinline__ bf16x8 pack8(f32x4 a, f32x4 b) {
    u32x4 w = {cvtpk(a[0], a[1]), cvtpk(a[2], a[3]), cvtpk(b[0], b[1]), cvtpk(b[2], b[3])};
    return *reinterpret_cast<bf16x8*>(&w);
}
template <class T> __device__ __forceinline__ bf16x8 load8(const T* p) {
    if constexpr (same_t<T, float>::v) { return pack8(*(const f32x4*)p, *(const f32x4*)(p + 4)); }
    else { return *reinterpret_cast<const bf16x8*>(p); }
}
__device__ __forceinline__ void mask_tile(f32x16& p0, f32x16& p1, int dq, unsigned W) {
    const float NEG = -__builtin_inff();
#pragma unroll
    for (int r = 0; r < 16; ++r) {
        const int c = (r & 3) + 8 * (r >> 2);
        if ((unsigned)(dq - c) >= W) p0[r] = NEG;
        if ((unsigned)(dq - c - 32) >= W) p1[r] = NEG;
    }
}
__device__ __forceinline__ void partialSM(f32x16& p0, f32x16& p1, float& m_reg, float& mn, float& alpha) {
    float pmax = p0[0]; for (int r = 1; r < 16; ++r) pmax = fmaxf(pmax, p0[r]); for (int r = 0; r < 16; ++r) pmax = fmaxf(pmax, p1[r]);
    { auto rr = __builtin_amdgcn_permlane32_swap(__float_as_uint(pmax), __float_as_uint(pmax), false, false);
      pmax = fmaxf(__uint_as_float(rr[0]), __uint_as_float(rr[1])); }
    constexpr float C2 = 1.4426950408889634f * SCALE;
    if (__builtin_expect(__all((pmax - m_reg) * SCALE <= THR), 1)) { mn = m_reg; alpha = 1.f; }
    else { mn = fmaxf(m_reg, pmax); alpha = __builtin_amdgcn_exp2f((m_reg - mn) * C2); m_reg = mn; }
    const float mnL = -mn * C2;
    for (int r = 0; r < 16; ++r) p0[r] = fmaf(p0[r], C2, mnL); for (int r = 0; r < 16; ++r) p1[r] = fmaf(p1[r], C2, mnL);
    for (int r = 0; r < 16; ++r) p0[r] = __builtin_amdgcn_exp2f(p0[r]);
}
__device__ __forceinline__ void finishSM(f32x16& p0, f32x16& p1, float alpha, float& l_reg, bf16x8& pa0, bf16x8& pa1, bf16x8& pa2, bf16x8& pa3) {
    for (int r = 0; r < 16; ++r) p1[r] = __builtin_amdgcn_exp2f(p1[r]);
    float ps = 0; for (int r = 0; r < 16; ++r) ps += p0[r]; for (int r = 0; r < 16; ++r) ps += p1[r];
    { auto rr = __builtin_amdgcn_permlane32_swap(__float_as_uint(ps), __float_as_uint(ps), false, false);
      ps = __uint_as_float(rr[0]) + __uint_as_float(rr[1]); }
    l_reg = l_reg * alpha + ps;
#define PK4(P, B_, OUT) do { unsigned a0 = cvtpk(P[B_+0], P[B_+1]), a1 = cvtpk(P[B_+2], P[B_+3]);                          \
        unsigned b0 = cvtpk(P[B_+4], P[B_+5]), b1 = cvtpk(P[B_+6], P[B_+7]);                                             \
        auto r0 = __builtin_amdgcn_permlane32_swap(a0, b0, false, false); auto r1 = __builtin_amdgcn_permlane32_swap(a1, b1, false, false); \
        u32x4 w = {r0[0], r1[0], r0[1], r1[1]}; OUT = *reinterpret_cast<bf16x8*>(&w); } while (0)
    PK4(p0, 0, pa0); PK4(p0, 8, pa1); PK4(p1, 0, pa2); PK4(p1, 8, pa3);
#undef PK4
}
template <int KB, bool SK>
__device__ __forceinline__ void qkt(f32x16& p0, f32x16& p1, const char* K_lds, int r32, int hi, const bf16x8* qr, bool act) {
    if (SK && !act) { const float NEG = -__builtin_inff();
#pragma unroll
        for (int r = 0; r < 16; ++r) { p0[r] = NEG; p1[r] = NEG; } return; }
    p0 = f32x16{}; p1 = f32x16{};
    const char* kb[4];
#pragma unroll
    for (int dd = 0; dd < 4; ++dd) kb[dd] = K_lds + KB * SHM_K + KSWZ(r32, (dd * 16 + hi * 8) * 2);
#pragma unroll
    for (int d0 = 0; d0 < 8; ++d0) { const char* a = kb[d0 & 3] + (d0 >> 2) * 128;
        bf16x8 b0 = *reinterpret_cast<const bf16x8*>(a);
        bf16x8 b1 = *reinterpret_cast<const bf16x8*>(a + 32 * 256);
        p0 = __builtin_amdgcn_mfma_f32_32x32x16_bf16(b0, qr[d0], p0, 0, 0, 0);
        p1 = __builtin_amdgcn_mfma_f32_32x32x16_bf16(b1, qr[d0], p1, 0, 0, 0); }
}
template <int VB, bool SK>
__device__ __forceinline__ void pv_tile(f32x16* o, int vb0, bf16x8 pa0, bf16x8 pa1, bf16x8 pa2, bf16x8 pa3, bool act) {
    if (SK && !act) return;
#define TRRD(dst, off) asm volatile("ds_read_b64_tr_b16 %0, %1 offset:%2" : "=&v"(dst) : "v"(vb0), "i"(off) : "memory")
#define PV_D0(d0) do { s16x4 l0, l1, l2, l3, h0, h1, h2, h3; constexpr int b_ = VB * SHM_V + v_rd_off(d0, 0, 0);     \
        TRRD(l0, b_); TRRD(h0, b_ + 2048); TRRD(l1, b_ + 4096); TRRD(h1, b_ + 6144); TRRD(l2, b_ + 8192); TRRD(h2, b_ + 10240); TRRD(l3, b_ + 12288); TRRD(h3, b_ + 14336); \
        asm volatile("s_waitcnt lgkmcnt(0)" ::: "memory"); SBAR();                 \
        o[d0] = __builtin_amdgcn_mfma_f32_32x32x16_bf16(pa0, (bf16x8){l0[0], l0[1], l0[2], l0[3], h0[0], h0[1], h0[2], h0[3]}, o[d0], 0, 0, 0);   \
        o[d0] = __builtin_amdgcn_mfma_f32_32x32x16_bf16(pa1, (bf16x8){l1[0], l1[1], l1[2], l1[3], h1[0], h1[1], h1[2], h1[3]}, o[d0], 0, 0, 0);   \
        o[d0] = __builtin_amdgcn_mfma_f32_32x32x16_bf16(pa2, (bf16x8){l2[0], l2[1], l2[2], l2[3], h2[0], h2[1], h2[2], h2[3]}, o[d0], 0, 0, 0);   \
        o[d0] = __builtin_amdgcn_mfma_f32_32x32x16_bf16(pa3, (bf16x8){l3[0], l3[1], l3[2], l3[3], h3[0], h3[1], h3[2], h3[3]}, o[d0], 0, 0, 0); } while (0)
    PV_D0(0); PV_D0(1); PV_D0(2); PV_D0(3);
#undef PV_D0
#undef TRRD
}

struct BlockRef { const bf16* Q; const bf16* K; const bf16* V; bf16* O; float* L; int P0, W, skv, rs; };
struct Seam { bf16x8 qr[8]; bf16x8 st_v0, st_v1, st_k0, st_k1; };
__device__ __forceinline__ int swa_jlo(int P0, int W) { const int lowk = P0 - W + 1; return lowk > 0 ? lowk / KVBLK : 0; }
#define VMW() asm volatile("s_waitcnt vmcnt(0)" ::: "memory")
#define VMWN(n) asm volatile("s_waitcnt vmcnt(%0)" :: "i"(n) : "memory")
#define ROW(p, k0, rr) ((p) + (size_t)(unsigned)(((k0) + (rr)) * RS_) + sc)
#define RS_OF(ref) ({ int rs__ = (ref).rs; asm volatile("" : "+s"(rs__)); rs__; })
#define SLOAD_H(Kp, Vp, k0) do { S.st_v0 = load8<bf16>(ROW(Vp, k0, sr)); S.st_v1 = load8<bf16>(ROW(Vp, k0, 32 + sr));              \
                         S.st_k0 = load8<bf16>(ROW(Kp, k0, sr)); S.st_k1 = load8<bf16>(ROW(Kp, k0, 32 + sr)); } while (0)
#define SWRITE_HK(bf) do { *(bf16x8*)(K_lds + (bf) * SHM_K + kws) = S.st_k0; *(bf16x8*)(K_lds + (bf) * SHM_K + kws + 32 * 256) = S.st_k1; } while (0)
#define SWRITE_HV(bf) do { *(bf16x8*)(V_lds + (bf) * SHM_V + vst0) = S.st_v0; *(bf16x8*)(V_lds + (bf) * SHM_V + vst1) = S.st_v1; } while (0)
#define SWRITE_H(bf) do { SWRITE_HV(bf); SWRITE_HK(bf); } while (0)
__device__ __forceinline__ void causal_swa_prime(const BlockRef& cur, char* lds, Seam& S) {
    const int tid = threadIdx.x, wid = __builtin_amdgcn_readfirstlane(tid >> 6), lane = tid & 63, r32 = lane & 31, hi = lane >> 5;
    const int sr = tid >> 4, sc = (tid & 15) * 8, kws = KSWZ(sr, sc * 2); char* K_lds = lds + 2 * SHM_V;
    const int kb0 = swa_jlo(cur.P0, cur.W) * KVBLK;
    { const int RS_ = RS_OF(cur);
    for (int d0 = 0; d0 < 8; ++d0) S.qr[d0] = load8<bf16>(cur.Q + (size_t)(unsigned)((wid * QBLK + r32) * RS_) + d0 * 16 + hi * 8);
    SLOAD_H(cur.K, cur.V, kb0); } VMW(); SWRITE_HK(0);
    __syncthreads();
}
struct Svc { const float* tu; const float* tv; unsigned char* du; unsigned char* dv; int next, p_old, p_new, par, G, bid; };
constexpr int SVC_OFF = 73728, SVC_NCH = 65536;
typedef float svc_f4 __attribute__((ext_vector_type(4)));
__device__ __forceinline__ void svc_top(Svc& sv, char* lds) {
    if (sv.p_old < 0) return;
    int tid; asm volatile("v_mov_b32 %0, %1" : "=v"(tid) : "v"(threadIdx.x));
    const int g = sv.p_old, e = (g >> 1) & 16383;
    svc_f4 x = *(const svc_f4*)(lds + SVC_OFF + sv.par * 8192 + tid * 16);
    x *= (g >> 15) ? 16.0f : 256.0f;
    int w = __builtin_amdgcn_cvt_pk_fp8_f32(x.x, x.y, 0, false); w = __builtin_amdgcn_cvt_pk_fp8_f32(x.z, x.w, w, true);
    unsigned char* d = ((g >> 15) ? sv.dv : sv.du) + (size_t)e * 128 + ((size_t)(g & 1) << 25);
    __builtin_nontemporal_store(w, (int*)(d + (((tid >> 5) << 21) | ((tid & 31) << 2))));
}
__device__ __forceinline__ void svc_dma(Svc& sv, char* lds) {
    int tid; asm volatile("v_mov_b32 %0, %1" : "=v"(tid) : "v"(threadIdx.x));
    const int g = sv.next * sv.G + sv.bid;
    const bool live = sv.next >= 0 && g < SVC_NCH;
    const float* src = live ? ((g >> 15) ? sv.tv : sv.tu) + (size_t)((g >> 1) & 16383) * 4096 + (g & 1) * 2048 : sv.tu;
    const unsigned ldsa = __builtin_amdgcn_readfirstlane((unsigned)(uintptr_t)lds + SVC_OFF + sv.par * 8192 + (tid >> 6) * 1024);
    asm volatile("s_mov_b32 m0, %0\n\ts_nop 0\n\tglobal_load_lds_dwordx4 %1, %2 nt" :: "s"(ldsa), "v"(tid * 16), "s"(src) : "memory", "m0");
    sv.p_old = sv.p_new; sv.p_new = live ? g : -1; sv.next = live ? sv.next + 1 : -1; sv.par ^= 1;
}
__device__ __forceinline__ bool svc_busy(const Svc& sv) { return sv.next >= 0 || sv.p_old >= 0 || sv.p_new >= 0; }
template <bool SK>
__device__ __forceinline__ void causal_swa_block(const BlockRef& cur, const BlockRef& nxt, char* lds, Seam& S, Svc& sv) {
    const int tid = threadIdx.x, wid = __builtin_amdgcn_readfirstlane(tid >> 6), lane = tid & 63, r32 = lane & 31, hi = lane >> 5;
    const int W = cur.W, skv = cur.skv;
    const int j_lo = swa_jlo(cur.P0, W);
    int j_hi = (cur.P0 + QB - 1) / KVBLK + 1; if (j_hi > skv / KVBLK) j_hi = skv / KVBLK;
    const int NT = j_hi - j_lo;
    const int kbn = swa_jlo(nxt.P0, nxt.W) * KVBLK;
    const int qlo = cur.P0 + wid * QBLK, qm = qlo + r32 - 4 * hi;
    char* V_lds = lds; char* K_lds = lds + 2 * SHM_V;
    float* ws = (float*)(lds + 2 * SHM_V + 2 * SHM_K) + wid * 64; float* li_l = ws, * al_l = ws + 32;
    float m_reg = -1e30f, l_reg = 0; f32x16 o[4] = {};
    const int sr = tid >> 4, sc = (tid & 15) * 8, vst0 = v_st(sr, sc), vst1 = v_st(32 + sr, sc), kws = KSWZ(sr, sc * 2);
    const int vb0 = (int)(uintptr_t)V_lds + v_rd_base(lane);
    const bf16* Kh = cur.K; const bf16* Vh = cur.V;
#define RESC(a) do { if (__any((a) < 1.f)) { if (hi == 0) al_l[r32] = (a); asm volatile("s_waitcnt lgkmcnt(0)" ::: "memory");              \
                     for (int d_ = 0; d_ < 4; ++d_) for (int r = 0; r < 16; ++r) o[d_][r] *= al_l[crow(r, hi)]; } } while (0)
#define KBASE(t) ((j_lo + (t)) * KVBLK)
#define ACT(t) (KBASE(t) <= qlo + QBLK - 1 && KBASE(t) + KVBLK - 1 >= qlo - W + 1)
#define MASKT(P0_, P1_, t) do { const int kb_ = KBASE(t); if ((!SK || ACT(t)) && (kb_ + KVBLK - 1 > qlo || kb_ <= qlo + QBLK - 1 - W)) mask_tile(P0_, P1_, qm - kb_, (unsigned)W); } while (0)
    constexpr int NQL = 8;
#define SEAM_K0() do { VMWN(NQL); SWRITE_HK(0); SBAR(); } while (0)
    f32x16 pA0, pA1, pB0, pB1; float mnA, mnB, alA, alB; bf16x8 pa0, pa1, pa2, pa3;
    SWRITE_HV(0); SBAR();
    if (NT > 1) { const int RS_ = RS_OF(cur); SLOAD_H(Kh, Vh, KBASE(1)); }
    SBAR(); qkt<0, SK>(pA0, pA1, K_lds, r32, hi, S.qr, ACT(0));
    MASKT(pA0, pA1, 0); partialSM(pA0, pA1, m_reg, mnA, alA);
    if (NT > 1) { VMW(); SWRITE_H(1); }
    __syncthreads();
#define HALF_STEP(PX0, PX1, mnX, alX, PY0, PY1, alY, t, KB, VB, SB) do {                                                      \
        svc_top(sv, lds);                                                                                                     \
        SBAR(); qkt<KB, SK>(PX0, PX1, K_lds, r32, hi, S.qr, ACT(t));                                             \
        finishSM(PY0, PY1, alY, l_reg, pa0, pa1, pa2, pa3); SBAR();                                                           \
        if ((t) + 1 < NT) { const int RS_ = RS_OF(cur); SLOAD_H(Kh, Vh, KBASE((t) + 1)); } svc_dma(sv, lds); SBAR();                              \
        pv_tile<VB, SK>(o, vb0, pa0, pa1, pa2, pa3, ACT((t) - 1)); MASKT(PX0, PX1, (t)); partialSM(PX0, PX1, m_reg, mnX, alX);                                        \
        __syncthreads();                                                                                                      \
        if ((t) + 1 < NT) { VMWN(1); SWRITE_H(SB); }                                                                        \
        RESC(alX); __syncthreads(); } while (0)
    for (int t = 1; t + 1 < NT; t += 2) {
        HALF_STEP(pB0, pB1, mnB, alB, pA0, pA1, alA, t, 1, 0, 0);
        HALF_STEP(pA0, pA1, mnA, alA, pB0, pB1, alB, t + 1, 0, 1, 1);
    }
    const bool even = (NT & 1) == 0;
    if (even) { SBAR(); qkt<1, SK>(pB0, pB1, K_lds, r32, hi, S.qr, ACT(NT - 1)); SBAR(); }
    { const int RS_ = RS_OF(nxt); SLOAD_H(nxt.K, nxt.V, kbn); SBAR();
#pragma unroll
      for (int d0 = 0; d0 < 8; ++d0) S.qr[d0] = load8<bf16>(nxt.Q + (size_t)(unsigned)((wid * QBLK + r32) * RS_) + d0 * 16 + hi * 8); }
    SBAR();
    finishSM(pA0, pA1, alA, l_reg, pa0, pa1, pa2, pa3); SBAR();
    pv_tile<0, SK>(o, vb0, pa0, pa1, pa2, pa3, ACT(even ? NT - 2 : NT - 1));
    if (even) { MASKT(pB0, pB1, NT - 1); partialSM(pB0, pB1, m_reg, mnB, alB); __syncthreads(); RESC(alB);
        finishSM(pB0, pB1, alB, l_reg, pa0, pa1, pa2, pa3); SBAR(); pv_tile<1, SK>(o, vb0, pa0, pa1, pa2, pa3, ACT(NT - 1)); }
    SBAR(); SEAM_K0();
    if (hi == 0) li_l[r32] = l_reg; asm volatile("s_waitcnt lgkmcnt(0)" ::: "memory");
    if (cur.L != nullptr && hi == 0) cur.L[wid * QBLK + r32] = m_reg * SCALE + __logf(l_reg);
    float rli[16];
#pragma unroll
    for (int r = 0; r < 16; ++r) rli[r] = __builtin_amdgcn_rcpf(li_l[crow(r, hi)]);
    bf16* Ow = cur.O + (size_t)(wid * QBLK) * D;
#pragma unroll
    for (int r = 0; r < 16; ++r) { const int orow = crow(r, hi);
#pragma unroll
        for (int d0 = 0; d0 < 4; ++d0) { const float v = o[d0][r] * rli[r]; const float vn = __shfl_xor(v, 1);
            if ((r32 & 1) == 0) *(unsigned*)(Ow + (size_t)orow * D + d0 * 32 + r32) = cvtpk(v, vn); } }
    __syncthreads();
#undef RESC
#undef KBASE
#undef ACT
#undef MASKT
#undef SEAM_K0
#undef HALF_STEP
}
#undef ROW
#undef RS_OF
#undef VMW
#undef VMWN
#undef SLOAD_H
#undef SWRITE_HK
#undef SWRITE_HV
#undef SWRITE_H
#undef KSWZ
#undef SBAR
}
#define XB_TMO      128
#define XB_XCNT(j)  (256  + 64 * (j))
#define XB_XSUB(j)  (1280 + 64 * (j))
#define XB_XGEN(j)  (2304 + 64 * (j))
#define XB_TOP      3328
#define XB_TOPGEN   3392
#define XCD_BAR_WORDS 3456
#define XB_SPIN_CAP (1u << 18)
#define LAS __attribute__((address_space(3)))

__device__ __forceinline__ unsigned xb_ld(unsigned* p)              { return __hip_atomic_load(p, __ATOMIC_RELAXED, __HIP_MEMORY_SCOPE_AGENT); }
__device__ __forceinline__ unsigned xb_add(unsigned* p, unsigned v) { return __hip_atomic_fetch_add(p, v, __ATOMIC_RELAXED, __HIP_MEMORY_SCOPE_AGENT); }
__device__ __forceinline__ unsigned xb_xcc_id() { return (unsigned)__builtin_amdgcn_s_getreg((3 << 11) | 20) & 0xFu; }
#define XB_SPIN(cond, bar) do { unsigned _sp = 0; while (cond) { __builtin_amdgcn_s_sleep(1); \
    if ((++_sp & 255u) == 0u) { if (xb_ld(&(bar)[XB_TMO])) break; if (_sp > XB_SPIN_CAP) { atomicAdd(&(bar)[XB_TMO], 1u); break; } } } } while (0)

struct XcdBarrier {
    unsigned* bar; unsigned x;
    volatile LAS unsigned* st;
};

__device__ __forceinline__ XcdBarrier xcd_barrier_post(unsigned* bar, volatile LAS unsigned* st) {
    XcdBarrier b; b.bar = bar; b.x = xb_xcc_id(); b.st = st;
    if (threadIdx.x == 0) (void)xb_add(&bar[XB_XCNT(b.x)], 1u);
    return b;
}
__device__ __forceinline__ void xcd_barrier_complete(unsigned* bar, unsigned x, unsigned& nloc, unsigned& nx) {
    const unsigned G = gridDim.x * gridDim.y * gridDim.z;
    unsigned sum, cnt, mine, sp = 0u;
    for (;;) {
        sum = 0u; cnt = 0u; mine = 0u;
#pragma unroll
        for (unsigned j = 0; j < 16; ++j) { const unsigned c = xb_ld(&bar[XB_XCNT(j)]); sum += c; cnt += (c > 0u) ? 1u : 0u; mine = (j == x) ? c : mine; }
        if (sum == G) break;
        __builtin_amdgcn_s_sleep(1);
        if ((++sp & 255u) == 0u) { if (xb_ld(&bar[XB_TMO])) break; if (sp > XB_SPIN_CAP) { atomicAdd(&bar[XB_TMO], 1u); break; } }
    }
    nloc = mine > 0u ? mine : 1u; nx = cnt > 0u ? cnt : 1u;
}

__device__ __forceinline__ void xcd_barrier(const XcdBarrier& b) {
    asm volatile("s_waitcnt vmcnt(0)" ::: "memory");
    __syncthreads();
    if (threadIdx.x == 0) {
        unsigned* bar = b.bar;
        __builtin_amdgcn_s_waitcnt(0);
        unsigned nloc = b.st[0], nx = b.st[1];
        if (nloc == 0u) { xcd_barrier_complete(bar, b.x, nloc, nx); b.st[0] = nloc; b.st[1] = nx; }
        const unsigned old = xb_add(&bar[XB_XSUB(b.x)], 1u);
        const unsigned gen = old / nloc;
        if (old + 1u == (gen + 1u) * nloc) {
            __builtin_amdgcn_fence(__ATOMIC_RELEASE, "agent");
            asm volatile("s_waitcnt vmcnt(0)" ::: "memory");
            const unsigned og = xb_add(&bar[XB_TOP], 1u);
            const unsigned tg = og / nx;
            if (og + 1u == (tg + 1u) * nx) xb_add(&bar[XB_TOPGEN], 1u);
            else XB_SPIN(xb_ld(&bar[XB_TOPGEN]) == tg, bar);
            __builtin_amdgcn_fence(__ATOMIC_ACQUIRE, "agent");
            xb_add(&bar[XB_XGEN(b.x)], 1u);
            asm volatile("s_waitcnt vmcnt(0)" ::: "memory");
        } else {
            XB_SPIN(xb_ld(&bar[XB_XGEN(b.x)]) == gen, bar);
            __builtin_amdgcn_fence(__ATOMIC_ACQUIRE, "agent");
            asm volatile("s_waitcnt vmcnt(0)" ::: "memory");
        }
    }
    __syncthreads();
}
typedef unsigned short bf16_t;
typedef float f32x4 __attribute__((ext_vector_type(4)));
typedef float f32x2 __attribute__((ext_vector_type(2)));
typedef unsigned u32x4 __attribute__((ext_vector_type(4)));
typedef unsigned u32x2 __attribute__((ext_vector_type(2)));
typedef __bf16 bf16v2 __attribute__((ext_vector_type(2)));
#define LDS_WAIT() asm volatile("s_waitcnt lgkmcnt(0)" ::: "memory")

struct Args {
    const float* x; const float* c; const int* positions; const float* norm1_g; const float* norm2_g; const float* w_ada; const float* b_ada;
    const float* w_in; const float* lam_q1; const float* lam_k1; const float* lam_q2; const float* lam_k2; const float* diff_subln_g; const float* dil_out_g;
    const float* w_out; const float* peer_wq; const float* peer_subkeys; const float* peer_u; const float* peer_v; const float* final_g;
    float* out; unsigned char* ws; int ph_lo, ph_hi, flag, pad;
};

__device__ __forceinline__ unsigned cvt_pk(float lo, float hi) { unsigned r; asm volatile("v_cvt_pk_bf16_f32 %0, %1, %2" : "=v"(r) : "v"(lo), "v"(hi)); return r; }
__device__ __forceinline__ float bf_lo(unsigned u) { return __uint_as_float(u << 16); }
__device__ __forceinline__ float bf_hi(unsigned u) { return __uint_as_float(u & 0xffff0000u); }
__device__ __forceinline__ float dot2bf(unsigned a, unsigned b, float c) { return __builtin_amdgcn_fdot2_f32_bf16(__builtin_bit_cast(bf16v2, a), __builtin_bit_cast(bf16v2, b), c, false); }
__device__ __forceinline__ unsigned pk_fp8(const f32x4 v) { int r = __builtin_amdgcn_cvt_pk_fp8_f32(v.x, v.y, 0, false); r = __builtin_amdgcn_cvt_pk_fp8_f32(v.z, v.w, r, true); return (unsigned)r; }
__device__ __forceinline__ f32x4 ld4bf(const bf16_t* p) { const u32x2 w = *(const u32x2*)p; return (f32x4){bf_lo(w.x), bf_hi(w.x), bf_lo(w.y), bf_hi(w.y)}; }
__device__ __forceinline__ float wave_sum(float v) {
#pragma unroll
    for (int o = 1; o < 64; o <<= 1) v += __shfl_xor(v, o);
    return v;
}
__device__ __forceinline__ float half_sum(float v) {
#pragma unroll
    for (int o = 1; o < 32; o <<= 1) v += __shfl_xor(v, o);
    return v;
}

#ifdef PROBE_FLAGS
#define P0SEL(b) (!(A.flag & 0xf00) || (A.flag & (0x100 << (b))))
#else
#define P0SEL(b) true
#endif
__device__ __forceinline__ void p0_gemv_unit(const Args& A, float* mod, LAS float* red, int unit, int tid) {
    LAS float* sc = red + 2048;
    for (int i = tid; i < DM; i += 512) { const float cv = A.c[i]; sc[i] = cv / (1.0f + __expf(-cv)); }
    __syncthreads();
    const int rl = tid / 24, c4 = tid - rl * 24;
    if (tid < 384) {
        const float* wp = A.w_ada + (size_t)rl * NADA + unit * 96 + c4 * 4;
        const LAS float* cp = sc + rl;
        f32x4 acc = {0.f, 0.f, 0.f, 0.f};
        f32x4 w0[8], w1[8];
#pragma unroll
        for (int i = 0; i < 8; ++i) w0[i] = *(const f32x4*)(wp + (size_t)(16 * i) * NADA);
        for (int k0 = 0; k0 < DM; k0 += 256) {
#pragma unroll
            for (int i = 0; i < 8; ++i) w1[i] = *(const f32x4*)(wp + (size_t)(k0 + 128 + 16 * i) * NADA);
#pragma unroll
            for (int i = 0; i < 8; ++i) acc += cp[k0 + 16 * i] * w0[i];
            if (k0 + 256 < DM) {
#pragma unroll
                for (int i = 0; i < 8; ++i) w0[i] = *(const f32x4*)(wp + (size_t)(k0 + 256 + 16 * i) * NADA);
            }
#pragma unroll
            for (int i = 0; i < 8; ++i) acc += cp[k0 + 128 + 16 * i] * w1[i];
        }
        *(LAS f32x4*)(red + rl * 96 + c4 * 4) = acc;
    }
    __syncthreads();
    if (tid < 96) { float s = 0.f;
#pragma unroll
        for (int r = 0; r < 16; ++r) s += red[r * 96 + tid];
        mod[unit * 96 + tid] = s + A.b_ada[unit * 96 + tid]; }
    __syncthreads();
}
__device__ __forceinline__ void p0_tr_load(const float* W, int N, int item, int lane, f32x4 (&ld)[8]) {
    const int nblk = N / 32, kb = item / nblk, nb = item - kb * nblk;
    const float* p = W + (size_t)(64 * kb + (lane >> 3)) * N + 32 * nb + 4 * (lane & 7);
#pragma unroll
    for (int i = 0; i < 8; ++i) ld[i] = *(const f32x4*)(p + (size_t)(8 * i) * N);
}
template <bool F8>
__device__ __forceinline__ void p0_tr_store(const f32x4 (&ld)[8], int K, int N, bf16_t* WT, LAS float* scr, int item, int lane) {
    const int nblk = N / 32, kb = item / nblk, nb = item - kb * nblk, k0 = 64 * kb, n0 = 32 * nb;
#pragma unroll
    for (int i = 0; i < 8; ++i) { LAS float* d = scr + (8 * i + (lane >> 3)) * 33 + 4 * (lane & 7); d[0] = ld[i].x; d[1] = ld[i].y; d[2] = ld[i].z; d[3] = ld[i].w; }
    LDS_WAIT(); asm volatile("" ::: "memory");
    const int c = lane & 7;
#pragma unroll
    for (int j = 0; j < 4; ++j) { const int n = (lane >> 3) + 8 * j; const LAS float* s = scr + (8 * c) * 33 + n;
        if (F8) { u32x2 o8; o8.x = pk_fp8((f32x4){s[0 * 33], s[1 * 33], s[2 * 33], s[3 * 33]} * 1024.0f); o8.y = pk_fp8((f32x4){s[4 * 33], s[5 * 33], s[6 * 33], s[7 * 33]} * 1024.0f);
            *(u32x2*)((unsigned char*)WT + (size_t)(n0 + n) * K + k0 + 8 * c) = o8; }
        else { u32x4 o; o.x = cvt_pk(s[0 * 33], s[1 * 33]); o.y = cvt_pk(s[2 * 33], s[3 * 33]); o.z = cvt_pk(s[4 * 33], s[5 * 33]); o.w = cvt_pk(s[6 * 33], s[7 * 33]);
            *(u32x4*)(WT + (size_t)(n0 + n) * K + k0 + 8 * c) = o; } }
    LDS_WAIT(); asm volatile("" ::: "memory");
}
typedef __bf16 bf16v8_t __attribute__((ext_vector_type(8))); typedef float f32x8_t __attribute__((ext_vector_type(8)));
__device__ __forceinline__ pg8::bf16x8 pack8f(const f32x4 a, const f32x4 b) { const f32x8_t v = {a.x, a.y, a.z, a.w, b.x, b.y, b.z, b.w}; return __builtin_bit_cast(pg8::bf16x8, __builtin_convertvector(v, bf16v8_t)); }
__device__ __forceinline__ void p0_fold_item(const Args& A, bf16_t* wsc, int item, int lane) {
    const int g = item >> 7, d0 = (item & 127) * 32, r = lane & 15, kg = lane >> 4;
    pg8::bf16x8 af[2][4];
#pragma unroll
    for (int mt = 0; mt < 2; ++mt)
#pragma unroll
        for (int ks = 0; ks < 4; ++ks) { const float* p = A.peer_wq + (size_t)(d0 + 16 * mt + r) * 2048 + g * 128 + 32 * ks + 8 * kg; af[mt][ks] = pack8f(*(const f32x4*)p, *(const f32x4*)(p + 4)); }
    const float* skp = A.peer_subkeys + (size_t)g * 16384 + 8 * kg;
#pragma unroll 2
    for (int nt = 0; nt < 8; ++nt) {
        pg8::bf16x8 bfr[4];
#pragma unroll
        for (int ks = 0; ks < 4; ++ks) { const float* p = skp + (size_t)(16 * nt + r) * 128 + 32 * ks; bfr[ks] = pack8f(*(const f32x4*)p, *(const f32x4*)(p + 4)); }
#pragma unroll
        for (int mt = 0; mt < 2; ++mt) {
            f32x4 c = {0.f, 0.f, 0.f, 0.f};
#pragma unroll
            for (int ks = 0; ks < 4; ++ks) c = __builtin_amdgcn_mfma_f32_16x16x32_bf16(af[mt][ks], bfr[ks], c, 0, 0, 0);
            typedef __bf16 bf16v4_t __attribute__((ext_vector_type(4)));
            const u32x2 w = __builtin_bit_cast(u32x2, __builtin_convertvector(c, bf16v4_t));
            *(u32x2*)(wsc + (size_t)(g * 128 + 16 * nt + r) * DM + d0 + 16 * mt + 4 * kg) = w;
        }
    }
}
__device__ __forceinline__ void p0_cv_load(const Args& A, int item, int lane, f32x4 (&lu)[4], f32x4 (&lv)[4]) {
    const int eb = item >> 5, s = item & 31;
    const size_t off = (size_t)(eb * 8 + (lane >> 3)) * DM + s * 128 + 16 * (lane & 7);
#pragma unroll
    for (int i = 0; i < 4; ++i) { lu[i] = *(const f32x4*)(A.peer_u + off + 4 * i); lv[i] = *(const f32x4*)(A.peer_v + off + 4 * i); }
}
__device__ __forceinline__ void p0_cv_store(unsigned char* ws, int item, int lane, const f32x4 (&lu)[4], const f32x4 (&lv)[4]) {
    const int eb = item >> 5, s = item & 31;
    const size_t dst = ((size_t)s * NEXP + (size_t)eb * 8) * 8 + lane;
    u32x4 o, p;
    o.x = pk_fp8(lu[0] * 256.0f); o.y = pk_fp8(lu[1] * 256.0f); o.z = pk_fp8(lu[2] * 256.0f); o.w = pk_fp8(lu[3] * 256.0f);
    p.x = pk_fp8(lv[0] * 16.0f); p.y = pk_fp8(lv[1] * 16.0f); p.z = pk_fp8(lv[2] * 16.0f); p.w = pk_fp8(lv[3] * 16.0f);
    ((u32x4*)(ws + WS_UB))[dst] = o; ((u32x4*)(ws + WS_VB))[dst] = p;
}
__device__ __forceinline__ void p0_fold_item_old(const Args& A, bf16_t* wsc, LAS float* lds, int item, int tid) {
    const int g = item >> 6, d0 = (item & 63) * 64;
    LAS float* SK = lds;
    LAS float* WQ = lds + 128 * 132;
    const float* skp = A.peer_subkeys + (size_t)g * 16384;
    for (int i = tid; i < 128 * 32; i += 512) { const int n = i >> 5, k4 = i & 31; *(LAS f32x4*)(SK + n * 132 + 4 * k4) = *(const f32x4*)(skp + n * 128 + 4 * k4); }
    for (int i = tid; i < 64 * 32; i += 512) { const int d = i >> 5, k4 = i & 31; *(LAS f32x4*)(WQ + d * 132 + 4 * k4) = *(const f32x4*)(A.peer_wq + (size_t)(d0 + d) * 2048 + g * 128 + 4 * k4); }
    __syncthreads();
    const int n = tid & 127, dg = tid >> 7;
    float acc[16];
#pragma unroll
    for (int j = 0; j < 16; ++j) acc[j] = 0.f;
    for (int k4 = 0; k4 < 32; ++k4) {
        const f32x4 a = *(const LAS f32x4*)(SK + n * 132 + 4 * k4);
#pragma unroll
        for (int j = 0; j < 16; ++j) { const f32x4 b = *(const LAS f32x4*)(WQ + (dg * 16 + j) * 132 + 4 * k4); acc[j] += a.x * b.x + a.y * b.y + a.z * b.z + a.w * b.w; }
    }
    u32x4 o0, o1;
    o0.x = cvt_pk(acc[0], acc[1]); o0.y = cvt_pk(acc[2], acc[3]); o0.z = cvt_pk(acc[4], acc[5]); o0.w = cvt_pk(acc[6], acc[7]);
    o1.x = cvt_pk(acc[8], acc[9]); o1.y = cvt_pk(acc[10], acc[11]); o1.z = cvt_pk(acc[12], acc[13]); o1.w = cvt_pk(acc[14], acc[15]);
    bf16_t* op = wsc + (size_t)(g * 128 + n) * DM + d0 + dg * 16;
    *(u32x4*)op = o0; *(u32x4*)(op + 8) = o1;
    __syncthreads();
}
__device__ __forceinline__ void p0_prologue(const Args& A, LAS unsigned char* lds, int G, int bid, int tid) {
    const int lane = tid & 63, wave = __builtin_amdgcn_readfirstlane(tid >> 6);
    unsigned char* ws = A.ws;
    float* mod = (float*)(ws + WS_MOD);
    const int gw = bid * 8 + wave, NGW = G * 8;
    if (P0SEL(0)) for (int u = bid; u < NADA / 96; u += G) p0_gemv_unit(A, mod, (LAS float*)lds, u, tid);
    if (bid == G - 1 && wave == 0) {
        float a = 0.f, b = 0.f;
        for (int i = lane; i < 128; i += 64) { a += A.lam_q1[i] * A.lam_k1[i]; b += A.lam_q2[i] * A.lam_k2[i]; }
        a = wave_sum(a); b = wave_sum(b);
        if (lane == 0) *(float*)(ws + WS_LAM) = expf(a) - expf(b) + LAM_INIT;
    }
    {
        float* rope = (float*)(ws + WS_ROPE);
        for (int i = bid * 512 + tid; i < S * 16; i += G * 512) {
            const int s = i >> 4, f = i & 15;
            const float inv = powf(500000.0f, -(float)(2 * f) / 32.0f);
            const float ang = (float)A.positions[s] * inv;
            double rev = (double)ang * 0.15915494309189535; rev -= rint(rev);
            const float fr = (float)rev;
            rope[s * 32 + f] = __builtin_amdgcn_cosf(fr);
            rope[s * 32 + 16 + f] = __builtin_amdgcn_sinf(fr);
        }
    }
    if (P0SEL(1)) {
        LAS float* scr = (LAS float*)(lds + wave * 16384);
        constexpr int I_IN = (DM / 64) * (NIN / 32), I_OUT = (DM / 64) * (DM / 32);
        bf16_t* win = (bf16_t*)(ws + WS_WIN); bf16_t* wout = (bf16_t*)(ws + WS_WOUT);
        f32x4 cur[8], nxt[8];
        int it = gw;
        if (it < I_IN + I_OUT) { if (it < I_IN) p0_tr_load(A.w_in, NIN, it, lane, cur); else p0_tr_load(A.w_out, DM, it - I_IN, lane, cur); }
        for (; it < I_IN + I_OUT; it += NGW) {
            const int itn = it + NGW;
            if (itn < I_IN + I_OUT) { if (itn < I_IN) p0_tr_load(A.w_in, NIN, itn, lane, nxt); else p0_tr_load(A.w_out, DM, itn - I_IN, lane, nxt); }
            if (it < I_IN) { const int T_ = ((it % (NIN / 32)) * 32) >> 11;
                if (T_ == 2 || T_ == 5) p0_tr_store<true>(cur, DM, NIN, (bf16_t*)((unsigned char*)win + WIN8_OFF + ((ptrdiff_t)(T_ == 2 ? -4096 : -8192)) * DM), scr, it, lane);
                else p0_tr_store<false>(cur, DM, NIN, win + ((ptrdiff_t)(T_ > 2 ? -2048 : 0)) * DM, scr, it, lane); }
            else p0_tr_store<true>(cur, DM, DM, wout, scr, it - I_IN, lane);
#pragma unroll
            for (int i = 0; i < 8; ++i) cur[i] = nxt[i];
        }
    }
#ifdef OLD_FOLD
    __syncthreads();
    if (P0SEL(2)) for (int it = bid; it < 16 * 64; it += G) p0_fold_item_old(A, (bf16_t*)(ws + WS_WSC), (LAS float*)lds, it, tid);
#else
    if (P0SEL(2)) for (int it = gw; it < 16 * 128; it += NGW) p0_fold_item(A, (bf16_t*)(ws + WS_WSC), it, lane);
#endif
    if (false) {
        constexpr int NIT = (NEXP / 8) * 32;
        f32x4 cu[4], cv[4], nu[4], nv[4];
        int it = gw;
        if (it < NIT) p0_cv_load(A, it, lane, cu, cv);
        for (; it < NIT; it += NGW) {
            const int itn = it + NGW;
            if (itn < NIT) p0_cv_load(A, itn, lane, nu, nv);
            p0_cv_store(ws, it, lane, cu, cv);
#pragma unroll
            for (int i = 0; i < 4; ++i) { cu[i] = nu[i]; cv[i] = nv[i]; }
        }
    }
    __syncthreads();
}

template <bool INBF, bool F8OUT>
__device__ __forceinline__ void row_modulate(const void* xin_, const float* g, const float* sh, const float* sc, bf16_t* out, unsigned char* out8, LAS float* lv, int tid, int gw, int ngw, int lane) {
    for (int i = tid; i < DM / 4; i += 512) { const f32x4 gv = ((const f32x4*)g)[i], sv = ((const f32x4*)sc)[i]; ((LAS f32x4*)lv)[i] = gv * (1.0f + sv); ((LAS f32x4*)(lv + DM))[i] = ((const f32x4*)sh)[i]; }
    __syncthreads();
    for (int r = gw; r < S; r += ngw) {
        f32x4 v[16]; float ss = 0.f;
        if (INBF) { const bf16_t* xr = (const bf16_t*)xin_ + (size_t)r * DM + 8 * lane;
#pragma unroll
            for (int j = 0; j < 8; ++j) { const u32x4 w = *(const u32x4*)(xr + 512 * j);
                v[2 * j] = (f32x4){bf_lo(w.x), bf_hi(w.x), bf_lo(w.y), bf_hi(w.y)}; v[2 * j + 1] = (f32x4){bf_lo(w.z), bf_hi(w.z), bf_lo(w.w), bf_hi(w.w)}; }
        } else { const float* xr = (const float*)xin_ + (size_t)r * DM + 8 * lane;
#pragma unroll
            for (int j = 0; j < 8; ++j) { v[2 * j] = *(const f32x4*)(xr + 512 * j); v[2 * j + 1] = *(const f32x4*)(xr + 512 * j + 4); }
        }
#pragma unroll
        for (int j = 0; j < 16; ++j) ss += (v[j].x * v[j].x + v[j].y * v[j].y) + (v[j].z * v[j].z + v[j].w * v[j].w);
        ss = wave_sum(ss);
        const float rstd = 1.0f / sqrtf(ss * (1.0f / DM) + NORM_EPS);
        bf16_t* orow = out + (size_t)r * DM + 8 * lane;
#pragma unroll
        for (int j = 0; j < 8; ++j) { const int c = 8 * lane + 512 * j;
            const f32x4 a0 = *(const LAS f32x4*)(lv + c), a1 = *(const LAS f32x4*)(lv + c + 4), h0 = *(const LAS f32x4*)(lv + DM + c), h1 = *(const LAS f32x4*)(lv + DM + c + 4);
            const f32x4 y0 = v[2 * j] * rstd * a0 + h0, y1 = v[2 * j + 1] * rstd * a1 + h1;
            u32x4 w; w.x = cvt_pk(y0.x, y0.y); w.y = cvt_pk(y0.z, y0.w); w.z = cvt_pk(y1.x, y1.y); w.w = cvt_pk(y1.z, y1.w);
            *(u32x4*)(orow + 512 * j) = w;
            if (F8OUT) { u32x2 w8; w8.x = pk_fp8(y0 * 16.0f); w8.y = pk_fp8(y1 * 16.0f); *(u32x2*)(out8 + (size_t)r * DM + c) = w8; }
            if ((j & 3) == 3) __builtin_amdgcn_sched_barrier(0); }
    }
    __syncthreads();
}

struct EpiQKV {
    static constexpr bool PERM = true, AFTER_DRAIN = false;
    bf16_t* qkv; bf16_t* qkv2; const float* rope; int skip;
    __device__ __forceinline__ void operator()(const pg8::f32x4 (&acc)[2][2][4][2], const pg8::Unit& u, int wr, int wc, int fr, int fq) const {
        if (skip) return;
        const int tt_ = u.pn >> 3, T = tt_ + (tt_ >= 2 ? 1 : 0), hh0 = 2 * (u.pn & 7);
        const bool rot = (wc == 0);
        const int d0 = wc * 32 + 8 * fq;
        const float sgn = (fq < 2) ? -1.0f : 1.0f;
        bf16_t* base = qkv + (size_t)T * QKV_T + d0;
        const int rowb = u.pm * 256 + wr * 64 + fr;
        f32x4 cs0 = {1.f, 1.f, 1.f, 1.f}, cs1 = cs0, sn0 = {0.f, 0.f, 0.f, 0.f}, sn1 = sn0, ncs0 = cs0, ncs1 = cs0, nsn0 = sn0, nsn1 = sn0;
        if (rot) { const float* rp = rope + (size_t)rowb * 32 + 8 * (fq & 1);
            cs0 = *(const f32x4*)rp; cs1 = *(const f32x4*)(rp + 4); sn0 = *(const f32x4*)(rp + 16); sn1 = *(const f32x4*)(rp + 20); }
#pragma unroll
        for (int gi = 0; gi < 8; ++gi) {
            const int ai = gi >> 2, m = gi & 3;
            const int row = rowb + ai * 128 + m * 16;
            if (rot && gi < 7) { const int nrow = rowb + ((gi + 1) >> 2) * 128 + ((gi + 1) & 3) * 16; const float* rp = rope + (size_t)nrow * 32 + 8 * (fq & 1);
                ncs0 = *(const f32x4*)rp; ncs1 = *(const f32x4*)(rp + 4); nsn0 = *(const f32x4*)(rp + 16); nsn1 = *(const f32x4*)(rp + 20); }
#pragma unroll
            for (int bj = 0; bj < 2; ++bj) {
                f32x4 v0 = acc[ai][bj][m][0], v1 = acc[ai][bj][m][1];
                if (rot) {
                    f32x4 o0, o1;
                    o0.x = __shfl_xor(v0.x, 32); o0.y = __shfl_xor(v0.y, 32); o0.z = __shfl_xor(v0.z, 32); o0.w = __shfl_xor(v0.w, 32);
                    o1.x = __shfl_xor(v1.x, 32); o1.y = __shfl_xor(v1.y, 32); o1.z = __shfl_xor(v1.z, 32); o1.w = __shfl_xor(v1.w, 32);
                    v0 = v0 * cs0 + sgn * o0 * sn0; v1 = v1 * cs1 + sgn * o1 * sn1;
                }
                u32x4 w; w.x = cvt_pk(v0[0], v0[1]); w.y = cvt_pk(v0[2], v0[3]); w.z = cvt_pk(v1[0], v1[1]); w.w = cvt_pk(v1[2], v1[3]);
                *(u32x4*)(base + ((size_t)(hh0 + bj) * S + row) * 128) = w;
            }
            cs0 = ncs0; cs1 = ncs1; sn0 = nsn0; sn1 = nsn1;
        }
    }
};
struct EpiSV {
    static constexpr bool PERM = true, AFTER_DRAIN = false;
    bf16_t* qkv; bf16_t* qkv2;
    __device__ __forceinline__ void operator()(const pg8::f32x4 (&acc)[2][2][4][2], const pg8::Unit& u, int wr, int wc, int fr, int fq) const {
        const bool dil = (u.pn >> 3) != 0; const int T = dil ? 5 : 2;
        const int hh0 = 2 * (u.pn & 7), d0 = wc * 32 + 8 * fq, rowb = u.pm * 256 + wr * 64 + fr;
        bf16_t* base = qkv + (size_t)T * QKV_T + d0;
#pragma unroll
        for (int gi = 0; gi < 8; ++gi) { const int ai = gi >> 2, m = gi & 3, row = rowb + ai * 128 + m * 16;
#pragma unroll
            for (int bj = 0; bj < 2; ++bj) {
                const f32x4 v0 = acc[ai][bj][m][0] * (1.0f / 16384.0f), v1 = acc[ai][bj][m][1] * (1.0f / 16384.0f);
                u32x4 w; w.x = cvt_pk(v0[0], v0[1]); w.y = cvt_pk(v0[2], v0[3]); w.z = cvt_pk(v1[0], v1[1]); w.w = cvt_pk(v1[2], v1[3]);
                *(u32x4*)(base + ((size_t)(hh0 + bj) * S + row) * 128) = w;
            } }
    }
};
struct EpiResid {
    static constexpr bool PERM = true, AFTER_DRAIN = false;
    const float* x; const float* gate; bf16_t* out;
    __device__ __forceinline__ void operator()(const pg8::f32x4 (&acc)[2][2][4][2], const pg8::Unit& u, int wr, int wc, int fr, int fq) const {
        const int row0 = u.pm * 256 + wr * 64 + fr, col0 = u.pn * 256 + wc * 32 + 8 * fq;
        f32x4 gv[2][2];
#pragma unroll
        for (int bj = 0; bj < 2; ++bj)
#pragma unroll
            for (int n = 0; n < 2; ++n) gv[bj][n] = *(const f32x4*)(gate + col0 + bj * 128 + n * 4) * (1.0f / 16384.0f);
        f32x4 xq[2][2][2];
#define ER_LOAD(slot, gi_) do { const size_t o_ = (size_t)(row0 + ((gi_) >> 2) * 128 + ((gi_) & 3) * 16) * DM + col0; \
            _Pragma("unroll") for (int bj = 0; bj < 2; ++bj) { xq[slot][bj][0] = *(const f32x4*)(x + o_ + bj * 128); xq[slot][bj][1] = *(const f32x4*)(x + o_ + bj * 128 + 4); } } while (0)
        ER_LOAD(0, 0); ER_LOAD(1, 1);
#pragma unroll
        for (int gi = 0; gi < 8; ++gi) { const int ai = gi >> 2, m = gi & 3;
            const size_t off = (size_t)(row0 + ai * 128 + m * 16) * DM + col0;
            f32x4 xc[2][2];
#pragma unroll
            for (int bj = 0; bj < 2; ++bj) { xc[bj][0] = xq[gi % 2][bj][0]; xc[bj][1] = xq[gi % 2][bj][1]; }
            if (gi + 2 < 8) ER_LOAD(gi % 2, gi + 2);
#pragma unroll
            for (int bj = 0; bj < 2; ++bj) {
#ifdef DBG_NO_MIXER
                const f32x4 r0 = xc[bj][0], r1 = xc[bj][1];
#else
                const f32x4 r0 = xc[bj][0] + gv[bj][0] * acc[ai][bj][m][0], r1 = xc[bj][1] + gv[bj][1] * acc[ai][bj][m][1];
#endif
                u32x4 w; w.x = cvt_pk(r0[0], r0[1]); w.y = cvt_pk(r0[2], r0[3]); w.z = cvt_pk(r1[0], r1[1]); w.w = cvt_pk(r1[2], r1[3]);
                *(u32x4*)(out + off + bj * 128) = w;
            }
            __builtin_amdgcn_sched_barrier(0);
        }
#undef ER_LOAD
    }
};

struct AttIt { int kind, L, pass; };
__device__ __forceinline__ at::BlockRef att_ref(const AttIt& it, unsigned char* ws, bool remap) {
    const bf16_t* qkv = (const bf16_t*)(ws + WS_QKV);
    at::BlockRef r;
    if (it.kind == 0) {
        const int b_ = it.L & 255, L_ = remap ? ((((it.L >> 8) * 16 + 2 * (b_ & 7) + (b_ >> 7)) << 4) + ((b_ >> 3) & 15)) : it.L;
        const int vp = L_ >> 4, x = L_ & 15, qb = it.pass ? x : 31 - x;
        const int h = vp >> 2, s = (vp >> 1) & 1, hf = vp & 1;
        const size_t hq = (size_t)(2 * h + s) * S * 128, hv = (size_t)(2 * h + hf) * S * 128;
        r.Q = qkv + 0 * QKV_T + hq + (size_t)qb * 256 * 128; r.K = qkv + 1 * QKV_T + hq; r.V = qkv + 2 * QKV_T + hv;
        r.O = (bf16_t*)(ws + WS_OD) + ((size_t)vp * S + (size_t)qb * 256) * 128; r.L = nullptr;
        r.P0 = qb * 256; r.W = S; r.skv = S; r.rs = 128;
    } else {
        const int b_ = it.L & 255, j_ = it.L >> 8;
        const int g = remap ? (j_ % 3) : (it.L >> 9), h = remap ? (2 * (b_ & 7) + (j_ >= 3 ? 1 : 0)) : ((it.L & 511) >> 5), blk = remap ? (((b_ >> 3) + ((0x524011 >> (4 * j_)) & 15)) & 31) : (it.L & 31);
        const int dil = (g == 0) ? 1 : (g == 1 ? 4 : 16), bpr = 32 / dil, res = blk / bpr, qb = blk % bpr;
        const bf16_t* tb = qkv + 3 * QKV_T;
        const size_t hb = ((size_t)h * S + (size_t)res * (S / dil)) * 128, hn = ((size_t)h * S + (size_t)res) * 128;
        r.skv = S / dil; r.P0 = qb * 256; r.W = 129; r.rs = 128 * dil;
        r.Q = tb + 0 * QKV_T + hn + (size_t)qb * 256 * 128 * dil; r.K = tb + 1 * QKV_T + hn; r.V = tb + 2 * QKV_T + hn;
        r.O = (bf16_t*)(ws + WS_OS) + ((size_t)(g * 16 + h) * S + (size_t)res * (S / dil) + (size_t)qb * 256) * 128;
        r.L = (float*)(ws + WS_LSE) + (size_t)(g * 16 + h) * S + (size_t)res * (S / dil) + (size_t)qb * 256;
    }
    return r;
}
__device__ __forceinline__ AttIt att_next(const AttIt& it, int G, int bid) {
    AttIt n = it;
    if (it.kind == 0) {
        if (it.pass == 0) { n.pass = 1; return n; }
        n.pass = 0; n.L = it.L + G;
        if (n.L < 512) return n;
        n.kind = 1; n.L = bid; if (n.L >= 1536) n.kind = 2;
        return n;
    }
    n.L = it.L + G; if (n.L >= 1536) n.kind = 2;
    return n;
}
__device__ __forceinline__ void attn_phase(const Args& A, char* lds, int G, int bid) {
    AttIt it; it.kind = 0; it.L = bid; it.pass = 0;
    if (it.L >= 512) { it.kind = 1; it.L = bid; if (it.L >= 1536) it.kind = 2; }
    const bool remap = (G == 256);
    at::Svc sv; sv.tu = A.peer_u; sv.tv = A.peer_v; sv.du = A.ws + WS_UB; sv.dv = A.ws + WS_VB; sv.next = 0; sv.p_old = -1; sv.p_new = -1; sv.par = 0; sv.G = G; sv.bid = bid;
    if (it.kind != 2) {
        at::BlockRef cur = att_ref(it, A.ws, remap);
        at::Seam Sm;
        at::causal_swa_prime(cur, lds, Sm);
        while (it.kind != 2) {
            const AttIt itn = att_next(it, G, bid);
            const at::BlockRef nxt = (itn.kind == 2) ? cur : att_ref(itn, A.ws, remap);
            at::causal_swa_block<false>(cur, nxt, lds, Sm, sv);
            cur = nxt; it = itn;
        }
    }
    while (at::svc_busy(sv)) { asm volatile("s_waitcnt vmcnt(0)" ::: "memory"); at::svc_top(sv, lds); at::svc_dma(sv, lds); }
    asm volatile("s_waitcnt vmcnt(0)" ::: "memory");
}

__device__ __forceinline__ void ld16bf(const bf16_t* p, f32x4 (&o)[4]) { const u32x4 a = *(const u32x4*)p, b = *(const u32x4*)(p + 8);
    o[0] = (f32x4){bf_lo(a.x), bf_hi(a.x), bf_lo(a.y), bf_hi(a.y)}; o[1] = (f32x4){bf_lo(a.z), bf_hi(a.z), bf_lo(a.w), bf_hi(a.w)};
    o[2] = (f32x4){bf_lo(b.x), bf_hi(b.x), bf_lo(b.y), bf_hi(b.y)}; o[3] = (f32x4){bf_lo(b.z), bf_hi(b.z), bf_lo(b.w), bf_hi(b.w)}; }
__device__ __forceinline__ float sq16(const f32x4 (&v)[4]) { float s = 0.f;
#pragma unroll
    for (int i = 0; i < 4; ++i) s += (v[i].x * v[i].x + v[i].y * v[i].y) + (v[i].z * v[i].z + v[i].w * v[i].w);
    return s; }
__device__ __forceinline__ void combine_phase(const Args& A, int gw, int ngw, int lane) {
    unsigned char* ws = A.ws;
    const float lam = *(const float*)(ws + WS_LAM);
    const bf16_t* OD = (const bf16_t*)(ws + WS_OD); const bf16_t* OS = (const bf16_t*)(ws + WS_OS); const float* LSE = (const float*)(ws + WS_LSE);
    unsigned char* Y = (unsigned char*)(ws + WS_Y);
    for (int t = gw; t < S; t += ngw) {
#pragma unroll
        for (int hq = 0; hq < 2; ++hq) {
            const int h = 4 * hq + (lane >> 4), e0 = 16 * (lane & 15), hf = e0 >> 7, d0 = e0 & 127;
            f32x4 a[4], b[4], v[4];
            ld16bf(OD + ((size_t)(h * 4 + 0 + hf) * S + t) * 128 + d0, a); ld16bf(OD + ((size_t)(h * 4 + 2 + hf) * S + t) * 128 + d0, b);
#pragma unroll
            for (int i = 0; i < 4; ++i) v[i] = a[i] - lam * b[i];
            float ss = sq16(v);
            ss += __shfl_xor(ss, 1); ss += __shfl_xor(ss, 2); ss += __shfl_xor(ss, 4); ss += __shfl_xor(ss, 8);
            const float rstd = 16.0f * (1.0f - LAM_INIT) / sqrtf(ss * (1.0f / 256.0f) + NORM_EPS);
            u32x4 w;
            w.x = pk_fp8(v[0] * rstd * *(const f32x4*)(A.diff_subln_g + e0)); w.y = pk_fp8(v[1] * rstd * *(const f32x4*)(A.diff_subln_g + e0 + 4));
            w.z = pk_fp8(v[2] * rstd * *(const f32x4*)(A.diff_subln_g + e0 + 8)); w.w = pk_fp8(v[3] * rstd * *(const f32x4*)(A.diff_subln_g + e0 + 12));
            *(u32x4*)(Y + (size_t)t * DM + h * 256 + e0) = w;
        }
        const int r1 = (t & 3) * (S / 4) + (t >> 2), r2 = (t & 15) * (S / 16) + (t >> 4);
#pragma unroll
        for (int hq = 0; hq < 2; ++hq) {
            const int h = 8 * hq + (lane >> 3), d0 = 16 * (lane & 7);
            const float l0 = LSE[(size_t)(0 * 16 + h) * S + t], l1 = LSE[(size_t)(1 * 16 + h) * S + r1], l2 = LSE[(size_t)(2 * 16 + h) * S + r2];
            const float mx = fmaxf(l0, fmaxf(l1, l2));
            const float e0 = __expf(l0 - mx), e1 = __expf(l1 - mx), e2 = __expf(l2 - mx), inv = 1.0f / (e0 + e1 + e2);
            f32x4 o0[4], o1[4], o2[4], v[4];
            ld16bf(OS + ((size_t)(0 * 16 + h) * S + t) * 128 + d0, o0); ld16bf(OS + ((size_t)(1 * 16 + h) * S + r1) * 128 + d0, o1); ld16bf(OS + ((size_t)(2 * 16 + h) * S + r2) * 128 + d0, o2);
#pragma unroll
            for (int i = 0; i < 4; ++i) v[i] = (e0 * inv) * o0[i] + (e1 * inv) * o1[i] + (e2 * inv) * o2[i];
            float ss = sq16(v);
            ss += __shfl_xor(ss, 1); ss += __shfl_xor(ss, 2); ss += __shfl_xor(ss, 4);
            const float rstd = 16.0f / sqrtf(ss * (1.0f / 128.0f) + NORM_EPS);
            const float* gp = A.dil_out_g + h * 128 + d0;
            u32x4 w;
            w.x = pk_fp8(v[0] * rstd * *(const f32x4*)gp); w.y = pk_fp8(v[1] * rstd * *(const f32x4*)(gp + 4));
            w.z = pk_fp8(v[2] * rstd * *(const f32x4*)(gp + 8)); w.w = pk_fp8(v[3] * rstd * *(const f32x4*)(gp + 12));
            *(u32x4*)(Y + (size_t)t * DM + 2048 + h * 128 + d0) = w;
        }
    }
}

__device__ __forceinline__ unsigned fkey(float f) { const unsigned b = __float_as_uint(f); return b ^ ((b >> 31) ? 0xFFFFFFFFu : 0x80000000u); }
__device__ __forceinline__ int mbcnt64(unsigned long long m) { return (int)__builtin_amdgcn_mbcnt_hi((unsigned)(m >> 32), __builtin_amdgcn_mbcnt_lo((unsigned)m, 0u)); }
template <int NR> __device__ __forceinline__ unsigned kth16_key(const unsigned (&key)[NR]) {
    unsigned T = 0u;
    for (int bit = 31; bit >= 0; --bit) {
        const unsigned cand = T | (1u << bit); int cnt = 0;
#pragma unroll
        for (int r = 0; r < NR; ++r) cnt += __builtin_popcountll(__ballot(key[r] >= cand));
        if (cnt >= 16) T = cand;
    }
    return T;
}
template <int NR> __device__ __forceinline__ void select16(const unsigned (&key)[NR], bool (&sel)[NR], int (&pos)[NR]) {
    const unsigned T = kth16_key<NR>(key);
    int cgt = 0;
#pragma unroll
    for (int r = 0; r < NR; ++r) cgt += __builtin_popcountll(__ballot(key[r] > T));
    const int need = 16 - cgt; int eqb = 0, selb = 0;
#pragma unroll
    for (int r = 0; r < NR; ++r) {
        const bool gt = key[r] > T, eq = key[r] == T;
        const unsigned long long beq = __ballot(eq);
        const bool s = gt || (eq && (eqb + mbcnt64(beq)) < need);
        const unsigned long long bs = __ballot(s);
        sel[r] = s; pos[r] = selb + mbcnt64(bs);
        selb += __builtin_popcountll(bs); eqb += __builtin_popcountll(beq);
    }
}
__device__ __forceinline__ float funkey(unsigned k) { return __uint_as_float((k & 0x80000000u) ? (k ^ 0x80000000u) : ~k); }
__device__ __forceinline__ void ins16(unsigned (&L)[16], unsigned x) {
#pragma unroll
    for (int i = 0; i < 16; ++i) { const unsigned hi = L[i] > x ? L[i] : x, lo = L[i] > x ? x : L[i]; L[i] = hi; x = lo; }
}
__device__ __forceinline__ void topk_phase(const Args& A, LAS unsigned char* lds, int gw, int ngw, int wave, int lane, int nwb = S * 16 / 64) {
    unsigned char* ws = A.ws;
    const float* SC = (const float*)(ws + WS_SC); int* IDX = (int*)(ws + WS_IDX); float* GATE = (float*)(ws + WS_GATE);
    LAS float* scr = (LAS float*)(lds + wave * 8448);
    LAS int* tab = (LAS int*)scr;
    for (int wb = gw; wb < nwb; wb += ngw) {
        const float* base = SC + (size_t)wb * 64 * 128;
        unsigned L[16];
#pragma unroll
        for (int i = 0; i < 16; ++i) L[i] = 0u;
        f32x4 ld[8], ln[8];
        const int lr = lane >> 3, lc = lane & 7;
#pragma unroll
        for (int i = 0; i < 8; ++i) ld[i] = *(const f32x4*)(base + (size_t)(8 * i + lr) * 128 + 4 * lc);
#pragma unroll
        for (int c = 0; c < 4; ++c) {
            if (c < 3) {
#pragma unroll
                for (int i = 0; i < 8; ++i) ln[i] = *(const f32x4*)(base + (size_t)(8 * i + lr) * 128 + 32 * (c + 1) + 4 * lc);
            }
#pragma unroll
            for (int i = 0; i < 8; ++i) { LAS float* d = scr + (8 * i + lr) * 33 + 4 * lc; d[0] = ld[i].x; d[1] = ld[i].y; d[2] = ld[i].z; d[3] = ld[i].w; }
            LDS_WAIT(); __builtin_amdgcn_wave_barrier();
#pragma unroll
            for (int j = 0; j < 32; ++j) { const float v = scr[lane * 33 + j]; ins16(L, (fkey(v) & ~127u) | (unsigned)(127 - (32 * c + j))); }
            LDS_WAIT(); __builtin_amdgcn_wave_barrier();
#pragma unroll
            for (int i = 0; i < 8; ++i) ld[i] = ln[i];
        }
        unsigned M[16];
#pragma unroll
        for (int i = 0; i < 16; ++i) M[i] = (unsigned)__shfl_down((int)L[i], 1);
        float av[16], bv[16];
#pragma unroll
        for (int i = 0; i < 16; ++i) { av[i] = funkey((L[i] & ~127u) | 64u); bv[i] = funkey((M[i] & ~127u) | 64u);
            tab[lane * 33 + i] = 127 - (int)(L[i] & 127u); tab[lane * 33 + 16 + i] = 127 - (int)(M[i] & 127u); }
        unsigned K2[16];
#pragma unroll
        for (int i = 0; i < 16; ++i) K2[i] = 0u;
#pragma unroll
        for (int i = 0; i < 16; ++i)
#pragma unroll
            for (int j = 0; j < 16; ++j)
                if ((i + 1) * (j + 1) <= 16) ins16(K2, (fkey(av[i] + bv[j]) & ~255u) | (unsigned)(255 - (i * 16 + j)));
        LDS_WAIT(); __builtin_amdgcn_wave_barrier();
        float fv[16]; int fe[16]; float sm = 0.f;
        const float mx = funkey((K2[0] & ~255u) | 128u);
#pragma unroll
        for (int q = 0; q < 16; ++q) { const int cid = 255 - (int)(K2[q] & 255u);
            fe[q] = tab[lane * 33 + (cid >> 4)] * 128 + tab[lane * 33 + 16 + (cid & 15)];
            fv[q] = __expf(funkey((K2[q] & ~255u) | 128u) - mx); sm += fv[q]; }
        const float inv = 1.0f / sm;
        if ((lane & 1) == 0) {
            const size_t o = ((size_t)wb * 32 + (lane >> 1)) * 16;
#pragma unroll
            for (int q = 0; q < 4; ++q) {
                *(u32x4*)(IDX + o + 4 * q) = (u32x4){(unsigned)fe[4 * q], (unsigned)fe[4 * q + 1], (unsigned)fe[4 * q + 2], (unsigned)fe[4 * q + 3]};
                *(f32x4*)(GATE + o + 4 * q) = (f32x4){fv[4 * q] * inv, fv[4 * q + 1] * inv, fv[4 * q + 2] * inv, fv[4 * q + 3] * inv};
            }
        }
        LDS_WAIT(); __builtin_amdgcn_wave_barrier();
    }
}

__device__ __forceinline__ float gelu_erf(float x) { return 0.5f * x * (1.0f + erff(x * 0.70710678118654752f)); }
__device__ __forceinline__ f32x2 fp8lo(unsigned w) { return __builtin_amdgcn_cvt_pk_f32_fp8((int)w, false); }
__device__ __forceinline__ f32x2 fp8hi(unsigned w) { return __builtin_amdgcn_cvt_pk_f32_fp8((int)w, true); }
__device__ __forceinline__ float dot16_fp8(const u32x4 w, const f32x2 (&hp)[8]) {
    f32x2 t = fp8lo(w.x) * hp[0];
    t = __builtin_elementwise_fma(fp8hi(w.x), hp[1], t); t = __builtin_elementwise_fma(fp8lo(w.y), hp[2], t); t = __builtin_elementwise_fma(fp8hi(w.y), hp[3], t);
    t = __builtin_elementwise_fma(fp8lo(w.z), hp[4], t); t = __builtin_elementwise_fma(fp8hi(w.z), hp[5], t); t = __builtin_elementwise_fma(fp8lo(w.w), hp[6], t);
    t = __builtin_elementwise_fma(fp8hi(w.w), hp[7], t);
    return t.x + t.y;
}
__device__ __forceinline__ float d2cv(unsigned w, bool hi, unsigned hpair, float acc) {
    return __builtin_amdgcn_fdot2_f32_bf16(hi ? __builtin_amdgcn_cvt_scalef32_pk_bf16_fp8(w, 1.0f, true) : __builtin_amdgcn_cvt_scalef32_pk_bf16_fp8(w, 1.0f, false), __builtin_bit_cast(bf16v2, hpair), acc, false); }
__device__ __forceinline__ float dot16_fp8_bf(const u32x4 w, const u32x4 h0, const u32x4 h1, float acc) {
    acc = d2cv(w.x, false, h0.x, acc); acc = d2cv(w.x, true, h0.y, acc); acc = d2cv(w.y, false, h0.z, acc); acc = d2cv(w.y, true, h0.w, acc);
    acc = d2cv(w.z, false, h1.x, acc); acc = d2cv(w.z, true, h1.y, acc); acc = d2cv(w.w, false, h1.z, acc); return d2cv(w.w, true, h1.w, acc);
}
__device__ __forceinline__ void axpy16_fp8(const u32x4 w, const float a, f32x2 (&o)[8]) {
    const f32x2 av = {a, a};
    o[0] = __builtin_elementwise_fma(fp8lo(w.x), av, o[0]); o[1] = __builtin_elementwise_fma(fp8hi(w.x), av, o[1]);
    o[2] = __builtin_elementwise_fma(fp8lo(w.y), av, o[2]); o[3] = __builtin_elementwise_fma(fp8hi(w.y), av, o[3]);
    o[4] = __builtin_elementwise_fma(fp8lo(w.z), av, o[4]); o[5] = __builtin_elementwise_fma(fp8hi(w.z), av, o[5]);
    o[6] = __builtin_elementwise_fma(fp8lo(w.w), av, o[6]); o[7] = __builtin_elementwise_fma(fp8hi(w.w), av, o[7]);
}
__device__ __forceinline__ void peer_phase(const Args& A, LAS unsigned char* lds, int G, int bid, int tid) {
    unsigned char* ws = A.ws;
    const bf16_t* H2 = (const bf16_t*)(ws + WS_H2);
    const int* IDX = (const int*)(ws + WS_IDX); const float* GATE = (const float*)(ws + WS_GATE);
    bf16_t* X1 = (bf16_t*)(ws + WS_X1); const float* g2 = (const float*)(ws + WS_MOD) + 5 * DM;
    const int grp = tid >> 3, sub = tid & 7, tok = grp >> 1, eh = grp & 1;
    const int srot = 4 * (int)(xb_xcc_id() & 7u);
    const unsigned so = (unsigned)sub * 16u;
    LAS int* lidx = (LAS int*)lds; LAS float* lact = (LAS float*)(lds + 16384); LAS float* lrs = (LAS float*)(lds + 32768);
    const LAS int* myidx = lidx + tok * 128 + eh * 64; const LAS float* myact = lact + tok * 128 + eh * 64;
    for (int tt = bid; tt < S / 32; tt += G) {
        const int t0 = tt * 32;
        topk_phase(A, lds + 40960, tt * 8 + (tid >> 6), 1 << 30, tid >> 6, tid & 63, tt * 8 + (tid >> 6) + 1);
        asm volatile("s_waitcnt vmcnt(0)" ::: "memory"); __syncthreads();
        for (int i = tid; i < 1024; i += 512) ((LAS u32x4*)lidx)[i] = ((const u32x4*)(IDX + (size_t)t0 * 128))[i];
        __syncthreads();
        float acc[64];
#pragma unroll
        for (int j = 0; j < 64; ++j) acc[j] = 0.f;
        for (int si = 0; si < 32; ++si) {
            const int s = (si + srot) & 31;
            const u32x4 h0 = *(const u32x4*)(H2 + (size_t)(t0 + tok) * DM + s * 128 + sub * 16), h1 = *(const u32x4*)(H2 + (size_t)(t0 + tok) * DM + s * 128 + sub * 16 + 8);
            const char* ub = (const char*)(ws + WS_UB) + (size_t)s * ((size_t)NEXP * 128);
#pragma unroll
            for (int eb = 0; eb < 64; eb += 16) {
                u32x4 id4[4];
#pragma unroll
                for (int k = 0; k < 4; ++k) id4[k] = *(const LAS u32x4*)(myidx + eb + 4 * k);
                u32x4 uv[16];
#pragma unroll
                for (int k = 0; k < 4; ++k) { uv[4 * k + 0] = *(const u32x4*)(ub + (id4[k].x * 128u + so)); uv[4 * k + 1] = *(const u32x4*)(ub + (id4[k].y * 128u + so));
                                              uv[4 * k + 2] = *(const u32x4*)(ub + (id4[k].z * 128u + so)); uv[4 * k + 3] = *(const u32x4*)(ub + (id4[k].w * 128u + so)); }
#pragma unroll
                for (int i = 0; i < 16; ++i) acc[eb + i] = dot16_fp8_bf(uv[i], h0, h1, acc[eb + i]);
                asm volatile("" ::: "memory");
            }
        }
        {
            float g8[8];
#pragma unroll
            for (int k = 0; k < 8; ++k) g8[k] = GATE[(size_t)(t0 + tok) * 128 + eh * 64 + 8 * k + sub];
            const bool b4 = (sub & 4) != 0, b2 = (sub & 2) != 0, b1 = (sub & 1) != 0;
            float a32[32], a16[16], a8[8];
#pragma unroll
            for (int p = 0; p < 32; ++p) { const int jl = (p >> 2) * 8 + (p & 3), jh = jl + 4;
                float x0 = acc[jl], x1 = acc[jh]; asm volatile("" : "+v"(x0), "+v"(x1));
                const float keep = b4 ? x1 : x0, send = b4 ? x0 : x1; a32[p] = keep + __shfl_xor(send, 4); }
#pragma unroll
            for (int p = 0; p < 16; ++p) { const int il = (p >> 1) * 4 + (p & 1), ih = il + 2;
                float x0 = a32[il], x1 = a32[ih]; asm volatile("" : "+v"(x0), "+v"(x1));
                const float keep = b2 ? x1 : x0, send = b2 ? x0 : x1; a16[p] = keep + __shfl_xor(send, 2); }
#pragma unroll
            for (int k = 0; k < 8; ++k) { float x0 = a16[2 * k], x1 = a16[2 * k + 1]; asm volatile("" : "+v"(x0), "+v"(x1));
                const float keep = b1 ? x1 : x0, send = b1 ? x0 : x1; a8[k] = keep + __shfl_xor(send, 1); }
#pragma unroll
            for (int k = 0; k < 8; ++k) lact[tok * 128 + eh * 64 + 8 * k + sub] = g8[k] * gelu_erf(a8[k] * (1.0f / 256.0f));
        }
        __syncthreads();
        float ssq = 0.f;
        for (int si = 0; si < 32; ++si) {
            const int s = (si + srot) & 31;
            const char* vb = (const char*)(ws + WS_VB) + (size_t)s * ((size_t)NEXP * 128);
            f32x2 o[8];
#pragma unroll
            for (int i = 0; i < 8; ++i) o[i] = (f32x2){0.f, 0.f};
#pragma unroll
            for (int eb = 0; eb < 64; eb += 16) {
                u32x4 id4[4]; f32x4 a4[4];
#pragma unroll
                for (int k = 0; k < 4; ++k) { id4[k] = *(const LAS u32x4*)(myidx + eb + 4 * k); a4[k] = *(const LAS f32x4*)(myact + eb + 4 * k); }
                u32x4 vv[16];
#pragma unroll
                for (int k = 0; k < 4; ++k) { vv[4 * k + 0] = *(const u32x4*)(vb + (id4[k].x * 128u + so)); vv[4 * k + 1] = *(const u32x4*)(vb + (id4[k].y * 128u + so));
                                              vv[4 * k + 2] = *(const u32x4*)(vb + (id4[k].z * 128u + so)); vv[4 * k + 3] = *(const u32x4*)(vb + (id4[k].w * 128u + so)); }
#pragma unroll
                for (int k = 0; k < 4; ++k) { axpy16_fp8(vv[4 * k + 0], a4[k].x, o); axpy16_fp8(vv[4 * k + 1], a4[k].y, o); axpy16_fp8(vv[4 * k + 2], a4[k].z, o); axpy16_fp8(vv[4 * k + 3], a4[k].w, o); }
                asm volatile("" ::: "memory");
            }
#pragma unroll
            for (int i = 0; i < 8; ++i) { o[i].x += __shfl_xor(o[i].x, 8); o[i].y += __shfl_xor(o[i].y, 8); }
            if (eh == 0) {
                const size_t off = (size_t)(t0 + tok) * DM + s * 128 + sub * 16;
#pragma unroll
                for (int q = 0; q < 4; ++q) {
                    const f32x4 xv = ld4bf(X1 + off + 4 * q); const f32x4 gv = *(const f32x4*)(g2 + s * 128 + sub * 16 + 4 * q) * (1.0f / 16.0f);
                    f32x4 r; r.x = xv.x + gv.x * o[2 * q].x; r.y = xv.y + gv.y * o[2 * q].y; r.z = xv.z + gv.z * o[2 * q + 1].x; r.w = xv.w + gv.w * o[2 * q + 1].y;
                    ssq += (r.x * r.x + r.y * r.y) + (r.z * r.z + r.w * r.w);
                    u32x2 w; w.x = cvt_pk(r.x, r.y); w.y = cvt_pk(r.z, r.w); *(u32x2*)(X1 + off + 4 * q) = w;
                }
            }
        }
        ssq += __shfl_xor(ssq, 1); ssq += __shfl_xor(ssq, 2); ssq += __shfl_xor(ssq, 4);
        if (eh == 0 && sub == 0) lrs[tok] = 1.0f / sqrtf(ssq * (1.0f / DM) + NORM_EPS);
        __syncthreads();
        for (int i0 = tid; i0 < 32 * 1024; i0 += 512 * 8) {
            u32x2 pv[8];
#pragma unroll
            for (int k = 0; k < 8; ++k) { const int i = i0 + 512 * k, tn = i >> 10, c4 = i & 1023; pv[k] = *((const u32x2*)(X1 + (size_t)(t0 + tn) * DM) + c4); }
#pragma unroll
            for (int k = 0; k < 8; ++k) { const int i = i0 + 512 * k, tn = i >> 10, c4 = i & 1023;
                const f32x4 xv = (f32x4){bf_lo(pv[k].x), bf_hi(pv[k].x), bf_lo(pv[k].y), bf_hi(pv[k].y)};
                *((f32x4*)(A.out + (size_t)(t0 + tn) * DM) + c4) = xv * lrs[tn] * ((const f32x4*)A.final_g)[c4]; }
        }
        __syncthreads();
    }
}

#ifdef DBG_CHECK
__device__ __forceinline__ void dbg_flag(unsigned char* ws, int bit) { atomicOr((unsigned*)(ws + WS_CTL + 65536), 1u << bit); }
__device__ __forceinline__ void dbg_phase(const Args& A, LAS unsigned char* lds, int bid, int tid) {
    unsigned char* ws = A.ws;
    const int lane = tid & 63, wave = __builtin_amdgcn_readfirstlane(tid >> 6);
    const bf16_t* H2 = (const bf16_t*)(ws + WS_H2); const float* SC = (const float*)(ws + WS_SC);
    const int* IDX = (const int*)(ws + WS_IDX); const float* GATE = (const float*)(ws + WS_GATE);
    const float* X1 = (const float*)(ws + WS_X1); const float* mod = (const float*)(ws + WS_MOD);
    if (wave != 0) return;
    if (bid < 4) {
        const int t = bid == 0 ? 5 : (bid == 1 ? 1234 : (bid == 2 ? 4097 : 8191)), g = (3 * bid + 5) & 15;
        LAS float* q = (LAS float*)lds;
        float q0 = 0.f, q1 = 0.f;
        for (int d = 0; d < DM; ++d) { const float hv = __uint_as_float(((unsigned)H2[(size_t)t * DM + d]) << 16);
            q0 += hv * A.peer_wq[(size_t)d * 2048 + g * 128 + lane]; q1 += hv * A.peer_wq[(size_t)d * 2048 + g * 128 + 64 + lane]; }
        q[lane] = q0; q[lane + 64] = q1; LDS_WAIT(); __builtin_amdgcn_wave_barrier();
        bool bad = false;
        for (int r = 0; r < 2; ++r) { const int n = lane + 64 * r; float s = 0.f;
            for (int k = 0; k < 128; ++k) s += q[k] * A.peer_subkeys[(size_t)g * 16384 + n * 128 + k];
            const float got = SC[(size_t)t * 2048 + g * 128 + n];
            if (!(fabsf(got - s) <= 0.03f * fabsf(s) + 0.03f)) bad = true; }
        if (__any(bad) && lane == 0) dbg_flag(ws, 0);
    } else if (bid < 8) {
        const int b = bid - 4, t = b == 0 ? 5 : (b == 1 ? 1234 : (b == 2 ? 4097 : 8191)), h = (2 * b + 1) & 7;
        LAS float* sv = (LAS float*)lds;
        LAS int* si = (LAS int*)(lds + 2048);
        LAS float* fv = (LAS float*)(lds + 4096);
        for (int i = lane; i < 256; i += 64) sv[i] = SC[(size_t)t * 2048 + h * 256 + i];
        LDS_WAIT(); __builtin_amdgcn_wave_barrier();
        if (lane == 0) {
            for (int p = 0; p < 2; ++p) for (int k = 0; k < 16; ++k) { float best = -3e38f; int bi = 0;
                for (int n = 0; n < 128; ++n) { const float x = sv[p * 128 + n]; if (x > best) { best = x; bi = n; } }
                sv[256 + p * 16 + k] = best; si[p * 16 + k] = bi; sv[p * 128 + bi] = -3e38f; }
            for (int a = 0; a < 16; ++a) for (int c = 0; c < 16; ++c) fv[16 + a * 16 + c] = sv[256 + a] + sv[272 + c];
            float mx = -3e38f;
            for (int k = 0; k < 16; ++k) { float best = -3e38f; int bi = 0;
                for (int c = 0; c < 256; ++c) { const float x = fv[16 + c]; if (x > best) { best = x; bi = c; } }
                fv[k] = best; si[32 + k] = si[bi >> 4] * 128 + si[16 + (bi & 15)]; fv[16 + bi] = -3e38f; if (best > mx) mx = best; }
            float sm = 0.f; for (int k = 0; k < 16; ++k) sm += __expf(fv[k] - mx);
            bool bad = false;
            for (int k = 0; k < 16; ++k) { const float gk = __expf(fv[k] - mx) / sm; bool found = false;
                for (int j = 0; j < 16; ++j) if (IDX[(size_t)t * 128 + h * 16 + j] == si[32 + k]) { found = true; if (fabsf(GATE[(size_t)t * 128 + h * 16 + j] - gk) > 2e-3f) bad = true; }
                if (!found && gk > 0.02f) bad = true; }
            if (bad) dbg_flag(ws, 1);
        }
    } else if (bid < 12) {
        const int b = bid - 8, t = b == 0 ? 5 : (b == 1 ? 1234 : (b == 2 ? 4097 : 8191));
        LAS float* av = (LAS float*)lds;
        for (int j = 0; j < 128; ++j) { const int e = IDX[(size_t)t * 128 + j]; float s = 0.f;
            for (int d = lane; d < DM; d += 64) s += __uint_as_float(((unsigned)H2[(size_t)t * DM + d]) << 16) * A.peer_u[(size_t)e * DM + d];
            s = wave_sum(s); if (lane == 0) av[j] = GATE[(size_t)t * 128 + j] * gelu_erf(s); }
        LDS_WAIT(); __builtin_amdgcn_wave_barrier();
        float ss = 0.f;
        for (int d = lane; d < DM; d += 64) { float o = 0.f;
            for (int j = 0; j < 128; ++j) o += av[j] * A.peer_v[(size_t)IDX[(size_t)t * 128 + j] * DM + d];
            const float x2 = X1[(size_t)t * DM + d] + mod[5 * DM + d] * o; ss += x2 * x2; }
        ss = wave_sum(ss); const float rstd = 1.0f / sqrtf(ss / DM + NORM_EPS);
        bool bad = false;
        for (int d = lane; d < DM; d += 64) { float o = 0.f;
            for (int j = 0; j < 128; ++j) o += av[j] * A.peer_v[(size_t)IDX[(size_t)t * 128 + j] * DM + d];
            const float ref = (X1[(size_t)t * DM + d] + mod[5 * DM + d] * o) * rstd * A.final_g[d];
            if (!(fabsf(A.out[(size_t)t * DM + d] - ref) <= 0.02f * fabsf(ref) + 0.02f)) bad = true; }
        if (__any(bad) && lane == 0) dbg_flag(ws, 2);
    } else if (bid < 16) {
        const int b = bid - 12, t = b == 0 ? 5 : (b == 1 ? 1234 : (b == 2 ? 4097 : 8191));
        float ss = 0.f; for (int d = lane; d < DM; d += 64) { const float x = X1[(size_t)t * DM + d]; ss += x * x; }
        ss = wave_sum(ss); const float rstd = 1.0f / sqrtf(ss / DM + NORM_EPS); bool bad = false;
        for (int d = lane; d < DM; d += 64) { const float ref = X1[(size_t)t * DM + d] * rstd * A.norm2_g[d] * (1.0f + mod[4 * DM + d]) + mod[3 * DM + d];
            const float got = __uint_as_float(((unsigned)H2[(size_t)t * DM + d]) << 16);
            if (!(fabsf(got - ref) <= 0.01f * fabsf(ref) + 0.01f)) bad = true; }
        if (__any(bad) && lane == 0) dbg_flag(ws, 3);
    } else if (bid < 20) {
        const int b = bid - 16; bool bad = false;
        for (int r = 0; r < 6; ++r) { const int n = r * DM + 37 * lane + 500 * b; float s = 0.f;
            for (int k = 0; k < DM; ++k) { const float cv = A.c[k]; s += cv / (1.0f + __expf(-cv)) * A.w_ada[(size_t)k * NADA + n]; }
            s += A.b_ada[n]; if (!(fabsf(mod[n] - s) <= 1e-3f * fabsf(s) + 1e-3f)) bad = true; }
        if (__any(bad) && lane == 0) dbg_flag(ws, 4);
    } else if (bid < 24) {
        const int b = bid - 20, g = (5 * b + 2) & 15, n = 17 * b + 3; bool bad = false;
        const bf16_t* wsc = (const bf16_t*)(ws + WS_WSC);
        for (int d = lane; d < DM; d += 64) { float s = 0.f;
            for (int k = 0; k < 128; ++k) s += A.peer_subkeys[(size_t)g * 16384 + n * 128 + k] * A.peer_wq[(size_t)d * 2048 + g * 128 + k];
            const float got = __uint_as_float(((unsigned)wsc[(size_t)(g * 128 + n) * DM + d]) << 16);
            if (!(fabsf(got - s) <= 0.01f * fabsf(s) + 2e-4f)) bad = true; }
        if (__any(bad) && lane == 0) dbg_flag(ws, 5);
    }
}
__device__ __forceinline__ void dbg_emit(const Args& A, int bid, int tid, int G) {
    const unsigned mask = *(const unsigned*)(A.ws + WS_CTL + 65536);
    const float cval = sqrtf((float)mask + 1.0f);
    for (size_t i = (size_t)bid * 512 + tid; i < (size_t)S * DM; i += (size_t)G * 512) A.out[i] = cval;
}
#endif
__global__ void __launch_bounds__(512, 2) hymba_fwd(Args A) {
    extern __shared__ __attribute__((aligned(16))) unsigned char lds_raw[];
    LAS unsigned char* lds = (LAS unsigned char*)lds_raw;
    const int tid = threadIdx.x, lane = tid & 63, wave = __builtin_amdgcn_readfirstlane(tid >> 6);
    const int G = gridDim.x, bid = blockIdx.x;
    const int gw = bid * 8 + wave, ngw = G * 8;
    unsigned char* ws = A.ws;
    for (int u = tid; u < (LDS_BYTES - RING_BYTES) / 4; u += 512) ((LAS unsigned*)(lds + RING_BYTES))[u] = 0u;
    __syncthreads();
    XcdBarrier bar; bar.bar = (unsigned*)(ws + WS_CTL) + CW_BAR; bar.x = 0; bar.st = nullptr;
    if (MK_N_LAUNCHES == 1) bar = xcd_barrier_post((unsigned*)(ws + WS_CTL) + CW_BAR, (volatile LAS unsigned*)(lds + MISC_OFF + 32));
    const int lo = A.ph_lo, hi = A.ph_hi;
#ifndef PH_MASK
#define PH_MASK 0xfff
#endif
#define IN(k) (((PH_MASK >> (k)) & 1) && lo <= (k) && (k) < hi)
#define REP(k) (((REP_MASK >> (k)) & 1) ? 2 : 1)
#ifdef DBG_TIME
#define SEAM(k) do { if (IN(k) && IN((k) + 1)) xcd_barrier(bar); if (bid == 0 && tid == 0) ((unsigned long long*)(ws + WS_CTL + 32768))[(k) + 1] = __builtin_amdgcn_s_memrealtime(); } while (0)
#else
#define SEAM(k) do { if (IN(k) && IN((k) + 1)) xcd_barrier(bar); } while (0)
#endif
    float* mod = (float*)(ws + WS_MOD);
#ifdef DBG_TIME
    if (bid == 0 && tid == 0) ((unsigned long long*)(ws + WS_CTL + 32768))[0] = __builtin_amdgcn_s_memrealtime();
#endif

    if (IN(0)) for (int rep_ = 0; rep_ < REP(0); ++rep_) { p0_prologue(A, lds, G, bid, tid); }
    SEAM(0);
    if (IN(1)) for (int rep_ = 0; rep_ < REP(1); ++rep_) { row_modulate<false, true>(A.x, A.norm1_g, mod + 0 * DM, mod + 1 * DM, (bf16_t*)(ws + WS_H1), ws + WS_H1F8, (LAS float*)lds, tid, gw, ngw, lane); }
    SEAM(1);
    if (IN(2)) for (int rep_ = 0; rep_ < REP(2); ++rep_) {
        {
            pg8::Gemm g{(const bf16_t*)(ws + WS_H1), (const bf16_t*)(ws + WS_WIN), S, 8192, DM}; pg8::StaticOrder So; So.init(S, 8192, G, bid);
            EpiQKV E{(bf16_t*)(ws + WS_QKV), (bf16_t*)(ws + WS_QKV2), (const float*)(ws + WS_ROPE), 0};
            pg8::gemm_phase<EpiQKV, pg8::StaticOrder, false>(lds, g, So, E, nullptr);
        }
        __syncthreads();
        {
            pg8::Gemm g{(const bf16_t*)(ws + WS_H1F8), (const bf16_t*)(ws + WS_WIN + WIN8_OFF), S, 4096, DM / 2}; pg8::StaticOrder So; So.init(S, 4096, G, bid);
            EpiSV E{(bf16_t*)(ws + WS_QKV), (bf16_t*)(ws + WS_QKV2)};
            pg8::gemm_phase<EpiSV, pg8::StaticOrder, false, true>(lds, g, So, E, nullptr);
        }
    }
    SEAM(2);
    if (IN(3)) for (int rep_ = 0; rep_ < REP(3); ++rep_) { attn_phase(A, (char*)lds_raw, G, bid); }
    SEAM(3);
    if (IN(4)) for (int rep_ = 0; rep_ < REP(4); ++rep_) { combine_phase(A, gw, ngw, lane); }
    SEAM(4);
    if (IN(5)) for (int rep_ = 0; rep_ < REP(5); ++rep_) {
        pg8::Gemm g{(const bf16_t*)(ws + WS_Y), (const bf16_t*)(ws + WS_WOUT), S, DM, DM / 2}; pg8::StaticOrder So; So.init(S, DM, G, bid);
        EpiResid E{A.x, mod + 2 * DM, (bf16_t*)(ws + WS_X1)};
        pg8::gemm_phase<EpiResid, pg8::StaticOrder, false, true>(lds, g, So, E, nullptr);
    }
    SEAM(5);
    if (IN(6)) for (int rep_ = 0; rep_ < REP(6); ++rep_) { row_modulate<true, false>(ws + WS_X1, A.norm2_g, mod + 3 * DM, mod + 4 * DM, (bf16_t*)(ws + WS_H2), nullptr, (LAS float*)lds, tid, gw, ngw, lane); }
    SEAM(6);
    if (IN(7)) for (int rep_ = 0; rep_ < REP(7); ++rep_) {
        pg8::Gemm g{(const bf16_t*)(ws + WS_H2), (const bf16_t*)(ws + WS_WSC), S, 2048, DM}; pg8::StaticOrder So; So.init(S, 2048, G, bid);
#ifdef PROBE_FLAGS
        if (A.flag & 2) g.K = DM / 2;
        if (A.flag & 4) g.K = 256;
#endif
        pg8::EpiF32 E{(float*)(ws + WS_SC), 2048, nullptr};
        pg8::gemm_phase<pg8::EpiF32, pg8::StaticOrder, false>(lds, g, So, E, nullptr);
    }
    SEAM(7);
    if (IN(9)) for (int rep_ = 0; rep_ < REP(9); ++rep_) { peer_phase(A, lds, G, bid, tid); }
#ifdef DBG_TIME
    xcd_barrier(bar);
    if (bid == 0 && tid == 0) ((unsigned long long*)(ws + WS_CTL + 32768))[10] = __builtin_amdgcn_s_memrealtime();
    xcd_barrier(bar);
    {
        const unsigned long long* ts = (const unsigned long long*)(ws + WS_CTL + 32768);
        const float d1 = (float)(ts[DBG_T1 + 1] - ts[DBG_T1]) * 0.01f, d2 = (float)(ts[DBG_T2 + 1] - ts[DBG_T2]) * 0.01f;
        const float cval = sqrtf(fmaxf(d1 * 0.1f, 0.f));
        for (size_t i = (size_t)bid * 512 + tid; i < (size_t)S * DM; i += (size_t)G * 512) A.out[i] = (i == 0) ? 10.0f * d2 : cval;
    }
#endif
#undef IN
#undef SEAM
}

#ifdef DBG_CHECK
__global__ void __launch_bounds__(512) dbg_kernel(Args A, int which) {
    __shared__ __attribute__((aligned(16))) unsigned char dl[8192];
    if (which == 0) dbg_phase(A, (LAS unsigned char*)dl, blockIdx.x, threadIdx.x);
    else dbg_emit(A, blockIdx.x, threadIdx.x, gridDim.x);
}
#endif
extern "C" void kernel_launch(void* const* d_in, const int* in_sizes, int n_in, void* d_out, int out_size, void* d_ws, size_t ws_size, hipStream_t stream) {
    static int grid = 0;
    if (grid == 0) {
        if (n_in != 20 || out_size != S * DM || ws_size < WS_END) { fprintf(stderr, "kernel_launch: unexpected shapes (n_in %d out %d ws %zu)\n", n_in, out_size, ws_size); grid = -1; return; }
        int dev = 0, cus = 0, per_cu = 0;
        if (hipGetDevice(&dev) != hipSuccess || hipDeviceGetAttribute(&cus, hipDeviceAttributeMultiprocessorCount, dev) != hipSuccess) { grid = -1; return; }
        if (hipFuncSetAttribute((const void*)hymba_fwd, hipFuncAttributeMaxDynamicSharedMemorySize, LDS_BYTES) != hipSuccess) { fprintf(stderr, "kernel_launch: hipFuncSetAttribute failed\n"); grid = -1; return; }
        if (hipOccupancyMaxActiveBlocksPerMultiprocessor(&per_cu, (const void*)hymba_fwd, 512, LDS_BYTES) != hipSuccess || per_cu < 1) fprintf(stderr, "kernel_launch: occupancy query reports %d\n", per_cu);
        (void)hipGetLastError();
        grid = cus;
    }
    if (grid < 0) return;
    (void)hipMemsetAsync((char*)d_ws + WS_CTL, 0, CTL_ZERO_BYTES, stream);
    Args a{};
    a.x = (const float*)d_in[0]; a.c = (const float*)d_in[1]; a.positions = (const int*)d_in[2]; a.norm1_g = (const float*)d_in[3]; a.norm2_g = (const float*)d_in[4];
    a.w_ada = (const float*)d_in[5]; a.b_ada = (const float*)d_in[6]; a.w_in = (const float*)d_in[7]; a.lam_q1 = (const float*)d_in[8]; a.lam_k1 = (const float*)d_in[9];
    a.lam_q2 = (const float*)d_in[10]; a.lam_k2 = (const float*)d_in[11]; a.diff_subln_g = (const float*)d_in[12]; a.dil_out_g = (const float*)d_in[13];
    a.w_out = (const float*)d_in[14]; a.peer_wq = (const float*)d_in[15]; a.peer_subkeys = (const float*)d_in[16]; a.peer_u = (const float*)d_in[17]; a.peer_v = (const float*)d_in[18];
    a.final_g = (const float*)d_in[19];
    a.out = (float*)d_out; a.ws = (unsigned char*)d_ws;
    if (MK_N_LAUNCHES == 1) { a.ph_lo = 0; a.ph_hi = NPHASE; hipLaunchKernelGGL(hymba_fwd, dim3(grid), dim3(512), LDS_BYTES, stream, a); }
    else { for (int p = 0; p < NPHASE; ++p) { a.ph_lo = p; a.ph_hi = p + 1; const int nr = ((REP_MASK >> p) & 1) ? 2 : 1;
            for (int r = 0; r < nr; ++r) { a.flag = (nr == 2 && r == 0) ? PROBE_FLAG_VAL : 0; hipLaunchKernelGGL(hymba_fwd, dim3(grid), dim3(512), LDS_BYTES, stream, a); } } }
#ifdef DBG_CHECK
    hipLaunchKernelGGL(dbg_kernel, dim3(grid), dim3(512), 0, stream, a, 0);
    hipLaunchKernelGGL(dbg_kernel, dim3(grid), dim3(512), 0, stream, a, 1);
#endif
}
```

```cpp
#include <hip/hip_runtime.h>
#include <cstdint>
#include <cstdio>

#define REP_MASK 0x000
#define PROBE_FLAG_VAL 0
#ifndef MK_N_LAUNCHES
#define MK_N_LAUNCHES 1
#endif
constexpr int NPHASE = 10;

constexpr int S = 8192, DM = 4096, NIN = 12288, NADA = 24576, NEXP = 16384;
constexpr float NORM_EPS = 1e-6f;
constexpr float LAM_INIT = 0.2f;

constexpr size_t MiB = 1u << 20;
constexpr size_t WS_CTL = 0, CTL_ZERO_BYTES = 128 * 1024;
constexpr size_t WS_MOD = 1 * MiB;
constexpr size_t WS_LAM = 1 * MiB + 128 * 1024;
constexpr size_t WS_ROPE = 2 * MiB;
constexpr size_t WS_WIN = 4 * MiB;
constexpr size_t WS_WOUT = 100 * MiB;
constexpr size_t WS_WSC = 132 * MiB;
constexpr size_t WS_UB = 148 * MiB;
constexpr size_t WS_VB = 276 * MiB;
constexpr size_t WS_H1 = 404 * MiB;
constexpr size_t WS_Y = 468 * MiB;
constexpr size_t WS_H2 = 532 * MiB;
constexpr size_t WS_QKV = 596 * MiB;
constexpr size_t QKV_T = (size_t)16 * S * 128;
constexpr size_t WS_OD = 788 * MiB;
constexpr size_t WS_OS = 916 * MiB;
constexpr size_t WS_H1F8 = 1012 * MiB;
constexpr size_t WIN8_OFF = 64 * MiB;
constexpr size_t WS_LSE = 1108 * MiB;
constexpr size_t WS_X1 = 1110 * MiB;
constexpr size_t WS_SC = 1238 * MiB;
constexpr size_t WS_IDX = 1302 * MiB;
constexpr size_t WS_GATE = 1306 * MiB;
constexpr size_t WS_QKV2 = 1310 * MiB;
constexpr size_t WS_END = 1502 * MiB;
constexpr int CW_BAR = 4096;

constexpr int RING_BYTES = 131072;
constexpr int MISC_OFF = RING_BYTES + 320;
constexpr int LDS_BYTES = 147456;

namespace pg8 {
#define PG8_LAS __attribute__((address_space(3)))
typedef unsigned short bf16_t;
typedef short bf16x8 __attribute__((ext_vector_type(8)));
typedef float f32x4 __attribute__((ext_vector_type(4)));
typedef unsigned u32x4 __attribute__((ext_vector_type(4)));
constexpr int BM = 256, BK = 64, HALF = 128, HTB = HALF * BK * 2  , STAGE_BYTES = 8 * HTB, NXCD = 8, WGM = 8;

__host__ __device__ __forceinline__ int lds_byte(int r, int c) { const int st = (r >> 4) * 2 + (c >> 5), rr = r & 15, cc = c & 31, ob = rr * 64 + cc * 2; return st * 1024 + (ob ^ (((ob >> 9) & 1) << 5)); }
__host__ __device__ __forceinline__ void stage_rc(int b, int& R, int& C) { const int st = b / 1024, sb = b % 1024, swz = sb ^ (((sb >> 9) & 1) << 5); R = (st >> 1) * 16 + swz / 64; C = (st & 1) * 32 + (swz % 64) / 2; }
__host__ __device__ __forceinline__ int perm32(int rho) { const int n = rho >> 4, i = rho & 15; return 8 * (i >> 2) + 4 * n + (i & 3); }

struct Unit { int pm, pn; };
struct Gemm { const bf16_t* A; const bf16_t* Bt; int M, N, K; };

struct StaticOrder {
    int nM, nN, nwg, G, c;
    __host__ __device__ void init(int M, int N, int G_, int c_) { nM = M / BM; nN = N / BM; nwg = nM * nN; G = G_; c = c_; }
    __host__ __device__ bool next(int i, Unit& u) const {
        const long L = (long)i * G + c; if (L >= nwg) return false;
        int wgid = (int)L; { const int q = nwg / NXCD, r = nwg % NXCD, xcd = wgid % NXCD, off = wgid / NXCD; wgid = (xcd < r ? xcd * (q + 1) : r * (q + 1) + (xcd - r) * q) + off; }
        const int nig = WGM * nN, gid = wgid / nig, fm = gid * WGM, gsz = (nM - fm) < WGM ? (nM - fm) : WGM;
        u.pm = fm + ((wgid % nig) % gsz); u.pn = (wgid % nig) / gsz; return true;
    }
    __device__ __forceinline__ void a_ready(const Unit&) const {}
    __device__ __forceinline__ void done(const Unit&) const {}
};
struct CountedOrder : StaticOrder {
    const unsigned* ready; unsigned need; unsigned* tmo;
    __device__ __forceinline__ void a_ready(const Unit& u) const {
        if (threadIdx.x < 64) {
            const unsigned long long t0 = __builtin_amdgcn_s_memrealtime(); unsigned polls = 0;
            while ((unsigned)__builtin_amdgcn_readfirstlane(__hip_atomic_load(ready + 64 * u.pm, __ATOMIC_RELAXED, __HIP_MEMORY_SCOPE_AGENT)) < need) {
                if ((++polls & 255u) == 0u && __builtin_amdgcn_readfirstlane(__hip_atomic_load(tmo, __ATOMIC_RELAXED, __HIP_MEMORY_SCOPE_AGENT)) != 0u) break;
                if (__builtin_amdgcn_s_memrealtime() - t0 > 2000000ull) {
                    if (threadIdx.x == 0) { unsigned expect = 0u; __hip_atomic_compare_exchange_strong(tmo + 1, &expect, 0x600u | (unsigned)(u.pm & 0xff), __ATOMIC_RELAXED, __ATOMIC_RELAXED, __HIP_MEMORY_SCOPE_AGENT); __hip_atomic_store(tmo, 1u, __ATOMIC_RELAXED, __HIP_MEMORY_SCOPE_AGENT); }
                    break; }
                __builtin_amdgcn_s_sleep(2); }
            __builtin_amdgcn_fence(__ATOMIC_ACQUIRE, "agent");
            asm volatile("s_waitcnt vmcnt(0)" ::: "memory");
        }
#if !defined(BROKEN_HOOK_NO_BARRIER)
        asm volatile("" ::: "memory"); __builtin_amdgcn_s_barrier(); asm volatile("" ::: "memory");
#endif
    }
};

__device__ __forceinline__ unsigned cvt_pk_bf16(float lo, float hi) { unsigned r; asm volatile("v_cvt_pk_bf16_f32 %0, %1, %2" : "=v"(r) : "v"(lo), "v"(hi)); return r; }
typedef float f32x2 __attribute__((ext_vector_type(2)));
__device__ __forceinline__ f32x2 gelu_pk(f32x2 v) {
    const f32x2 av = __builtin_elementwise_abs(v), d = av * 0.2316418882f + 1.0f;
    f32x2 t; t.x = __builtin_amdgcn_rcpf(d.x); t.y = __builtin_amdgcn_rcpf(d.y);
    f32x2 q = t * 0.5307027145f + (-0.7265760135f); q = q * t + 0.7107068705f; q = q * t + (-0.142248368f); q = q * t + 0.127414796f; q = q * t;
    const f32x2 s = (v * v) * (-0.72134752044f);
    f32x2 e; e.x = __builtin_amdgcn_exp2f(s.x); e.y = __builtin_amdgcn_exp2f(s.y);
    const f32x2 m = v * (q * e), r = v - m;
    f32x2 o; o.x = v.x < 0.f ? m.x : r.x; o.y = v.y < 0.f ? m.y : r.y; return o;
}

struct EpiF32 {
    static constexpr bool PERM = false, AFTER_DRAIN = false;
    float* C; int ldc; const float* bias;
    __device__ __forceinline__ void operator()(const f32x4 (&acc)[2][2][4][2], const Unit& u, int wr, int wc, int fr, int fq) const {
        const int row0 = u.pm * BM + wr * 64 + fr, col0 = u.pn * BM + wc * 32 + 4 * fq;
        f32x4 bv[2][2];
#pragma unroll
        for (int bj = 0; bj < 2; ++bj)
#pragma unroll
            for (int n = 0; n < 2; ++n) bv[bj][n] = bias ? *(const f32x4*)(bias + col0 + bj * HALF + n * 16) : (f32x4){0.f, 0.f, 0.f, 0.f};
#pragma unroll
        for (int ai = 0; ai < 2; ++ai)
#pragma unroll
            for (int m = 0; m < 4; ++m) { float* rowp = C + (size_t)(row0 + ai * HALF + m * 16) * ldc + col0;
#pragma unroll
                for (int bj = 0; bj < 2; ++bj)
#pragma unroll
                    for (int n = 0; n < 2; ++n) *(f32x4*)(rowp + bj * HALF + n * 16) = acc[ai][bj][m][n] + bv[bj][n]; }
    }
};
template <int ACT  > struct EpiBf16 {
    static constexpr bool PERM = true, AFTER_DRAIN = false;
    bf16_t* O; int ldc; const float* bias; int split_cols; size_t split_stride;
    __device__ __forceinline__ void operator()(const f32x4 (&acc)[2][2][4][2], const Unit& u, int wr, int wc, int fr, int fq) const {
        const int row0 = u.pm * BM + wr * 64 + fr; int colt = u.pn * BM; bf16_t* base = O;
        if (split_cols) { const int t = colt / split_cols; base += (size_t)t * split_stride; colt -= t * split_cols; }
        const int col0 = colt + wc * 32 + 8 * fq, bcol0 = u.pn * BM + wc * 32 + 8 * fq;
        f32x4 bv[2][2];
#pragma unroll
        for (int bj = 0; bj < 2; ++bj)
#pragma unroll
            for (int n = 0; n < 2; ++n) bv[bj][n] = bias ? *(const f32x4*)(bias + bcol0 + bj * HALF + 4 * n) : (f32x4){0.f, 0.f, 0.f, 0.f};
#pragma unroll
        for (int ai = 0; ai < 2; ++ai)
#pragma unroll
            for (int m = 0; m < 4; ++m) { bf16_t* rowp = base + (size_t)(row0 + ai * HALF + m * 16) * ldc + col0;
#pragma unroll
                for (int bj = 0; bj < 2; ++bj) { f32x4 v0 = acc[ai][bj][m][0] + bv[bj][0], v1 = acc[ai][bj][m][1] + bv[bj][1];
                    if (ACT == 1) { f32x2 a = gelu_pk((f32x2){v0[0], v0[1]}), b = gelu_pk((f32x2){v0[2], v0[3]}), c = gelu_pk((f32x2){v1[0], v1[1]}), d = gelu_pk((f32x2){v1[2], v1[3]});
                        v0 = (f32x4){a.x, a.y, b.x, b.y}; v1 = (f32x4){c.x, c.y, d.x, d.y}; }
                    if (ACT == 2) {
#pragma unroll
                        for (int j = 0; j < 4; ++j) { v0[j] = 0.5f * v0[j] * (1.0f + erff(v0[j] * 0.70710678f)); v1[j] = 0.5f * v1[j] * (1.0f + erff(v1[j] * 0.70710678f)); } }
                    u32x4 w; w.x = cvt_pk_bf16(v0[0], v0[1]); w.y = cvt_pk_bf16(v0[2], v0[3]); w.z = cvt_pk_bf16(v1[0], v1[1]); w.w = cvt_pk_bf16(v1[2], v1[3]);
                    *(u32x4*)(rowp + bj * HALF) = w; } }
    }
};
template <class Epi, class Sched, bool STAMP = false, bool F8 = false>
__device__ __forceinline__ void gemm_phase(PG8_LAS unsigned char* lds, const Gemm g, const Sched& S, const Epi& E, unsigned long long* stamps) {
    const int tid = threadIdx.x, wid = __builtin_amdgcn_readfirstlane(tid >> 6), lane = tid & 63, wr = wid >> 2, wc = wid & 3, fr = lane & 15, fq = lane >> 4;
    const int K = g.K, nt = K / BK;
    int ts_lo = 0, ts_hi = 0, nts = 0; const unsigned long long rt_entry = STAMP ? (unsigned long long)wall_clock64() : 0ull;
#define PG8_STAMP() do { if (STAMP && wid == 0 && nts < 64) { const unsigned long long _c = (unsigned long long)clock64(); \
        ts_lo = (lane == nts) ? (int)(unsigned)_c : ts_lo; ts_hi = (lane == nts) ? (int)(unsigned)(_c >> 32) : ts_hi; ++nts; } } while (0)
    PG8_STAMP();
    unsigned voffA[2], voffB[2];
#pragma unroll
    for (int i = 0; i < 2; ++i) { int R, C; stage_rc(tid * 16 + i * 8192, R, C); const int Rb = Epi::PERM ? ((R & ~31) + perm32(R & 31)) : R;
        voffA[i] = (unsigned)(R * K + C) * 2u; voffB[i] = (unsigned)(Rb * K + C) * 2u; }
    const size_t kstep = (size_t)(BK * 2);
    const size_t hstep = (size_t)HALF * K * 2;
    const size_t tstep = 2 * hstep;
    const unsigned ldsw = (unsigned)wid * 1024u;
    const int aoff = lds_byte(wr * 64 + fr, fq * 8), boff = lds_byte(wc * 32 + fr, fq * 8);
#define PG8_SA(b, h) (((b) * 2 + (h)) * HTB)
#define PG8_SB(b, h) ((4 + (b) * 2 + (h)) * HTB)
#define PG8_STAGE(bufoff, gbase, voff) do { _Pragma("unroll") for (int _i = 0; _i < 2; ++_i) \
        __builtin_amdgcn_global_load_lds((const unsigned*)((const char*)(gbase) + (voff)[_i]), (PG8_LAS unsigned*)(lds + (bufoff) + ldsw + _i * 8192), 16, 0, 0); } while (0)
typedef int pg8_i32x4 __attribute__((ext_vector_type(4))); typedef int pg8_i32x8 __attribute__((ext_vector_type(8)));
#define PG8_LD8(addr) __builtin_shufflevector(*(const PG8_LAS pg8_i32x4*)(addr), *(const PG8_LAS pg8_i32x4*)((addr) + 1024), 0, 1, 2, 3, 4, 5, 6, 7)
#define PG8_LDA(dst, b, h) do { if constexpr (F8) { _Pragma("unroll") for (int m = 0; m < 4; ++m) dst##8[m] = PG8_LD8(lds + PG8_SA(b, h) + aoff + m * 2048); } \
        else { _Pragma("unroll") for (int m = 0; m < 4; ++m) _Pragma("unroll") for (int k = 0; k < 2; ++k) dst[m][k] = *(const PG8_LAS bf16x8*)(lds + PG8_SA(b, h) + aoff + m * 2048 + k * 1024); } } while (0)
#define PG8_LDB(dst, b, h) do { if constexpr (F8) { _Pragma("unroll") for (int n = 0; n < 2; ++n) dst##8[n] = PG8_LD8(lds + PG8_SB(b, h) + boff + n * 2048); } \
        else { _Pragma("unroll") for (int n = 0; n < 2; ++n) _Pragma("unroll") for (int k = 0; k < 2; ++k) dst[n][k] = *(const PG8_LAS bf16x8*)(lds + PG8_SB(b, h) + boff + n * 2048 + k * 1024); } } while (0)
#define PG8_MMA(ai, bj, At, Bt) do { __builtin_amdgcn_s_setprio(1); _Pragma("unroll") for (int m = 0; m < 4; ++m) _Pragma("unroll") for (int n = 0; n < 2; ++n) { \
        if constexpr (F8) { asm volatile("v_mfma_scale_f32_16x16x128_f8f6f4 %0, %1, %2, %0, %3, %3 op_sel_hi:[0,0,0]" : "+v"(acc[ai][bj][m][n]) : "v"(Bt##8[n]), "v"(At##8[m]), "v"(sc1_)); } \
        else { _Pragma("unroll") for (int k = 0; k < 2; ++k) acc[ai][bj][m][n] = __builtin_amdgcn_mfma_f32_16x16x32_bf16(Bt[n][k], At[m][k], acc[ai][bj][m][n], 0, 0, 0); } } \
        __builtin_amdgcn_s_setprio(0); } while (0)
#define PG8_WAIT_V(n) asm volatile("s_waitcnt vmcnt(" #n ")" ::: "memory")
#define PG8_WAIT_L(n) asm volatile("s_waitcnt lgkmcnt(" #n ")" ::: "memory")
#define PG8_BAR __builtin_amdgcn_s_barrier()
#define PG8_SCHED __builtin_amdgcn_sched_barrier(0)
    Unit cur, nxt; int ui = 0;
    if (!S.next(0, cur)) return;
    f32x4 acc[2][2][4][2];
#pragma unroll
    for (int a = 0; a < 2; ++a)
#pragma unroll
        for (int b = 0; b < 2; ++b)
#pragma unroll
            for (int m = 0; m < 4; ++m)
#pragma unroll
                for (int n = 0; n < 2; ++n) acc[a][b][m][n] = (f32x4){0.f, 0.f, 0.f, 0.f};
    const int sc1_ = 0x7f7f7f7f;
    bf16x8 At[4][2], B0[2][2], B1[2][2]; pg8_i32x8 At8[4], B08[2], B18[2];
    const char* cA = (const char*)g.A + (size_t)cur.pm * tstep; const char* cB = (const char*)g.Bt + (size_t)cur.pn * tstep;
    S.a_ready(cur);
    PG8_STAGE(PG8_SB(0, 0), cB, voffB); PG8_STAGE(PG8_SA(0, 0), cA, voffA); PG8_STAGE(PG8_SB(0, 1), cB + hstep, voffB); PG8_STAGE(PG8_SA(0, 1), cA + hstep, voffA);
    if (wr == 1) PG8_BAR;
    PG8_WAIT_V(4); PG8_BAR;
    PG8_STAGE(PG8_SB(1, 0), cB + kstep, voffB); PG8_STAGE(PG8_SA(1, 0), cA + kstep, voffA); PG8_STAGE(PG8_SB(1, 1), cB + hstep + kstep, voffB);
    PG8_WAIT_V(6); PG8_BAR;
    PG8_STAMP();
    for (;;) {
        const bool has_next = S.next(ui + 1, nxt);
        const char* nA = has_next ? (const char*)g.A + (size_t)nxt.pm * tstep : cA; const char* nB = has_next ? (const char*)g.Bt + (size_t)nxt.pn * tstep : cB;
        for (int t = 0; t < nt; t += 2) {
            const bool last = (t == nt - 2);
            const char* a1 = cA + (size_t)(t + 1) * kstep;
            const char* a2 = last ? nA : cA + (size_t)(t + 2) * kstep; const char* b2 = last ? nB : cB + (size_t)(t + 2) * kstep;
            const char* a3 = a2 + kstep; const char* b3 = b2 + kstep;
            if (last && has_next) S.a_ready(nxt);
            PG8_LDB(B0, 0, 0); PG8_SCHED; PG8_LDA(At, 0, 0); PG8_STAGE(PG8_SA(1, 1), a1 + hstep, voffA);
            PG8_WAIT_L(8); PG8_BAR; PG8_WAIT_L(0); PG8_MMA(0, 0, At, B0); PG8_BAR; PG8_SCHED;
            PG8_LDB(B1, 0, 1); PG8_STAGE(PG8_SB(0, 0), b2, voffB);
            PG8_BAR; PG8_WAIT_L(0); PG8_MMA(0, 1, At, B1); PG8_BAR;
            PG8_LDA(At, 0, 1); PG8_STAGE(PG8_SA(0, 0), a2, voffA);
            PG8_BAR; PG8_WAIT_L(0); PG8_MMA(1, 0, At, B0); PG8_BAR; PG8_SCHED;
            PG8_STAGE(PG8_SB(0, 1), b2 + hstep, voffB);
            PG8_WAIT_V(6); PG8_BAR; PG8_MMA(1, 1, At, B1); PG8_BAR;
            PG8_LDB(B0, 1, 0); PG8_SCHED; PG8_LDA(At, 1, 0); PG8_STAGE(PG8_SA(0, 1), a2 + hstep, voffA);
            PG8_WAIT_L(8); PG8_BAR; PG8_WAIT_L(0); PG8_MMA(0, 0, At, B0); PG8_BAR; PG8_SCHED;
            PG8_LDB(B1, 1, 1); PG8_STAGE(PG8_SB(1, 0), b3, voffB);
            PG8_BAR; PG8_WAIT_L(0); PG8_MMA(0, 1, At, B1); PG8_BAR;
            PG8_LDA(At, 1, 1); PG8_STAGE(PG8_SA(1, 0), a3, voffA);
            PG8_BAR; PG8_WAIT_L(0); PG8_MMA(1, 0, At, B0); PG8_BAR; PG8_SCHED;
            PG8_STAGE(PG8_SB(1, 1), b3 + hstep, voffB);
            PG8_WAIT_V(6); PG8_BAR; PG8_MMA(1, 1, At, B1); PG8_BAR;
        }
        PG8_STAMP();
        if constexpr (!Epi::AFTER_DRAIN) { E(acc, cur, wr, wc, fr, fq); S.done(cur); }
        PG8_STAMP();
        if (!has_next) break;
#pragma unroll
        for (int a = 0; a < 2; ++a)
#pragma unroll
            for (int b = 0; b < 2; ++b)
#pragma unroll
                for (int m = 0; m < 4; ++m)
#pragma unroll
                    for (int n = 0; n < 2; ++n) acc[a][b][m][n] = (f32x4){0.f, 0.f, 0.f, 0.f};
        cur = nxt; cA = nA; cB = nB; ++ui;
    }
    PG8_WAIT_V(0);
    if (wr == 0) PG8_BAR;
    PG8_BAR;
    if constexpr (Epi::AFTER_DRAIN) { E.fused(acc, cur, wr, wc, fr, fq, lds, wid, lane); S.done(cur); }
    PG8_STAMP();
    if (STAMP && wid == 0) { stamps[lane] = lane < nts ? (((unsigned long long)(unsigned)ts_hi << 32) | (unsigned)ts_lo) : 0ull;
        if (lane == 62) stamps[62] = rt_entry; if (lane == 63) stamps[63] = (unsigned long long)wall_clock64(); }
#undef PG8_STAMP
#undef PG8_SA
#undef PG8_SB
#undef PG8_STAGE
#undef PG8_LDA
#undef PG8_LD8
#undef PG8_LDB
#undef PG8_MMA
#undef PG8_WAIT_V
#undef PG8_WAIT_L
#undef PG8_BAR
#undef PG8_SCHED
}
}
namespace at {
constexpr int D = 128;
constexpr float THR = 8.f;
constexpr float SCALE = 0.08838834764831845f;
constexpr int NW = 8, QBLK = 32, KVBLK = 64, QB = NW * QBLK;
constexpr int SHM_V = KVBLK * D * 2, SHM_K = KVBLK * D * 2;
constexpr int LDS_BYTES = 2 * SHM_V + 2 * SHM_K + NW * 64 * 4;

typedef unsigned short bf16;
typedef short bf16x8 __attribute__((ext_vector_type(8)));
typedef short s16x4 __attribute__((ext_vector_type(4)));
typedef float f32x16 __attribute__((ext_vector_type(16)));
typedef float f32x4 __attribute__((ext_vector_type(4)));
typedef unsigned u32x4 __attribute__((ext_vector_type(4)));
template <class A, class Bt> struct same_t { static constexpr bool v = false; };
template <class A> struct same_t<A, A> { static constexpr bool v = true; };

#define KSWZ(row, colB) ((row) * 256 + ((colB) ^ (((row) & 7) << 4)))
#define SBAR() __builtin_amdgcn_sched_barrier(0)
__device__ __forceinline__ int v_st(int k, int c) { const int kk = (k & ~0xC) | ((k & 4) << 1) | ((k & 8) >> 1); return ((kk >> 3) * 4 + (c >> 5)) * 512 + ((kk & 7) * 32 + (c & 31)) * 2; }
__device__ __forceinline__ int v_rd_base(int lane) { return ((lane & 3) << 3) | (((lane >> 2) & 3) << 6) | (((lane >> 4) & 1) << 5) | (((lane >> 5) & 1) << 8); }
constexpr int v_rd_off(int d0, int ks, int half) { return d0 * 512 + ks * 4096 + half * 2048; }
__device__ __forceinline__ int crow(int r, int hi) { return (r & 3) + 8 * (r >> 2) + 4 * hi; }
__device__ __forceinline__ unsigned cvtpk(float lo, float hi) {
    unsigned r; asm volatile("v_cvt_pk_bf16_f32 %0, %1, %2" : "=v"(r) : "v"(lo), "v"(hi)); return r;
}
__device__ __forceinline__ bf16x8 pack8(f32x4 a, f32x4 b) {
    u32x4 w = {cvtpk(a[0], a[1]), cvtpk(a[2], a[3]), cvtpk(b[0], b[1]), cvtpk(b[2], b[3])};
    return *reinterpret_cast<bf16x8*>(&w);
}
template <class T> __device__ __forceinline__ bf16x8 load8(const T* p) {
    if constexpr (same_t<T, float>::v) { return pack8(*(const f32x4*)p, *(const f32x4*)(p + 4)); }
    else { return *reinterpret_cast<const bf16x8*>(p); }
}
__device__ __forceinline__ void mask_tile(f32x16& p0, f32x16& p1, int dq, unsigned W) {
    const float NEG = -__builtin_inff();
#pragma unroll
    for (int r = 0; r < 16; ++r) {
        const int c = (r & 3) + 8 * (r >> 2);
        if ((unsigned)(dq - c) >= W) p0[r] = NEG;
        if ((unsigned)(dq - c - 32) >= W) p1[r] = NEG;
    }
}
__device__ __forceinline__ void partialSM(f32x16& p0, f32x16& p1, float& m_reg, float& mn, float& alpha) {
    float pmax = p0[0]; for (int r = 1; r < 16; ++r) pmax = fmaxf(pmax, p0[r]); for (int r = 0; r < 16; ++r) pmax = fmaxf(pmax, p1[r]);
    { auto rr = __builtin_amdgcn_permlane32_swap(__float_as_uint(pmax), __float_as_uint(pmax), false, false);
      pmax = fmaxf(__uint_as_float(rr[0]), __uint_as_float(rr[1])); }
    constexpr float C2 = 1.4426950408889634f * SCALE;
    if (__builtin_expect(__all((pmax - m_reg) * SCALE <= THR), 1)) { mn = m_reg; alpha = 1.f; }
    else { mn = fmaxf(m_reg, pmax); alpha = __builtin_amdgcn_exp2f((m_reg - mn) * C2); m_reg = mn; }
    const float mnL = -mn * C2;
    for (int r = 0; r < 16; ++r) p0[r] = fmaf(p0[r], C2, mnL); for (int r = 0; r < 16; ++r) p1[r] = fmaf(p1[r], C2, mnL);
    for (int r = 0; r < 16; ++r) p0[r] = __builtin_amdgcn_exp2f(p0[r]);
}
__device__ __forceinline__ void finishSM(f32x16& p0, f32x16& p1, float alpha, float& l_reg, bf16x8& pa0, bf16x8& pa1, bf16x8& pa2, bf16x8& pa3) {
    for (int r = 0; r < 16; ++r) p1[r] = __builtin_amdgcn_exp2f(p1[r]);
    float ps = 0; for (int r = 0; r < 16; ++r) ps += p0[r]; for (int r = 0; r < 16; ++r) ps += p1[r];
    { auto rr = __builtin_amdgcn_permlane32_swap(__float_as_uint(ps), __float_as_uint(ps), false, false);
      ps = __uint_as_float(rr[0]) + __uint_as_float(rr[1]); }
    l_reg = l_reg * alpha + ps;
#define PK4(P, B_, OUT) do { unsigned a0 = cvtpk(P[B_+0], P[B_+1]), a1 = cvtpk(P[B_+2], P[B_+3]);                          \
        unsigned b0 = cvtpk(P[B_+4], P[B_+5]), b1 = cvtpk(P[B_+6], P[B_+7]);                                             \
        auto r0 = __builtin_amdgcn_permlane32_swap(a0, b0, false, false); auto r1 = __builtin_amdgcn_permlane32_swap(a1, b1, false, false); \
        u32x4 w = {r0[0], r1[0], r0[1], r1[1]}; OUT = *reinterpret_cast<bf16x8*>(&w); } while (0)
    PK4(p0, 0, pa0); PK4(p0, 8, pa1); PK4(p1, 0, pa2); PK4(p1, 8, pa3);
#undef PK4
}
template <int KB, bool SK>
__device__ __forceinline__ void qkt(f32x16& p0, f32x16& p1, const char* K_lds, int r32, int hi, const bf16x8* qr, bool act) {
    if (SK && !act) { const float NEG = -__builtin_inff();
#pragma unroll
        for (int r = 0; r < 16; ++r) { p0[r] = NEG; p1[r] = NEG; } return; }
    p0 = f32x16{}; p1 = f32x16{};
    const char* kb[4];
#pragma unroll
    for (int dd = 0; dd < 4; ++dd) kb[dd] = K_lds + KB * SHM_K + KSWZ(r32, (dd * 16 + hi * 8) * 2);
#pragma unroll
    for (int d0 = 0; d0 < 8; ++d0) { const char* a = kb[d0 & 3] + (d0 >> 2) * 128;
        bf16x8 b0 = *reinterpret_cast<const bf16x8*>(a);
        bf16x8 b1 = *reinterpret_cast<const bf16x8*>(a + 32 * 256);
        p0 = __builtin_amdgcn_mfma_f32_32x32x16_bf16(b0, qr[d0], p0, 0, 0, 0);
        p1 = __builtin_amdgcn_mfma_f32_32x32x16_bf16(b1, qr[d0], p1, 0, 0, 0); }
}
template <int VB, bool SK>
__device__ __forceinline__ void pv_tile(f32x16* o, int vb0, bf16x8 pa0, bf16x8 pa1, bf16x8 pa2, bf16x8 pa3, bool act) {
    if (SK && !act) return;
#define TRRD(dst, off) asm volatile("ds_read_b64_tr_b16 %0, %1 offset:%2" : "=&v"(dst) : "v"(vb0), "i"(off) : "memory")
#define PV_D0(d0) do { s16x4 l0, l1, l2, l3, h0, h1, h2, h3; constexpr int b_ = VB * SHM_V + v_rd_off(d0, 0, 0);     \
        TRRD(l0, b_); TRRD(h0, b_ + 2048); TRRD(l1, b_ + 4096); TRRD(h1, b_ + 6144); TRRD(l2, b_ + 8192); TRRD(h2, b_ + 10240); TRRD(l3, b_ + 12288); TRRD(h3, b_ + 14336); \
        asm volatile("s_waitcnt lgkmcnt(0)" ::: "memory"); SBAR();                 \
        o[d0] = __builtin_amdgcn_mfma_f32_32x32x16_bf16(pa0, (bf16x8){l0[0], l0[1], l0[2], l0[3], h0[0], h0[1], h0[2], h0[3]}, o[d0], 0, 0, 0);   \
        o[d0] = __builtin_amdgcn_mfma_f32_32x32x16_bf16(pa1, (bf16x8){l1[0], l1[1], l1[2], l1[3], h1[0], h1[1], h1[2], h1[3]}, o[d0], 0, 0, 0);   \
        o[d0] = __builtin_amdgcn_mfma_f32_32x32x16_bf16(pa2, (bf16x8){l2[0], l2[1], l2[2], l2[3], h2[0], h2[1], h2[2], h2[3]}, o[d0], 0, 0, 0);   \
        o[d0] = __builtin_amdgcn_mfma_f32_32x32x16_bf16(pa3, (bf16x8){l3[0], l3[1], l3[2], l3[3], h3[0], h3[1], h3[2], h3[3]}, o[d0], 0, 0, 0); } while (0)
    PV_D0(0); PV_D0(1); PV_D0(2); PV_D0(3);
#undef PV_D0
#undef TRRD
}

struct BlockRef { const bf16* Q; const bf16* K; const bf16* V; bf16* O; float* L; int P0, W, skv, rs; };
struct Seam { bf16x8 qr[8]; bf16x8 st_v0, st_v1, st_k0, st_k1; };
__device__ __forceinline__ int swa_jlo(int P0, int W) { const int lowk = P0 - W + 1; return lowk > 0 ? lowk / KVBLK : 0; }
#define VMW() asm volatile("s_waitcnt vmcnt(0)" ::: "memory")
#define VMWN(n) asm volatile("s_waitcnt vmcnt(%0)" :: "i"(n) : "memory")
#define ROW(p, k0, rr) ((p) + (size_t)(unsigned)(((k0) + (rr)) * RS_) + sc)
#define RS_OF(ref) ({ int rs__ = (ref).rs; asm volatile("" : "+s"(rs__)); rs__; })
#define SLOAD_H(Kp, Vp, k0) do { S.st_v0 = load8<bf16>(ROW(Vp, k0, sr)); S.st_v1 = load8<bf16>(ROW(Vp, k0, 32 + sr));              \
                         S.st_k0 = load8<bf16>(ROW(Kp, k0, sr)); S.st_k1 = load8<bf16>(ROW(Kp, k0, 32 + sr)); } while (0)
#define SWRITE_HK(bf) do { *(bf16x8*)(K_lds + (bf) * SHM_K + kws) = S.st_k0; *(bf16x8*)(K_lds + (bf) * SHM_K + kws + 32 * 256) = S.st_k1; } while (0)
#define SWRITE_HV(bf) do { *(bf16x8*)(V_lds + (bf) * SHM_V + vst0) = S.st_v0; *(bf16x8*)(V_lds + (bf) * SHM_V + vst1) = S.st_v1; } while (0)
#define SWRITE_H(bf) do { SWRITE_HV(bf); SWRITE_HK(bf); } while (0)
__device__ __forceinline__ void causal_swa_prime(const BlockRef& cur, char* lds, Seam& S) {
    const int tid = threadIdx.x, wid = __builtin_amdgcn_readfirstlane(tid >> 6), lane = tid & 63, r32 = lane & 31, hi = lane >> 5;
    const int sr = tid >> 4, sc = (tid & 15) * 8, kws = KSWZ(sr, sc * 2); char* K_lds = lds + 2 * SHM_V;
    const int kb0 = swa_jlo(cur.P0, cur.W) * KVBLK;
    { const int RS_ = RS_OF(cur);
    for (int d0 = 0; d0 < 8; ++d0) S.qr[d0] = load8<bf16>(cur.Q + (size_t)(unsigned)((wid * QBLK + r32) * RS_) + d0 * 16 + hi * 8);
    SLOAD_H(cur.K, cur.V, kb0); } VMW(); SWRITE_HK(0);
    __syncthreads();
}
struct Svc { const float* tu; const float* tv; unsigned char* du; unsigned char* dv; int next, p_old, p_new, par, G, bid; };
constexpr int SVC_OFF = 73728, SVC_NCH = 65536;
typedef float svc_f4 __attribute__((ext_vector_type(4)));
__device__ __forceinline__ void svc_top(Svc& sv, char* lds) {
    if (sv.p_old < 0) return;
    int tid; asm volatile("v_mov_b32 %0, %1" : "=v"(tid) : "v"(threadIdx.x));
    const int g = sv.p_old, e = (g >> 1) & 16383;
    svc_f4 x = *(const svc_f4*)(lds + SVC_OFF + sv.par * 8192 + tid * 16);
    x *= (g >> 15) ? 16.0f : 256.0f;
    int w = __builtin_amdgcn_cvt_pk_fp8_f32(x.x, x.y, 0, false); w = __builtin_amdgcn_cvt_pk_fp8_f32(x.z, x.w, w, true);
    unsigned char* d = ((g >> 15) ? sv.dv : sv.du) + (size_t)e * 128 + ((size_t)(g & 1) << 25);
    __builtin_nontemporal_store(w, (int*)(d + (((tid >> 5) << 21) | ((tid & 31) << 2))));
}
__device__ __forceinline__ void svc_dma(Svc& sv, char* lds) {
    int tid; asm volatile("v_mov_b32 %0, %1" : "=v"(tid) : "v"(threadIdx.x));
    const int g = sv.next * sv.G + sv.bid;
    const bool live = sv.next >= 0 && g < SVC_NCH;
    const float* src = live ? ((g >> 15) ? sv.tv : sv.tu) + (size_t)((g >> 1) & 16383) * 4096 + (g & 1) * 2048 : sv.tu;
    const unsigned ldsa = __builtin_amdgcn_readfirstlane((unsigned)(uintptr_t)lds + SVC_OFF + sv.par * 8192 + (tid >> 6) * 1024);
    asm volatile("s_mov_b32 m0, %0\n\ts_nop 0\n\tglobal_load_lds_dwordx4 %1, %2 nt" :: "s"(ldsa), "v"(tid * 16), "s"(src) : "memory", "m0");
    sv.p_old = sv.p_new; sv.p_new = live ? g : -1; sv.next = live ? sv.next + 1 : -1; sv.par ^= 1;
}
__device__ __forceinline__ bool svc_busy(const Svc& sv) { return sv.next >= 0 || sv.p_old >= 0 || sv.p_new >= 0; }
template <bool SK>
__device__ __forceinline__ void causal_swa_block(const BlockRef& cur, const BlockRef& nxt, char* lds, Seam& S, Svc& sv) {
    const int tid = threadIdx.x, wid = __builtin_amdgcn_readfirstlane(tid >> 6), lane = tid & 63, r32 = lane & 31, hi = lane >> 5;
    const int W = cur.W, skv = cur.skv;
    const int j_lo = swa_jlo(cur.P0, W);
    int j_hi = (cur.P0 + QB - 1) / KVBLK + 1; if (j_hi > skv / KVBLK) j_hi = skv / KVBLK;
    const int NT = j_hi - j_lo;
    const int kbn = swa_jlo(nxt.P0, nxt.W) * KVBLK;
    const int qlo = cur.P0 + wid * QBLK, qm = qlo + r32 - 4 * hi;
    char* V_lds = lds; char* K_lds = lds + 2 * SHM_V;
    float* ws = (float*)(lds + 2 * SHM_V + 2 * SHM_K) + wid * 64; float* li_l = ws, * al_l = ws + 32;
    float m_reg = -1e30f, l_reg = 0; f32x16 o[4] = {};
    const int sr = tid >> 4, sc = (tid & 15) * 8, vst0 = v_st(sr, sc), vst1 = v_st(32 + sr, sc), kws = KSWZ(sr, sc * 2);
    const int vb0 = (int)(uintptr_t)V_lds + v_rd_base(lane);
    const bf16* Kh = cur.K; const bf16* Vh = cur.V;
#define RESC(a) do { if (__any((a) < 1.f)) { if (hi == 0) al_l[r32] = (a); asm volatile("s_waitcnt lgkmcnt(0)" ::: "memory");              \
                     for (int d_ = 0; d_ < 4; ++d_) for (int r = 0; r < 16; ++r) o[d_][r] *= al_l[crow(r, hi)]; } } while (0)
#define KBASE(t) ((j_lo + (t)) * KVBLK)
#define ACT(t) (KBASE(t) <= qlo + QBLK - 1 && KBASE(t) + KVBLK - 1 >= qlo - W + 1)
#define MASKT(P0_, P1_, t) do { const int kb_ = KBASE(t); if ((!SK || ACT(t)) && (kb_ + KVBLK - 1 > qlo || kb_ <= qlo + QBLK - 1 - W)) mask_tile(P0_, P1_, qm - kb_, (unsigned)W); } while (0)
    constexpr int NQL = 8;
#define SEAM_K0() do { VMWN(NQL); SWRITE_HK(0); SBAR(); } while (0)
    f32x16 pA0, pA1, pB0, pB1; float mnA, mnB, alA, alB; bf16x8 pa0, pa1, pa2, pa3;
    SWRITE_HV(0); SBAR();
    if (NT > 1) { const int RS_ = RS_OF(cur); SLOAD_H(Kh, Vh, KBASE(1)); }
    SBAR(); qkt<0, SK>(pA0, pA1, K_lds, r32, hi, S.qr, ACT(0));
    MASKT(pA0, pA1, 0); partialSM(pA0, pA1, m_reg, mnA, alA);
    if (NT > 1) { VMW(); SWRITE_H(1); }
    __syncthreads();
#define HALF_STEP(PX0, PX1, mnX, alX, PY0, PY1, alY, t, KB, VB, SB) do {                                                      \
        svc_top(sv, lds);                                                                                                     \
        SBAR(); qkt<KB, SK>(PX0, PX1, K_lds, r32, hi, S.qr, ACT(t));                                             \
        finishSM(PY0, PY1, alY, l_reg, pa0, pa1, pa2, pa3); SBAR();                                                           \
        if ((t) + 1 < NT) { const int RS_ = RS_OF(cur); SLOAD_H(Kh, Vh, KBASE((t) + 1)); } svc_dma(sv, lds); SBAR();                              \
        pv_tile<VB, SK>(o, vb0, pa0, pa1, pa2, pa3, ACT((t) - 1)); MASKT(PX0, PX1, (t)); partialSM(PX0, PX1, m_reg, mnX, alX);                                        \
        __syncthreads();                                                                                                      \
        if ((t) + 1 < NT) { VMWN(1); SWRITE_H(SB); }                                                                        \
        RESC(alX); __syncthreads(); } while (0)
    for (int t = 1; t + 1 < NT; t += 2) {
        HALF_STEP(pB0, pB1, mnB, alB, pA0, pA1, alA, t, 1, 0, 0);
        HALF_STEP(pA0, pA1, mnA, alA, pB0, pB1, alB, t + 1, 0, 1, 1);
    }
    const bool even = (NT & 1) == 0;
    if (even) { SBAR(); qkt<1, SK>(pB0, pB1, K_lds, r32, hi, S.qr, ACT(NT - 1)); SBAR(); }
    { const int RS_ = RS_OF(nxt); SLOAD_H(nxt.K, nxt.V, kbn); SBAR();
#pragma unroll
      for (int d0 = 0; d0 < 8; ++d0) S.qr[d0] = load8<bf16>(nxt.Q + (size_t)(unsigned)((wid * QBLK + r32) * RS_) + d0 * 16 + hi * 8); }
    SBAR();
    finishSM(pA0, pA1, alA, l_reg, pa0, pa1, pa2, pa3); SBAR();
    pv_tile<0, SK>(o, vb0, pa0, pa1, pa2, pa3, ACT(even ? NT - 2 : NT - 1));
    if (even) { MASKT(pB0, pB1, NT - 1); partialSM(pB0, pB1, m_reg, mnB, alB); __syncthreads(); RESC(alB);
        finishSM(pB0, pB1, alB, l_reg, pa0, pa1, pa2, pa3); SBAR(); pv_tile<1, SK>(o, vb0, pa0, pa1, pa2, pa3, ACT(NT - 1)); }
    SBAR(); SEAM_K0();
    if (hi == 0) li_l[r32] = l_reg; asm volatile("s_waitcnt lgkmcnt(0)" ::: "memory");
    if (cur.L != nullptr && hi == 0) cur.L[wid * QBLK + r32] = m_reg * SCALE + __logf(l_reg);
    float rli[16];
#pragma unroll
    for (int r = 0; r < 16; ++r) rli[r] = __builtin_amdgcn_rcpf(li_l[crow(r, hi)]);
    bf16* Ow = cur.O + (size_t)(wid * QBLK) * D;
#pragma unroll
    for (int r = 0; r < 16; ++r) { const int orow = crow(r, hi);
#pragma unroll
        for (int d0 = 0; d0 < 4; ++d0) { const float v = o[d0][r] * rli[r]; const float vn = __shfl_xor(v, 1);
            if ((r32 & 1) == 0) *(unsigned*)(Ow + (size_t)orow * D + d0 * 32 + r32) = cvtpk(v, vn); } }
    __syncthreads();
#undef RESC
#undef KBASE
#undef ACT
#undef MASKT
#undef SEAM_K0
#undef HALF_STEP
}
#undef ROW
#undef RS_OF
#undef VMW
#undef VMWN
#undef SLOAD_H
#undef SWRITE_HK
#undef SWRITE_HV
#undef SWRITE_H
#undef KSWZ
#undef SBAR
}
#define XB_TMO      128
#define XB_XCNT(j)  (256  + 64 * (j))
#define XB_XSUB(j)  (1280 + 64 * (j))
#define XB_XGEN(j)  (2304 + 64 * (j))
#define XB_TOP      3328
#define XB_TOPGEN   3392
#define XCD_BAR_WORDS 3456
#define XB_SPIN_CAP (1u << 18)
#define LAS __attribute__((address_space(3)))

__device__ __forceinline__ unsigned xb_ld(unsigned* p)              { return __hip_atomic_load(p, __ATOMIC_RELAXED, __HIP_MEMORY_SCOPE_AGENT); }
__device__ __forceinline__ unsigned xb_add(unsigned* p, unsigned v) { return __hip_atomic_fetch_add(p, v, __ATOMIC_RELAXED, __HIP_MEMORY_SCOPE_AGENT); }
__device__ __forceinline__ unsigned xb_xcc_id() { return (unsigned)__builtin_amdgcn_s_getreg((3 << 11) | 20) & 0xFu; }
#define XB_SPIN(cond, bar) do { unsigned _sp = 0; while (cond) { __builtin_amdgcn_s_sleep(1); \
    if ((++_sp & 255u) == 0u) { if (xb_ld(&(bar)[XB_TMO])) break; if (_sp > XB_SPIN_CAP) { atomicAdd(&(bar)[XB_TMO], 1u); break; } } } } while (0)

struct XcdBarrier {
    unsigned* bar; unsigned x;
    volatile LAS unsigned* st;
};

__device__ __forceinline__ XcdBarrier xcd_barrier_post(unsigned* bar, volatile LAS unsigned* st) {
    XcdBarrier b; b.bar = bar; b.x = xb_xcc_id(); b.st = st;
    if (threadIdx.x == 0) (void)xb_add(&bar[XB_XCNT(b.x)], 1u);
    return b;
}
__device__ __forceinline__ void xcd_barrier_complete(unsigned* bar, unsigned x, unsigned& nloc, unsigned& nx) {
    const unsigned G = gridDim.x * gridDim.y * gridDim.z;
    unsigned sum, cnt, mine, sp = 0u;
    for (;;) {
        sum = 0u; cnt = 0u; mine = 0u;
#pragma unroll
        for (unsigned j = 0; j < 16; ++j) { const unsigned c = xb_ld(&bar[XB_XCNT(j)]); sum += c; cnt += (c > 0u) ? 1u : 0u; mine = (j == x) ? c : mine; }
        if (sum == G) break;
        __builtin_amdgcn_s_sleep(1);
        if ((++sp & 255u) == 0u) { if (xb_ld(&bar[XB_TMO])) break; if (sp > XB_SPIN_CAP) { atomicAdd(&bar[XB_TMO], 1u); break; } }
    }
    nloc = mine > 0u ? mine : 1u; nx = cnt > 0u ? cnt : 1u;
}

__device__ __forceinline__ void xcd_barrier(const XcdBarrier& b) {
    asm volatile("s_waitcnt vmcnt(0)" ::: "memory");
    __syncthreads();
    if (threadIdx.x == 0) {
        unsigned* bar = b.bar;
        __builtin_amdgcn_s_waitcnt(0);
        unsigned nloc = b.st[0], nx = b.st[1];
        if (nloc == 0u) { xcd_barrier_complete(bar, b.x, nloc, nx); b.st[0] = nloc; b.st[1] = nx; }
        const unsigned old = xb_add(&bar[XB_XSUB(b.x)], 1u);
        const unsigned gen = old / nloc;
        if (old + 1u == (gen + 1u) * nloc) {
            __builtin_amdgcn_fence(__ATOMIC_RELEASE, "agent");
            asm volatile("s_waitcnt vmcnt(0)" ::: "memory");
            const unsigned og = xb_add(&bar[XB_TOP], 1u);
            const unsigned tg = og / nx;
            if (og + 1u == (tg + 1u) * nx) xb_add(&bar[XB_TOPGEN], 1u);
            else XB_SPIN(xb_ld(&bar[XB_TOPGEN]) == tg, bar);
            __builtin_amdgcn_fence(__ATOMIC_ACQUIRE, "agent");
            xb_add(&bar[XB_XGEN(b.x)], 1u);
            asm volatile("s_waitcnt vmcnt(0)" ::: "memory");
        } else {
            XB_SPIN(xb_ld(&bar[XB_XGEN(b.x)]) == gen, bar);
            __builtin_amdgcn_fence(__ATOMIC_ACQUIRE, "agent");
            asm volatile("s_waitcnt vmcnt(0)" ::: "memory");
        }
    }
    __syncthreads();
}
typedef unsigned short bf16_t;
typedef float f32x4 __attribute__((ext_vector_type(4)));
typedef float f32x2 __attribute__((ext_vector_type(2)));
typedef unsigned u32x4 __attribute__((ext_vector_type(4)));
typedef unsigned u32x2 __attribute__((ext_vector_type(2)));
typedef __bf16 bf16v2 __attribute__((ext_vector_type(2)));
#define LDS_WAIT() asm volatile("s_waitcnt lgkmcnt(0)" ::: "memory")

struct Args {
    const float* x; const float* c; const int* positions; const float* norm1_g; const float* norm2_g; const float* w_ada; const float* b_ada;
    const float* w_in; const float* lam_q1; const float* lam_k1; const float* lam_q2; const float* lam_k2; const float* diff_subln_g; const float* dil_out_g;
    const float* w_out; const float* peer_wq; const float* peer_subkeys; const float* peer_u; const float* peer_v; const float* final_g;
    float* out; unsigned char* ws; int ph_lo, ph_hi, flag, pad;
};

__device__ __forceinline__ unsigned cvt_pk(float lo, float hi) { unsigned r; asm volatile("v_cvt_pk_bf16_f32 %0, %1, %2" : "=v"(r) : "v"(lo), "v"(hi)); return r; }
__device__ __forceinline__ float bf_lo(unsigned u) { return __uint_as_float(u << 16); }
__device__ __forceinline__ float bf_hi(unsigned u) { return __uint_as_float(u & 0xffff0000u); }
__device__ __forceinline__ float dot2bf(unsigned a, unsigned b, float c) { return __builtin_amdgcn_fdot2_f32_bf16(__builtin_bit_cast(bf16v2, a), __builtin_bit_cast(bf16v2, b), c, false); }
__device__ __forceinline__ unsigned pk_fp8(const f32x4 v) { int r = __builtin_amdgcn_cvt_pk_fp8_f32(v.x, v.y, 0, false); r = __builtin_amdgcn_cvt_pk_fp8_f32(v.z, v.w, r, true); return (unsigned)r; }
__device__ __forceinline__ f32x4 ld4bf(const bf16_t* p) { const u32x2 w = *(const u32x2*)p; return (f32x4){bf_lo(w.x), bf_hi(w.x), bf_lo(w.y), bf_hi(w.y)}; }
__device__ __forceinline__ float wave_sum(float v) {
#pragma unroll
    for (int o = 1; o < 64; o <<= 1) v += __shfl_xor(v, o);
    return v;
}
__device__ __forceinline__ float half_sum(float v) {
#pragma unroll
    for (int o = 1; o < 32; o <<= 1) v += __shfl_xor(v, o);
    return v;
}

#ifdef PROBE_FLAGS
#define P0SEL(b) (!(A.flag & 0xf00) || (A.flag & (0x100 << (b))))
#else
#define P0SEL(b) true
#endif
__device__ __forceinline__ void p0_gemv_unit(const Args& A, float* mod, LAS float* red, int unit, int tid) {
    LAS float* sc = red + 2048;
    for (int i = tid; i < DM; i += 512) { const float cv = A.c[i]; sc[i] = cv / (1.0f + __expf(-cv)); }
    __syncthreads();
    const int rl = tid / 24, c4 = tid - rl * 24;
    if (tid < 384) {
        const float* wp = A.w_ada + (size_t)rl * NADA + unit * 96 + c4 * 4;
        const LAS float* cp = sc + rl;
        f32x4 acc = {0.f, 0.f, 0.f, 0.f};
        f32x4 w0[8], w1[8];
#pragma unroll
        for (int i = 0; i < 8; ++i) w0[i] = *(const f32x4*)(wp + (size_t)(16 * i) * NADA);
        for (int k0 = 0; k0 < DM; k0 += 256) {
#pragma unroll
            for (int i = 0; i < 8; ++i) w1[i] = *(const f32x4*)(wp + (size_t)(k0 + 128 + 16 * i) * NADA);
#pragma unroll
            for (int i = 0; i < 8; ++i) acc += cp[k0 + 16 * i] * w0[i];
            if (k0 + 256 < DM) {
#pragma unroll
                for (int i = 0; i < 8; ++i) w0[i] = *(const f32x4*)(wp + (size_t)(k0 + 256 + 16 * i) * NADA);
            }
#pragma unroll
            for (int i = 0; i < 8; ++i) acc += cp[k0 + 128 + 16 * i] * w1[i];
        }
        *(LAS f32x4*)(red + rl * 96 + c4 * 4) = acc;
    }
    __syncthreads();
    if (tid < 96) { float s = 0.f;
#pragma unroll
        for (int r = 0; r < 16; ++r) s += red[r * 96 + tid];
        mod[unit * 96 + tid] = s + A.b_ada[unit * 96 + tid]; }
    __syncthreads();
}
__device__ __forceinline__ void p0_tr_load(const float* W, int N, int item, int lane, f32x4 (&ld)[8]) {
    const int nblk = N / 32, kb = item / nblk, nb = item - kb * nblk;
    const float* p = W + (size_t)(64 * kb + (lane >> 3)) * N + 32 * nb + 4 * (lane & 7);
#pragma unroll
    for (int i = 0; i < 8; ++i) ld[i] = *(const f32x4*)(p + (size_t)(8 * i) * N);
}
template <bool F8>
__device__ __forceinline__ void p0_tr_store(const f32x4 (&ld)[8], int K, int N, bf16_t* WT, LAS float* scr, int item, int lane) {
    const int nblk = N / 32, kb = item / nblk, nb = item - kb * nblk, k0 = 64 * kb, n0 = 32 * nb;
#pragma unroll
    for (int i = 0; i < 8; ++i) { LAS float* d = scr + (8 * i + (lane >> 3)) * 33 + 4 * (lane & 7); d[0] = ld[i].x; d[1] = ld[i].y; d[2] = ld[i].z; d[3] = ld[i].w; }
    LDS_WAIT(); asm volatile("" ::: "memory");
    const int c = lane & 7;
#pragma unroll
    for (int j = 0; j < 4; ++j) { const int n = (lane >> 3) + 8 * j; const LAS float* s = scr + (8 * c) * 33 + n;
        if (F8) { u32x2 o8; o8.x = pk_fp8((f32x4){s[0 * 33], s[1 * 33], s[2 * 33], s[3 * 33]} * 1024.0f); o8.y = pk_fp8((f32x4){s[4 * 33], s[5 * 33], s[6 * 33], s[7 * 33]} * 1024.0f);
            *(u32x2*)((unsigned char*)WT + (size_t)(n0 + n) * K + k0 + 8 * c) = o8; }
        else { u32x4 o; o.x = cvt_pk(s[0 * 33], s[1 * 33]); o.y = cvt_pk(s[2 * 33], s[3 * 33]); o.z = cvt_pk(s[4 * 33], s[5 * 33]); o.w = cvt_pk(s[6 * 33], s[7 * 33]);
            *(u32x4*)(WT + (size_t)(n0 + n) * K + k0 + 8 * c) = o; } }
    LDS_WAIT(); asm volatile("" ::: "memory");
}
typedef __bf16 bf16v8_t __attribute__((ext_vector_type(8))); typedef float f32x8_t __attribute__((ext_vector_type(8)));
__device__ __forceinline__ pg8::bf16x8 pack8f(const f32x4 a, const f32x4 b) { const f32x8_t v = {a.x, a.y, a.z, a.w, b.x, b.y, b.z, b.w}; return __builtin_bit_cast(pg8::bf16x8, __builtin_convertvector(v, bf16v8_t)); }
__device__ __forceinline__ void p0_fold_item(const Args& A, bf16_t* wsc, int item, int lane) {
    const int g = item >> 7, d0 = (item & 127) * 32, r = lane & 15, kg = lane >> 4;
    pg8::bf16x8 af[2][4];
#pragma unroll
    for (int mt = 0; mt < 2; ++mt)
#pragma unroll
        for (int ks = 0; ks < 4; ++ks) { const float* p = A.peer_wq + (size_t)(d0 + 16 * mt + r) * 2048 + g * 128 + 32 * ks + 8 * kg; af[mt][ks] = pack8f(*(const f32x4*)p, *(const f32x4*)(p + 4)); }
    const float* skp = A.peer_subkeys + (size_t)g * 16384 + 8 * kg;
#pragma unroll 2
    for (int nt = 0; nt < 8; ++nt) {
        pg8::bf16x8 bfr[4];
#pragma unroll
        for (int ks = 0; ks < 4; ++ks) { const float* p = skp + (size_t)(16 * nt + r) * 128 + 32 * ks; bfr[ks] = pack8f(*(const f32x4*)p, *(const f32x4*)(p + 4)); }
#pragma unroll
        for (int mt = 0; mt < 2; ++mt) {
            f32x4 c = {0.f, 0.f, 0.f, 0.f};
#pragma unroll
            for (int ks = 0; ks < 4; ++ks) c = __builtin_amdgcn_mfma_f32_16x16x32_bf16(af[mt][ks], bfr[ks], c, 0, 0, 0);
            typedef __bf16 bf16v4_t __attribute__((ext_vector_type(4)));
            const u32x2 w = __builtin_bit_cast(u32x2, __builtin_convertvector(c, bf16v4_t));
            *(u32x2*)(wsc + (size_t)(g * 128 + 16 * nt + r) * DM + d0 + 16 * mt + 4 * kg) = w;
        }
    }
}
__device__ __forceinline__ void p0_cv_load(const Args& A, int item, int lane, f32x4 (&lu)[4], f32x4 (&lv)[4]) {
    const int eb = item >> 5, s = item & 31;
    const size_t off = (size_t)(eb * 8 + (lane >> 3)) * DM + s * 128 + 16 * (lane & 7);
#pragma unroll
    for (int i = 0; i < 4; ++i) { lu[i] = *(const f32x4*)(A.peer_u + off + 4 * i); lv[i] = *(const f32x4*)(A.peer_v + off + 4 * i); }
}
__device__ __forceinline__ void p0_cv_store(unsigned char* ws, int item, int lane, const f32x4 (&lu)[4], const f32x4 (&lv)[4]) {
    const int eb = item >> 5, s = item & 31;
    const size_t dst = ((size_t)s * NEXP + (size_t)eb * 8) * 8 + lane;
    u32x4 o, p;
    o.x = pk_fp8(lu[0] * 256.0f); o.y = pk_fp8(lu[1] * 256.0f); o.z = pk_fp8(lu[2] * 256.0f); o.w = pk_fp8(lu[3] * 256.0f);
    p.x = pk_fp8(lv[0] * 16.0f); p.y = pk_fp8(lv[1] * 16.0f); p.z = pk_fp8(lv[2] * 16.0f); p.w = pk_fp8(lv[3] * 16.0f);
    ((u32x4*)(ws + WS_UB))[dst] = o; ((u32x4*)(ws + WS_VB))[dst] = p;
}
__device__ __forceinline__ void p0_fold_item_old(const Args& A, bf16_t* wsc, LAS float* lds, int item, int tid) {
    const int g = item >> 6, d0 = (item & 63) * 64;
    LAS float* SK = lds;
    LAS float* WQ = lds + 128 * 132;
    const float* skp = A.peer_subkeys + (size_t)g * 16384;
    for (int i = tid; i < 128 * 32; i += 512) { const int n = i >> 5, k4 = i & 31; *(LAS f32x4*)(SK + n * 132 + 4 * k4) = *(const f32x4*)(skp + n * 128 + 4 * k4); }
    for (int i = tid; i < 64 * 32; i += 512) { const int d = i >> 5, k4 = i & 31; *(LAS f32x4*)(WQ + d * 132 + 4 * k4) = *(const f32x4*)(A.peer_wq + (size_t)(d0 + d) * 2048 + g * 128 + 4 * k4); }
    __syncthreads();
    const int n = tid & 127, dg = tid >> 7;
    float acc[16];
#pragma unroll
    for (int j = 0; j < 16; ++j) acc[j] = 0.f;
    for (int k4 = 0; k4 < 32; ++k4) {
        const f32x4 a = *(const LAS f32x4*)(SK + n * 132 + 4 * k4);
#pragma unroll
        for (int j = 0; j < 16; ++j) { const f32x4 b = *(const LAS f32x4*)(WQ + (dg * 16 + j) * 132 + 4 * k4); acc[j] += a.x * b.x + a.y * b.y + a.z * b.z + a.w * b.w; }
    }
    u32x4 o0, o1;
    o0.x = cvt_pk(acc[0], acc[1]); o0.y = cvt_pk(acc[2], acc[3]); o0.z = cvt_pk(acc[4], acc[5]); o0.w = cvt_pk(acc[6], acc[7]);
    o1.x = cvt_pk(acc[8], acc[9]); o1.y = cvt_pk(acc[10], acc[11]); o1.z = cvt_pk(acc[12], acc[13]); o1.w = cvt_pk(acc[14], acc[15]);
    bf16_t* op = wsc + (size_t)(g * 128 + n) * DM + d0 + dg * 16;
    *(u32x4*)op = o0; *(u32x4*)(op + 8) = o1;
    __syncthreads();
}
__device__ __forceinline__ void p0_prologue(const Args& A, LAS unsigned char* lds, int G, int bid, int tid) {
    const int lane = tid & 63, wave = __builtin_amdgcn_readfirstlane(tid >> 6);
    unsigned char* ws = A.ws;
    float* mod = (float*)(ws + WS_MOD);
    const int gw = bid * 8 + wave, NGW = G * 8;
    if (P0SEL(0)) for (int u = bid; u < NADA / 96; u += G) p0_gemv_unit(A, mod, (LAS float*)lds, u, tid);
    if (bid == G - 1 && wave == 0) {
        float a = 0.f, b = 0.f;
        for (int i = lane; i < 128; i += 64) { a += A.lam_q1[i] * A.lam_k1[i]; b += A.lam_q2[i] * A.lam_k2[i]; }
        a = wave_sum(a); b = wave_sum(b);
        if (lane == 0) *(float*)(ws + WS_LAM) = expf(a) - expf(b) + LAM_INIT;
    }
    {
        float* rope = (float*)(ws + WS_ROPE);
        for (int i = bid * 512 + tid; i < S * 16; i += G * 512) {
            const int s = i >> 4, f = i & 15;
            const float inv = powf(500000.0f, -(float)(2 * f) / 32.0f);
            const float ang = (float)A.positions[s] * inv;
            double rev = (double)ang * 0.15915494309189535; rev -= rint(rev);
            const float fr = (float)rev;
            rope[s * 32 + f] = __builtin_amdgcn_cosf(fr);
            rope[s * 32 + 16 + f] = __builtin_amdgcn_sinf(fr);
        }
    }
    if (P0SEL(1)) {
        LAS float* scr = (LAS float*)(lds + wave * 16384);
        constexpr int I_IN = (DM / 64) * (NIN / 32), I_OUT = (DM / 64) * (DM / 32);
        bf16_t* win = (bf16_t*)(ws + WS_WIN); bf16_t* wout = (bf16_t*)(ws + WS_WOUT);
        f32x4 cur[8], nxt[8];
        int it = gw;
        if (it < I_IN + I_OUT) { if (it < I_IN) p0_tr_load(A.w_in, NIN, it, lane, cur); else p0_tr_load(A.w_out, DM, it - I_IN, lane, cur); }
        for (; it < I_IN + I_OUT; it += NGW) {
            const int itn = it + NGW;
            if (itn < I_IN + I_OUT) { if (itn < I_IN) p0_tr_load(A.w_in, NIN, itn, lane, nxt); else p0_tr_load(A.w_out, DM, itn - I_IN, lane, nxt); }
            if (it < I_IN) { const int T_ = ((it % (NIN / 32)) * 32) >> 11;
                if (T_ == 2 || T_ == 5) p0_tr_store<true>(cur, DM, NIN, (bf16_t*)((unsigned char*)win + WIN8_OFF + ((ptrdiff_t)(T_ == 2 ? -4096 : -8192)) * DM), scr, it, lane);
                else p0_tr_store<false>(cur, DM, NIN, win + ((ptrdiff_t)(T_ > 2 ? -2048 : 0)) * DM, scr, it, lane); }
            else p0_tr_store<true>(cur, DM, DM, wout, scr, it - I_IN, lane);
#pragma unroll
            for (int i = 0; i < 8; ++i) cur[i] = nxt[i];
        }
    }
#ifdef OLD_FOLD
    __syncthreads();
    if (P0SEL(2)) for (int it = bid; it < 16 * 64; it += G) p0_fold_item_old(A, (bf16_t*)(ws + WS_WSC), (LAS float*)lds, it, tid);
#else
    if (P0SEL(2)) for (int it = gw; it < 16 * 128; it += NGW) p0_fold_item(A, (bf16_t*)(ws + WS_WSC), it, lane);
#endif
    if (false) {
        constexpr int NIT = (NEXP / 8) * 32;
        f32x4 cu[4], cv[4], nu[4], nv[4];
        int it = gw;
        if (it < NIT) p0_cv_load(A, it, lane, cu, cv);
        for (; it < NIT; it += NGW) {
            const int itn = it + NGW;
            if (itn < NIT) p0_cv_load(A, itn, lane, nu, nv);
            p0_cv_store(ws, it, lane, cu, cv);
#pragma unroll
            for (int i = 0; i < 4; ++i) { cu[i] = nu[i]; cv[i] = nv[i]; }
        }
    }
    __syncthreads();
}

template <bool INBF, bool F8OUT>
__device__ __forceinline__ void row_modulate(const void* xin_, const float* g, const float* sh, const float* sc, bf16_t* out, unsigned char* out8, LAS float* lv, int tid, int gw, int ngw, int lane) {
    if constexpr (INBF && !F8OUT) {
        u32x4 raw[4][8];
#pragma unroll
        for (int k = 0; k < 4; ++k) { const int r = gw + k * ngw; if (r < S) {
#pragma unroll
            for (int j = 0; j < 8; ++j) raw[k][j] = *(const u32x4*)((const bf16_t*)xin_ + (size_t)r * DM + 8 * lane + 512 * j); } }
    for (int i = tid; i < DM / 4; i += 512) { const f32x4 gv = ((const f32x4*)g)[i], sv = ((const f32x4*)sc)[i]; ((LAS f32x4*)lv)[i] = gv * (1.0f + sv); ((LAS f32x4*)(lv + DM))[i] = ((const f32x4*)sh)[i]; }
    __syncthreads();
#pragma unroll
        for (int k = 0; k < 4; ++k) { const int r = gw + k * ngw; if (r < S) {
            f32x4 v[16]; float ss = 0.f;
#pragma unroll
            for (int j = 0; j < 8; ++j) { const u32x4 w = raw[k][j];
                v[2 * j] = (f32x4){bf_lo(w.x), bf_hi(w.x), bf_lo(w.y), bf_hi(w.y)}; v[2 * j + 1] = (f32x4){bf_lo(w.z), bf_hi(w.z), bf_lo(w.w), bf_hi(w.w)}; }
#pragma unroll
            for (int j = 0; j < 16; ++j) ss += (v[j].x * v[j].x + v[j].y * v[j].y) + (v[j].z * v[j].z + v[j].w * v[j].w);
            ss = wave_sum(ss);
            const float rstd = 1.0f / sqrtf(ss * (1.0f / DM) + NORM_EPS);
            bf16_t* orow = out + (size_t)r * DM + 8 * lane;
#pragma unroll
            for (int j = 0; j < 8; ++j) { const int c = 8 * lane + 512 * j;
                const f32x4 a0 = *(const LAS f32x4*)(lv + c), a1 = *(const LAS f32x4*)(lv + c + 4), h0 = *(const LAS f32x4*)(lv + DM + c), h1 = *(const LAS f32x4*)(lv + DM + c + 4);
                const f32x4 y0 = v[2 * j] * rstd * a0 + h0, y1 = v[2 * j + 1] * rstd * a1 + h1;
                u32x4 w; w.x = cvt_pk(y0.x, y0.y); w.y = cvt_pk(y0.z, y0.w); w.z = cvt_pk(y1.x, y1.y); w.w = cvt_pk(y1.z, y1.w);
                *(u32x4*)(orow + 512 * j) = w;
                if ((j & 3) == 3) __builtin_amdgcn_sched_barrier(0); }
        } }
        __syncthreads();
        if (4 * ngw >= S) return;
    } else {
    for (int i = tid; i < DM / 4; i += 512) { const f32x4 gv = ((const f32x4*)g)[i], sv = ((const f32x4*)sc)[i]; ((LAS f32x4*)lv)[i] = gv * (1.0f + sv); ((LAS f32x4*)(lv + DM))[i] = ((const f32x4*)sh)[i]; }
    __syncthreads();
    }
    for (int r = (INBF && !F8OUT) ? gw + 4 * ngw : gw; r < S; r += ngw) {
        f32x4 v[16]; float ss = 0.f;
        if (INBF) { const bf16_t* xr = (const bf16_t*)xin_ + (size_t)r * DM + 8 * lane;
#pragma unroll
            for (int j = 0; j < 8; ++j) { const u32x4 w = *(const u32x4*)(xr + 512 * j);
                v[2 * j] = (f32x4){bf_lo(w.x), bf_hi(w.x), bf_lo(w.y), bf_hi(w.y)}; v[2 * j + 1] = (f32x4){bf_lo(w.z), bf_hi(w.z), bf_lo(w.w), bf_hi(w.w)}; }
        } else { const float* xr = (const float*)xin_ + (size_t)r * DM + 8 * lane;
#pragma unroll
            for (int j = 0; j < 8; ++j) { v[2 * j] = *(const f32x4*)(xr + 512 * j); v[2 * j + 1] = *(const f32x4*)(xr + 512 * j + 4); }
        }
#pragma unroll
        for (int j = 0; j < 16; ++j) ss += (v[j].x * v[j].x + v[j].y * v[j].y) + (v[j].z * v[j].z + v[j].w * v[j].w);
        ss = wave_sum(ss);
        const float rstd = 1.0f / sqrtf(ss * (1.0f / DM) + NORM_EPS);
        bf16_t* orow = out + (size_t)r * DM + 8 * lane;
#pragma unroll
        for (int j = 0; j < 8; ++j) { const int c = 8 * lane + 512 * j;
            const f32x4 a0 = *(const LAS f32x4*)(lv + c), a1 = *(const LAS f32x4*)(lv + c + 4), h0 = *(const LAS f32x4*)(lv + DM + c), h1 = *(const LAS f32x4*)(lv + DM + c + 4);
            const f32x4 y0 = v[2 * j] * rstd * a0 + h0, y1 = v[2 * j + 1] * rstd * a1 + h1;
            u32x4 w; w.x = cvt_pk(y0.x, y0.y); w.y = cvt_pk(y0.z, y0.w); w.z = cvt_pk(y1.x, y1.y); w.w = cvt_pk(y1.z, y1.w);
            *(u32x4*)(orow + 512 * j) = w;
            if (F8OUT) { u32x2 w8; w8.x = pk_fp8(y0 * 16.0f); w8.y = pk_fp8(y1 * 16.0f); *(u32x2*)(out8 + (size_t)r * DM + c) = w8; }
            if ((j & 3) == 3) __builtin_amdgcn_sched_barrier(0); }
    }
    __syncthreads();
}

struct EpiQKV {
    static constexpr bool PERM = true, AFTER_DRAIN = false;
    bf16_t* qkv; bf16_t* qkv2; const float* rope; int skip;
    __device__ __forceinline__ void operator()(const pg8::f32x4 (&acc)[2][2][4][2], const pg8::Unit& u, int wr, int wc, int fr, int fq) const {
        if (skip) return;
        const int tt_ = u.pn >> 3, T = tt_ + (tt_ >= 2 ? 1 : 0), hh0 = 2 * (u.pn & 7);
        const bool rot = (wc == 0);
        const int d0 = wc * 32 + 8 * fq;
        const float sgn = (fq < 2) ? -1.0f : 1.0f;
        bf16_t* base = qkv + (size_t)T * QKV_T + d0;
        const int rowb = u.pm * 256 + wr * 64 + fr;
        f32x4 cs0 = {1.f, 1.f, 1.f, 1.f}, cs1 = cs0, sn0 = {0.f, 0.f, 0.f, 0.f}, sn1 = sn0, ncs0 = cs0, ncs1 = cs0, nsn0 = sn0, nsn1 = sn0;
        if (rot) { const float* rp = rope + (size_t)rowb * 32 + 8 * (fq & 1);
            cs0 = *(const f32x4*)rp; cs1 = *(const f32x4*)(rp + 4); sn0 = *(const f32x4*)(rp + 16); sn1 = *(const f32x4*)(rp + 20); }
#pragma unroll
        for (int gi = 0; gi < 8; ++gi) {
            const int ai = gi >> 2, m = gi & 3;
            const int row = rowb + ai * 128 + m * 16;
            if (rot && gi < 7) { const int nrow = rowb + ((gi + 1) >> 2) * 128 + ((gi + 1) & 3) * 16; const float* rp = rope + (size_t)nrow * 32 + 8 * (fq & 1);
                ncs0 = *(const f32x4*)rp; ncs1 = *(const f32x4*)(rp + 4); nsn0 = *(const f32x4*)(rp + 16); nsn1 = *(const f32x4*)(rp + 20); }
#pragma unroll
            for (int bj = 0; bj < 2; ++bj) {
                f32x4 v0 = acc[ai][bj][m][0], v1 = acc[ai][bj][m][1];
                if (rot) {
                    f32x4 o0, o1;
                    o0.x = __shfl_xor(v0.x, 32); o0.y = __shfl_xor(v0.y, 32); o0.z = __shfl_xor(v0.z, 32); o0.w = __shfl_xor(v0.w, 32);
                    o1.x = __shfl_xor(v1.x, 32); o1.y = __shfl_xor(v1.y, 32); o1.z = __shfl_xor(v1.z, 32); o1.w = __shfl_xor(v1.w, 32);
                    v0 = v0 * cs0 + sgn * o0 * sn0; v1 = v1 * cs1 + sgn * o1 * sn1;
                }
                u32x4 w; w.x = cvt_pk(v0[0], v0[1]); w.y = cvt_pk(v0[2], v0[3]); w.z = cvt_pk(v1[0], v1[1]); w.w = cvt_pk(v1[2], v1[3]);
                *(u32x4*)(base + ((size_t)(hh0 + bj) * S + row) * 128) = w;
            }
            cs0 = ncs0; cs1 = ncs1; sn0 = nsn0; sn1 = nsn1;
        }
    }
};
struct EpiSV {
    static constexpr bool PERM = true, AFTER_DRAIN = false;
    bf16_t* qkv; bf16_t* qkv2;
    __device__ __forceinline__ void operator()(const pg8::f32x4 (&acc)[2][2][4][2], const pg8::Unit& u, int wr, int wc, int fr, int fq) const {
        const bool dil = (u.pn >> 3) != 0; const int T = dil ? 5 : 2;
        const int hh0 = 2 * (u.pn & 7), d0 = wc * 32 + 8 * fq, rowb = u.pm * 256 + wr * 64 + fr;
        bf16_t* base = qkv + (size_t)T * QKV_T + d0;
#pragma unroll
        for (int gi = 0; gi < 8; ++gi) { const int ai = gi >> 2, m = gi & 3, row = rowb + ai * 128 + m * 16;
#pragma unroll
            for (int bj = 0; bj < 2; ++bj) {
                const f32x4 v0 = acc[ai][bj][m][0] * (1.0f / 16384.0f), v1 = acc[ai][bj][m][1] * (1.0f / 16384.0f);
                u32x4 w; w.x = cvt_pk(v0[0], v0[1]); w.y = cvt_pk(v0[2], v0[3]); w.z = cvt_pk(v1[0], v1[1]); w.w = cvt_pk(v1[2], v1[3]);
                *(u32x4*)(base + ((size_t)(hh0 + bj) * S + row) * 128) = w;
            } }
    }
};
struct EpiResid {
    static constexpr bool PERM = true, AFTER_DRAIN = false;
    const float* x; const float* gate; bf16_t* out;
    __device__ __forceinline__ void operator()(const pg8::f32x4 (&acc)[2][2][4][2], const pg8::Unit& u, int wr, int wc, int fr, int fq) const {
        const int row0 = u.pm * 256 + wr * 64 + fr, col0 = u.pn * 256 + wc * 32 + 8 * fq;
        f32x4 gv[2][2];
#pragma unroll
        for (int bj = 0; bj < 2; ++bj)
#pragma unroll
            for (int n = 0; n < 2; ++n) gv[bj][n] = *(const f32x4*)(gate + col0 + bj * 128 + n * 4) * (1.0f / 16384.0f);
        f32x4 xq[2][2][2];
#define ER_LOAD(slot, gi_) do { const size_t o_ = (size_t)(row0 + ((gi_) >> 2) * 128 + ((gi_) & 3) * 16) * DM + col0; \
            _Pragma("unroll") for (int bj = 0; bj < 2; ++bj) { xq[slot][bj][0] = *(const f32x4*)(x + o_ + bj * 128); xq[slot][bj][1] = *(const f32x4*)(x + o_ + bj * 128 + 4); } } while (0)
        ER_LOAD(0, 0); ER_LOAD(1, 1);
#pragma unroll
        for (int gi = 0; gi < 8; ++gi) { const int ai = gi >> 2, m = gi & 3;
            const size_t off = (size_t)(row0 + ai * 128 + m * 16) * DM + col0;
            f32x4 xc[2][2];
#pragma unroll
            for (int bj = 0; bj < 2; ++bj) { xc[bj][0] = xq[gi % 2][bj][0]; xc[bj][1] = xq[gi % 2][bj][1]; }
            if (gi + 2 < 8) ER_LOAD(gi % 2, gi + 2);
#pragma unroll
            for (int bj = 0; bj < 2; ++bj) {
#ifdef DBG_NO_MIXER
                const f32x4 r0 = xc[bj][0], r1 = xc[bj][1];
#else
                const f32x4 r0 = xc[bj][0] + gv[bj][0] * acc[ai][bj][m][0], r1 = xc[bj][1] + gv[bj][1] * acc[ai][bj][m][1];
#endif
                u32x4 w; w.x = cvt_pk(r0[0], r0[1]); w.y = cvt_pk(r0[2], r0[3]); w.z = cvt_pk(r1[0], r1[1]); w.w = cvt_pk(r1[2], r1[3]);
                *(u32x4*)(out + off + bj * 128) = w;
            }
            __builtin_amdgcn_sched_barrier(0);
        }
#undef ER_LOAD
    }
};

struct AttIt { int kind, L, pass; };
__device__ __forceinline__ at::BlockRef att_ref(const AttIt& it, unsigned char* ws, bool remap) {
    const bf16_t* qkv = (const bf16_t*)(ws + WS_QKV);
    at::BlockRef r;
    if (it.kind == 0) {
        const int b_ = it.L & 255, L_ = remap ? ((((it.L >> 8) * 16 + 2 * (b_ & 7) + (b_ >> 7)) << 4) + ((b_ >> 3) & 15)) : it.L;
        const int vp = L_ >> 4, x = L_ & 15, qb = it.pass ? x : 31 - x;
        const int h = vp >> 2, s = (vp >> 1) & 1, hf = vp & 1;
        const size_t hq = (size_t)(2 * h + s) * S * 128, hv = (size_t)(2 * h + hf) * S * 128;
        r.Q = qkv + 0 * QKV_T + hq + (size_t)qb * 256 * 128; r.K = qkv + 1 * QKV_T + hq; r.V = qkv + 2 * QKV_T + hv;
        r.O = (bf16_t*)(ws + WS_OD) + ((size_t)vp * S + (size_t)qb * 256) * 128; r.L = nullptr;
        r.P0 = qb * 256; r.W = S; r.skv = S; r.rs = 128;
    } else {
        const int b_ = it.L & 255, j_ = it.L >> 8;
        const int g = remap ? (j_ % 3) : (it.L >> 9), h = remap ? (2 * (b_ & 7) + (j_ >= 3 ? 1 : 0)) : ((it.L & 511) >> 5), blk = remap ? (((b_ >> 3) + ((0x524011 >> (4 * j_)) & 15)) & 31) : (it.L & 31);
        const int dil = (g == 0) ? 1 : (g == 1 ? 4 : 16), bpr = 32 / dil, res = blk / bpr, qb = blk % bpr;
        const bf16_t* tb = qkv + 3 * QKV_T;
        const size_t hb = ((size_t)h * S + (size_t)res * (S / dil)) * 128, hn = ((size_t)h * S + (size_t)res) * 128;
        r.skv = S / dil; r.P0 = qb * 256; r.W = 129; r.rs = 128 * dil;
        r.Q = tb + 0 * QKV_T + hn + (size_t)qb * 256 * 128 * dil; r.K = tb + 1 * QKV_T + hn; r.V = tb + 2 * QKV_T + hn;
        r.O = (bf16_t*)(ws + WS_OS) + ((size_t)(g * 16 + h) * S + (size_t)res * (S / dil) + (size_t)qb * 256) * 128;
        r.L = (float*)(ws + WS_LSE) + (size_t)(g * 16 + h) * S + (size_t)res * (S / dil) + (size_t)qb * 256;
    }
    return r;
}
__device__ __forceinline__ AttIt att_next(const AttIt& it, int G, int bid) {
    AttIt n = it;
    if (it.kind == 0) {
        if (it.pass == 0) { n.pass = 1; return n; }
        n.pass = 0; n.L = it.L + G;
        if (n.L < 512) return n;
        n.kind = 1; n.L = bid; if (n.L >= 1536) n.kind = 2;
        return n;
    }
    n.L = it.L + G; if (n.L >= 1536) n.kind = 2;
    return n;
}
__device__ __forceinline__ void attn_phase(const Args& A, char* lds, int G, int bid) {
    AttIt it; it.kind = 0; it.L = bid; it.pass = 0;
    if (it.L >= 512) { it.kind = 1; it.L = bid; if (it.L >= 1536) it.kind = 2; }
    const bool remap = (G == 256);
    at::Svc sv; sv.tu = A.peer_u; sv.tv = A.peer_v; sv.du = A.ws + WS_UB; sv.dv = A.ws + WS_VB; sv.next = 0; sv.p_old = -1; sv.p_new = -1; sv.par = 0; sv.G = G; sv.bid = bid;
    if (it.kind != 2) {
        at::BlockRef cur = att_ref(it, A.ws, remap);
        at::Seam Sm;
        at::causal_swa_prime(cur, lds, Sm);
        while (it.kind != 2) {
            const AttIt itn = att_next(it, G, bid);
            const at::BlockRef nxt = (itn.kind == 2) ? cur : att_ref(itn, A.ws, remap);
            at::causal_swa_block<false>(cur, nxt, lds, Sm, sv);
            cur = nxt; it = itn;
        }
    }
    while (at::svc_busy(sv)) { asm volatile("s_waitcnt vmcnt(0)" ::: "memory"); at::svc_top(sv, lds); at::svc_dma(sv, lds); }
    asm volatile("s_waitcnt vmcnt(0)" ::: "memory");
}

__device__ __forceinline__ void ld16bf(const bf16_t* p, f32x4 (&o)[4]) { const u32x4 a = *(const u32x4*)p, b = *(const u32x4*)(p + 8);
    o[0] = (f32x4){bf_lo(a.x), bf_hi(a.x), bf_lo(a.y), bf_hi(a.y)}; o[1] = (f32x4){bf_lo(a.z), bf_hi(a.z), bf_lo(a.w), bf_hi(a.w)};
    o[2] = (f32x4){bf_lo(b.x), bf_hi(b.x), bf_lo(b.y), bf_hi(b.y)}; o[3] = (f32x4){bf_lo(b.z), bf_hi(b.z), bf_lo(b.w), bf_hi(b.w)}; }
__device__ __forceinline__ float sq16(const f32x4 (&v)[4]) { float s = 0.f;
#pragma unroll
    for (int i = 0; i < 4; ++i) s += (v[i].x * v[i].x + v[i].y * v[i].y) + (v[i].z * v[i].z + v[i].w * v[i].w);
    return s; }
__device__ __forceinline__ void combine_phase(const Args& A, int gw, int ngw, int lane) {
    unsigned char* ws = A.ws;
    const float lam = *(const float*)(ws + WS_LAM);
    const bf16_t* OD = (const bf16_t*)(ws + WS_OD); const bf16_t* OS = (const bf16_t*)(ws + WS_OS); const float* LSE = (const float*)(ws + WS_LSE);
    unsigned char* Y = (unsigned char*)(ws + WS_Y);
    for (int t = gw; t < S; t += ngw) {
#pragma unroll
        for (int hq = 0; hq < 2; ++hq) {
            const int h = 4 * hq + (lane >> 4), e0 = 16 * (lane & 15), hf = e0 >> 7, d0 = e0 & 127;
            f32x4 a[4], b[4], v[4];
            ld16bf(OD + ((size_t)(h * 4 + 0 + hf) * S + t) * 128 + d0, a); ld16bf(OD + ((size_t)(h * 4 + 2 + hf) * S + t) * 128 + d0, b);
#pragma unroll
            for (int i = 0; i < 4; ++i) v[i] = a[i] - lam * b[i];
            float ss = sq16(v);
            ss += __shfl_xor(ss, 1); ss += __shfl_xor(ss, 2); ss += __shfl_xor(ss, 4); ss += __shfl_xor(ss, 8);
            const float rstd = 16.0f * (1.0f - LAM_INIT) / sqrtf(ss * (1.0f / 256.0f) + NORM_EPS);
            u32x4 w;
            w.x = pk_fp8(v[0] * rstd * *(const f32x4*)(A.diff_subln_g + e0)); w.y = pk_fp8(v[1] * rstd * *(const f32x4*)(A.diff_subln_g + e0 + 4));
            w.z = pk_fp8(v[2] * rstd * *(const f32x4*)(A.diff_subln_g + e0 + 8)); w.w = pk_fp8(v[3] * rstd * *(const f32x4*)(A.diff_subln_g + e0 + 12));
            *(u32x4*)(Y + (size_t)t * DM + h * 256 + e0) = w;
        }
        const int r1 = (t & 3) * (S / 4) + (t >> 2), r2 = (t & 15) * (S / 16) + (t >> 4);
#pragma unroll
        for (int hq = 0; hq < 2; ++hq) {
            const int h = 8 * hq + (lane >> 3), d0 = 16 * (lane & 7);
            const float l0 = LSE[(size_t)(0 * 16 + h) * S + t], l1 = LSE[(size_t)(1 * 16 + h) * S + r1], l2 = LSE[(size_t)(2 * 16 + h) * S + r2];
            const float mx = fmaxf(l0, fmaxf(l1, l2));
            const float e0 = __expf(l0 - mx), e1 = __expf(l1 - mx), e2 = __expf(l2 - mx), inv = 1.0f / (e0 + e1 + e2);
            f32x4 o0[4], o1[4], o2[4], v[4];
            ld16bf(OS + ((size_t)(0 * 16 + h) * S + t) * 128 + d0, o0); ld16bf(OS + ((size_t)(1 * 16 + h) * S + r1) * 128 + d0, o1); ld16bf(OS + ((size_t)(2 * 16 + h) * S + r2) * 128 + d0, o2);
#pragma unroll
            for (int i = 0; i < 4; ++i) v[i] = (e0 * inv) * o0[i] + (e1 * inv) * o1[i] + (e2 * inv) * o2[i];
            float ss = sq16(v);
            ss += __shfl_xor(ss, 1); ss += __shfl_xor(ss, 2); ss += __shfl_xor(ss, 4);
            const float rstd = 16.0f / sqrtf(ss * (1.0f / 128.0f) + NORM_EPS);
            const float* gp = A.dil_out_g + h * 128 + d0;
            u32x4 w;
            w.x = pk_fp8(v[0] * rstd * *(const f32x4*)gp); w.y = pk_fp8(v[1] * rstd * *(const f32x4*)(gp + 4));
            w.z = pk_fp8(v[2] * rstd * *(const f32x4*)(gp + 8)); w.w = pk_fp8(v[3] * rstd * *(const f32x4*)(gp + 12));
            *(u32x4*)(Y + (size_t)t * DM + 2048 + h * 128 + d0) = w;
        }
    }
}

__device__ __forceinline__ unsigned fkey(float f) { const unsigned b = __float_as_uint(f); return b ^ ((b >> 31) ? 0xFFFFFFFFu : 0x80000000u); }
__device__ __forceinline__ int mbcnt64(unsigned long long m) { return (int)__builtin_amdgcn_mbcnt_hi((unsigned)(m >> 32), __builtin_amdgcn_mbcnt_lo((unsigned)m, 0u)); }
template <int NR> __device__ __forceinline__ unsigned kth16_key(const unsigned (&key)[NR]) {
    unsigned T = 0u;
    for (int bit = 31; bit >= 0; --bit) {
        const unsigned cand = T | (1u << bit); int cnt = 0;
#pragma unroll
        for (int r = 0; r < NR; ++r) cnt += __builtin_popcountll(__ballot(key[r] >= cand));
        if (cnt >= 16) T = cand;
    }
    return T;
}
template <int NR> __device__ __forceinline__ void select16(const unsigned (&key)[NR], bool (&sel)[NR], int (&pos)[NR]) {
    const unsigned T = kth16_key<NR>(key);
    int cgt = 0;
#pragma unroll
    for (int r = 0; r < NR; ++r) cgt += __builtin_popcountll(__ballot(key[r] > T));
    const int need = 16 - cgt; int eqb = 0, selb = 0;
#pragma unroll
    for (int r = 0; r < NR; ++r) {
        const bool gt = key[r] > T, eq = key[r] == T;
        const unsigned long long beq = __ballot(eq);
        const bool s = gt || (eq && (eqb + mbcnt64(beq)) < need);
        const unsigned long long bs = __ballot(s);
        sel[r] = s; pos[r] = selb + mbcnt64(bs);
        selb += __builtin_popcountll(bs); eqb += __builtin_popcountll(beq);
    }
}
__device__ __forceinline__ float funkey(unsigned k) { return __uint_as_float((k & 0x80000000u) ? (k ^ 0x80000000u) : ~k); }
__device__ __forceinline__ void ins16(unsigned (&L)[16], unsigned x) {
#pragma unroll
    for (int i = 0; i < 16; ++i) { const unsigned hi = L[i] > x ? L[i] : x, lo = L[i] > x ? x : L[i]; L[i] = hi; x = lo; }
}
__device__ __forceinline__ void topk_phase(const Args& A, LAS unsigned char* lds, int gw, int ngw, int wave, int lane, int nwb = S * 16 / 64) {
    unsigned char* ws = A.ws;
    const float* SC = (const float*)(ws + WS_SC); int* IDX = (int*)(ws + WS_IDX); float* GATE = (float*)(ws + WS_GATE);
    LAS float* scr = (LAS float*)(lds + wave * 8448);
    LAS int* tab = (LAS int*)scr;
    for (int wb = gw; wb < nwb; wb += ngw) {
        const float* base = SC + (size_t)wb * 64 * 128;
        unsigned L[16];
#pragma unroll
        for (int i = 0; i < 16; ++i) L[i] = 0u;
        f32x4 ld[8], ln[8];
        const int lr = lane >> 3, lc = lane & 7;
#pragma unroll
        for (int i = 0; i < 8; ++i) ld[i] = *(const f32x4*)(base + (size_t)(8 * i + lr) * 128 + 4 * lc);
#pragma unroll
        for (int c = 0; c < 4; ++c) {
            if (c < 3) {
#pragma unroll
                for (int i = 0; i < 8; ++i) ln[i] = *(const f32x4*)(base + (size_t)(8 * i + lr) * 128 + 32 * (c + 1) + 4 * lc);
            }
#pragma unroll
            for (int i = 0; i < 8; ++i) { LAS float* d = scr + (8 * i + lr) * 33 + 4 * lc; d[0] = ld[i].x; d[1] = ld[i].y; d[2] = ld[i].z; d[3] = ld[i].w; }
            LDS_WAIT(); __builtin_amdgcn_wave_barrier();
#pragma unroll
            for (int j = 0; j < 32; ++j) { const float v = scr[lane * 33 + j]; ins16(L, (fkey(v) & ~127u) | (unsigned)(127 - (32 * c + j))); }
            LDS_WAIT(); __builtin_amdgcn_wave_barrier();
#pragma unroll
            for (int i = 0; i < 8; ++i) ld[i] = ln[i];
        }
        unsigned M[16];
#pragma unroll
        for (int i = 0; i < 16; ++i) M[i] = (unsigned)__shfl_down((int)L[i], 1);
        float av[16], bv[16];
#pragma unroll
        for (int i = 0; i < 16; ++i) { av[i] = funkey((L[i] & ~127u) | 64u); bv[i] = funkey((M[i] & ~127u) | 64u);
            tab[lane * 33 + i] = 127 - (int)(L[i] & 127u); tab[lane * 33 + 16 + i] = 127 - (int)(M[i] & 127u); }
        unsigned K2[16];
#pragma unroll
        for (int i = 0; i < 16; ++i) K2[i] = 0u;
#pragma unroll
        for (int i = 0; i < 16; ++i)
#pragma unroll
            for (int j = 0; j < 16; ++j)
                if ((i + 1) * (j + 1) <= 16) ins16(K2, (fkey(av[i] + bv[j]) & ~255u) | (unsigned)(255 - (i * 16 + j)));
        LDS_WAIT(); __builtin_amdgcn_wave_barrier();
        float fv[16]; int fe[16]; float sm = 0.f;
        const float mx = funkey((K2[0] & ~255u) | 128u);
#pragma unroll
        for (int q = 0; q < 16; ++q) { const int cid = 255 - (int)(K2[q] & 255u);
            fe[q] = tab[lane * 33 + (cid >> 4)] * 128 + tab[lane * 33 + 16 + (cid & 15)];
            fv[q] = __expf(funkey((K2[q] & ~255u) | 128u) - mx); sm += fv[q]; }
        const float inv = 1.0f / sm;
        if ((lane & 1) == 0) {
            const size_t o = ((size_t)wb * 32 + (lane >> 1)) * 16;
#pragma unroll
            for (int q = 0; q < 4; ++q) {
                *(u32x4*)(IDX + o + 4 * q) = (u32x4){(unsigned)fe[4 * q], (unsigned)fe[4 * q + 1], (unsigned)fe[4 * q + 2], (unsigned)fe[4 * q + 3]};
                *(f32x4*)(GATE + o + 4 * q) = (f32x4){fv[4 * q] * inv, fv[4 * q + 1] * inv, fv[4 * q + 2] * inv, fv[4 * q + 3] * inv};
            }
        }
        LDS_WAIT(); __builtin_amdgcn_wave_barrier();
    }
}

__device__ __forceinline__ float gelu_erf(float x) { return 0.5f * x * (1.0f + erff(x * 0.70710678118654752f)); }
__device__ __forceinline__ f32x2 fp8lo(unsigned w) { return __builtin_amdgcn_cvt_pk_f32_fp8((int)w, false); }
__device__ __forceinline__ f32x2 fp8hi(unsigned w) { return __builtin_amdgcn_cvt_pk_f32_fp8((int)w, true); }
__device__ __forceinline__ float dot16_fp8(const u32x4 w, const f32x2 (&hp)[8]) {
    f32x2 t = fp8lo(w.x) * hp[0];
    t = __builtin_elementwise_fma(fp8hi(w.x), hp[1], t); t = __builtin_elementwise_fma(fp8lo(w.y), hp[2], t); t = __builtin_elementwise_fma(fp8hi(w.y), hp[3], t);
    t = __builtin_elementwise_fma(fp8lo(w.z), hp[4], t); t = __builtin_elementwise_fma(fp8hi(w.z), hp[5], t); t = __builtin_elementwise_fma(fp8lo(w.w), hp[6], t);
    t = __builtin_elementwise_fma(fp8hi(w.w), hp[7], t);
    return t.x + t.y;
}
__device__ __forceinline__ float d2cv(unsigned w, bool hi, unsigned hpair, float acc) {
    return __builtin_amdgcn_fdot2_f32_bf16(hi ? __builtin_amdgcn_cvt_scalef32_pk_bf16_fp8(w, 1.0f, true) : __builtin_amdgcn_cvt_scalef32_pk_bf16_fp8(w, 1.0f, false), __builtin_bit_cast(bf16v2, hpair), acc, false); }
__device__ __forceinline__ float dot16_fp8_bf(const u32x4 w, const u32x4 h0, const u32x4 h1, float acc) {
    acc = d2cv(w.x, false, h0.x, acc); acc = d2cv(w.x, true, h0.y, acc); acc = d2cv(w.y, false, h0.z, acc); acc = d2cv(w.y, true, h0.w, acc);
    acc = d2cv(w.z, false, h1.x, acc); acc = d2cv(w.z, true, h1.y, acc); acc = d2cv(w.w, false, h1.z, acc); return d2cv(w.w, true, h1.w, acc);
}
__device__ __forceinline__ void axpy16_fp8(const u32x4 w, const float a, f32x2 (&o)[8]) {
    const f32x2 av = {a, a};
    o[0] = __builtin_elementwise_fma(fp8lo(w.x), av, o[0]); o[1] = __builtin_elementwise_fma(fp8hi(w.x), av, o[1]);
    o[2] = __builtin_elementwise_fma(fp8lo(w.y), av, o[2]); o[3] = __builtin_elementwise_fma(fp8hi(w.y), av, o[3]);
    o[4] = __builtin_elementwise_fma(fp8lo(w.z), av, o[4]); o[5] = __builtin_elementwise_fma(fp8hi(w.z), av, o[5]);
    o[6] = __builtin_elementwise_fma(fp8lo(w.w), av, o[6]); o[7] = __builtin_elementwise_fma(fp8hi(w.w), av, o[7]);
}
__device__ __forceinline__ void peer_phase(const Args& A, LAS unsigned char* lds, int G, int bid, int tid) {
    unsigned char* ws = A.ws;
    const bf16_t* H2 = (const bf16_t*)(ws + WS_H2);
    const int* IDX = (const int*)(ws + WS_IDX); const float* GATE = (const float*)(ws + WS_GATE);
    bf16_t* X1 = (bf16_t*)(ws + WS_X1); const float* g2 = (const float*)(ws + WS_MOD) + 5 * DM;
    const int grp = tid >> 3, sub = tid & 7, tok = grp >> 1, eh = grp & 1;
    const int srot = 4 * (int)(xb_xcc_id() & 7u);
    const unsigned so = (unsigned)sub * 16u;
    LAS int* lidx = (LAS int*)lds; LAS float* lact = (LAS float*)(lds + 16384); LAS float* lrs = (LAS float*)(lds + 32768);
    const LAS int* myidx = lidx + tok * 128 + eh * 64; const LAS float* myact = lact + tok * 128 + eh * 64;
    for (int tt = bid; tt < S / 32; tt += G) {
        const int t0 = tt * 32;
        topk_phase(A, lds + 40960, tt * 8 + (tid >> 6), 1 << 30, tid >> 6, tid & 63, tt * 8 + (tid >> 6) + 1);
        asm volatile("s_waitcnt vmcnt(0)" ::: "memory"); __syncthreads();
        for (int i = tid; i < 1024; i += 512) ((LAS u32x4*)lidx)[i] = ((const u32x4*)(IDX + (size_t)t0 * 128))[i];
        __syncthreads();
        float acc[64];
#pragma unroll
        for (int j = 0; j < 64; ++j) acc[j] = 0.f;
        for (int si = 0; si < 32; ++si) {
            const int s = (si + srot) & 31;
            const u32x4 h0 = *(const u32x4*)(H2 + (size_t)(t0 + tok) * DM + s * 128 + sub * 16), h1 = *(const u32x4*)(H2 + (size_t)(t0 + tok) * DM + s * 128 + sub * 16 + 8);
            const char* ub = (const char*)(ws + WS_UB) + (size_t)s * ((size_t)NEXP * 128);
#pragma unroll
            for (int eb = 0; eb < 64; eb += 16) {
                u32x4 id4[4];
#pragma unroll
                for (int k = 0; k < 4; ++k) id4[k] = *(const LAS u32x4*)(myidx + eb + 4 * k);
                u32x4 uv[16];
#pragma unroll
                for (int k = 0; k < 4; ++k) { uv[4 * k + 0] = *(const u32x4*)(ub + (id4[k].x * 128u + so)); uv[4 * k + 1] = *(const u32x4*)(ub + (id4[k].y * 128u + so));
                                              uv[4 * k + 2] = *(const u32x4*)(ub + (id4[k].z * 128u + so)); uv[4 * k + 3] = *(const u32x4*)(ub + (id4[k].w * 128u + so)); }
#pragma unroll
                for (int i = 0; i < 16; ++i) acc[eb + i] = dot16_fp8_bf(uv[i], h0, h1, acc[eb + i]);
                asm volatile("" ::: "memory");
            }
        }
        {
            float g8[8];
#pragma unroll
            for (int k = 0; k < 8; ++k) g8[k] = GATE[(size_t)(t0 + tok) * 128 + eh * 64 + 8 * k + sub];
            const bool b4 = (sub & 4) != 0, b2 = (sub & 2) != 0, b1 = (sub & 1) != 0;
            float a32[32], a16[16], a8[8];
#pragma unroll
            for (int p = 0; p < 32; ++p) { const int jl = (p >> 2) * 8 + (p & 3), jh = jl + 4;
                float x0 = acc[jl], x1 = acc[jh]; asm volatile("" : "+v"(x0), "+v"(x1));
                const float keep = b4 ? x1 : x0, send = b4 ? x0 : x1; a32[p] = keep + __shfl_xor(send, 4); }
#pragma unroll
            for (int p = 0; p < 16; ++p) { const int il = (p >> 1) * 4 + (p & 1), ih = il + 2;
                float x0 = a32[il], x1 = a32[ih]; asm volatile("" : "+v"(x0), "+v"(x1));
                const float keep = b2 ? x1 : x0, send = b2 ? x0 : x1; a16[p] = keep + __shfl_xor(send, 2); }
#pragma unroll
            for (int k = 0; k < 8; ++k) { float x0 = a16[2 * k], x1 = a16[2 * k + 1]; asm volatile("" : "+v"(x0), "+v"(x1));
                const float keep = b1 ? x1 : x0, send = b1 ? x0 : x1; a8[k] = keep + __shfl_xor(send, 1); }
#pragma unroll
            for (int k = 0; k < 8; ++k) lact[tok * 128 + eh * 64 + 8 * k + sub] = g8[k] * gelu_erf(a8[k] * (1.0f / 256.0f));
        }
        __syncthreads();
        float ssq = 0.f;
        for (int si = 0; si < 32; ++si) {
            const int s = (si + srot) & 31;
            const char* vb = (const char*)(ws + WS_VB) + (size_t)s * ((size_t)NEXP * 128);
            f32x2 o[8];
#pragma unroll
            for (int i = 0; i < 8; ++i) o[i] = (f32x2){0.f, 0.f};
#pragma unroll
            for (int eb = 0; eb < 64; eb += 16) {
                u32x4 id4[4]; f32x4 a4[4];
#pragma unroll
                for (int k = 0; k < 4; ++k) { id4[k] = *(const LAS u32x4*)(myidx + eb + 4 * k); a4[k] = *(const LAS f32x4*)(myact + eb + 4 * k); }
                u32x4 vv[16];
#pragma unroll
                for (int k = 0; k < 4; ++k) { vv[4 * k + 0] = *(const u32x4*)(vb + (id4[k].x * 128u + so)); vv[4 * k + 1] = *(const u32x4*)(vb + (id4[k].y * 128u + so));
                                              vv[4 * k + 2] = *(const u32x4*)(vb + (id4[k].z * 128u + so)); vv[4 * k + 3] = *(const u32x4*)(vb + (id4[k].w * 128u + so)); }
#pragma unroll
                for (int k = 0; k < 4; ++k) { axpy16_fp8(vv[4 * k + 0], a4[k].x, o); axpy16_fp8(vv[4 * k + 1], a4[k].y, o); axpy16_fp8(vv[4 * k + 2], a4[k].z, o); axpy16_fp8(vv[4 * k + 3], a4[k].w, o); }
                asm volatile("" ::: "memory");
            }
#pragma unroll
            for (int i = 0; i < 8; ++i) { o[i].x += __shfl_xor(o[i].x, 8); o[i].y += __shfl_xor(o[i].y, 8); }
            if (eh == 0) {
                const size_t off = (size_t)(t0 + tok) * DM + s * 128 + sub * 16;
#pragma unroll
                for (int q = 0; q < 4; ++q) {
                    const f32x4 xv = ld4bf(X1 + off + 4 * q); const f32x4 gv = *(const f32x4*)(g2 + s * 128 + sub * 16 + 4 * q) * (1.0f / 16.0f);
                    f32x4 r; r.x = xv.x + gv.x * o[2 * q].x; r.y = xv.y + gv.y * o[2 * q].y; r.z = xv.z + gv.z * o[2 * q + 1].x; r.w = xv.w + gv.w * o[2 * q + 1].y;
                    ssq += (r.x * r.x + r.y * r.y) + (r.z * r.z + r.w * r.w);
                    u32x2 w; w.x = cvt_pk(r.x, r.y); w.y = cvt_pk(r.z, r.w); *(u32x2*)(X1 + off + 4 * q) = w;
                }
            }
        }
        ssq += __shfl_xor(ssq, 1); ssq += __shfl_xor(ssq, 2); ssq += __shfl_xor(ssq, 4);
        if (eh == 0 && sub == 0) lrs[tok] = 1.0f / sqrtf(ssq * (1.0f / DM) + NORM_EPS);
        __syncthreads();
        for (int i0 = tid; i0 < 32 * 1024; i0 += 512 * 8) {
            u32x2 pv[8];
#pragma unroll
            for (int k = 0; k < 8; ++k) { const int i = i0 + 512 * k, tn = i >> 10, c4 = i & 1023; pv[k] = *((const u32x2*)(X1 + (size_t)(t0 + tn) * DM) + c4); }
#pragma unroll
            for (int k = 0; k < 8; ++k) { const int i = i0 + 512 * k, tn = i >> 10, c4 = i & 1023;
                const f32x4 xv = (f32x4){bf_lo(pv[k].x), bf_hi(pv[k].x), bf_lo(pv[k].y), bf_hi(pv[k].y)};
                *((f32x4*)(A.out + (size_t)(t0 + tn) * DM) + c4) = xv * lrs[tn] * ((const f32x4*)A.final_g)[c4]; }
        }
        __syncthreads();
    }
}

#ifdef DBG_CHECK
__device__ __forceinline__ void dbg_flag(unsigned char* ws, int bit) { atomicOr((unsigned*)(ws + WS_CTL + 65536), 1u << bit); }
__device__ __forceinline__ void dbg_phase(const Args& A, LAS unsigned char* lds, int bid, int tid) {
    unsigned char* ws = A.ws;
    const int lane = tid & 63, wave = __builtin_amdgcn_readfirstlane(tid >> 6);
    const bf16_t* H2 = (const bf16_t*)(ws + WS_H2); const float* SC = (const float*)(ws + WS_SC);
    const int* IDX = (const int*)(ws + WS_IDX); const float* GATE = (const float*)(ws + WS_GATE);
    const float* X1 = (const float*)(ws + WS_X1); const float* mod = (const float*)(ws + WS_MOD);
    if (wave != 0) return;
    if (bid < 4) {
        const int t = bid == 0 ? 5 : (bid == 1 ? 1234 : (bid == 2 ? 4097 : 8191)), g = (3 * bid + 5) & 15;
        LAS float* q = (LAS float*)lds;
        float q0 = 0.f, q1 = 0.f;
        for (int d = 0; d < DM; ++d) { const float hv = __uint_as_float(((unsigned)H2[(size_t)t * DM + d]) << 16);
            q0 += hv * A.peer_wq[(size_t)d * 2048 + g * 128 + lane]; q1 += hv * A.peer_wq[(size_t)d * 2048 + g * 128 + 64 + lane]; }
        q[lane] = q0; q[lane + 64] = q1; LDS_WAIT(); __builtin_amdgcn_wave_barrier();
        bool bad = false;
        for (int r = 0; r < 2; ++r) { const int n = lane + 64 * r; float s = 0.f;
            for (int k = 0; k < 128; ++k) s += q[k] * A.peer_subkeys[(size_t)g * 16384 + n * 128 + k];
            const float got = SC[(size_t)t * 2048 + g * 128 + n];
            if (!(fabsf(got - s) <= 0.03f * fabsf(s) + 0.03f)) bad = true; }
        if (__any(bad) && lane == 0) dbg_flag(ws, 0);
    } else if (bid < 8) {
        const int b = bid - 4, t = b == 0 ? 5 : (b == 1 ? 1234 : (b == 2 ? 4097 : 8191)), h = (2 * b + 1) & 7;
        LAS float* sv = (LAS float*)lds;
        LAS int* si = (LAS int*)(lds + 2048);
        LAS float* fv = (LAS float*)(lds + 4096);
        for (int i = lane; i < 256; i += 64) sv[i] = SC[(size_t)t * 2048 + h * 256 + i];
        LDS_WAIT(); __builtin_amdgcn_wave_barrier();
        if (lane == 0) {
            for (int p = 0; p < 2; ++p) for (int k = 0; k < 16; ++k) { float best = -3e38f; int bi = 0;
                for (int n = 0; n < 128; ++n) { const float x = sv[p * 128 + n]; if (x > best) { best = x; bi = n; } }
                sv[256 + p * 16 + k] = best; si[p * 16 + k] = bi; sv[p * 128 + bi] = -3e38f; }
            for (int a = 0; a < 16; ++a) for (int c = 0; c < 16; ++c) fv[16 + a * 16 + c] = sv[256 + a] + sv[272 + c];
            float mx = -3e38f;
            for (int k = 0; k < 16; ++k) { float best = -3e38f; int bi = 0;
                for (int c = 0; c < 256; ++c) { const float x = fv[16 + c]; if (x > best) { best = x; bi = c; } }
                fv[k] = best; si[32 + k] = si[bi >> 4] * 128 + si[16 + (bi & 15)]; fv[16 + bi] = -3e38f; if (best > mx) mx = best; }
            float sm = 0.f; for (int k = 0; k < 16; ++k) sm += __expf(fv[k] - mx);
            bool bad = false;
            for (int k = 0; k < 16; ++k) { const float gk = __expf(fv[k] - mx) / sm; bool found = false;
                for (int j = 0; j < 16; ++j) if (IDX[(size_t)t * 128 + h * 16 + j] == si[32 + k]) { found = true; if (fabsf(GATE[(size_t)t * 128 + h * 16 + j] - gk) > 2e-3f) bad = true; }
                if (!found && gk > 0.02f) bad = true; }
            if (bad) dbg_flag(ws, 1);
        }
    } else if (bid < 12) {
        const int b = bid - 8, t = b == 0 ? 5 : (b == 1 ? 1234 : (b == 2 ? 4097 : 8191));
        LAS float* av = (LAS float*)lds;
        for (int j = 0; j < 128; ++j) { const int e = IDX[(size_t)t * 128 + j]; float s = 0.f;
            for (int d = lane; d < DM; d += 64) s += __uint_as_float(((unsigned)H2[(size_t)t * DM + d]) << 16) * A.peer_u[(size_t)e * DM + d];
            s = wave_sum(s); if (lane == 0) av[j] = GATE[(size_t)t * 128 + j] * gelu_erf(s); }
        LDS_WAIT(); __builtin_amdgcn_wave_barrier();
        float ss = 0.f;
        for (int d = lane; d < DM; d += 64) { float o = 0.f;
            for (int j = 0; j < 128; ++j) o += av[j] * A.peer_v[(size_t)IDX[(size_t)t * 128 + j] * DM + d];
            const float x2 = X1[(size_t)t * DM + d] + mod[5 * DM + d] * o; ss += x2 * x2; }
        ss = wave_sum(ss); const float rstd = 1.0f / sqrtf(ss / DM + NORM_EPS);
        bool bad = false;
        for (int d = lane; d < DM; d += 64) { float o = 0.f;
            for (int j = 0; j < 128; ++j) o += av[j] * A.peer_v[(size_t)IDX[(size_t)t * 128 + j] * DM + d];
            const float ref = (X1[(size_t)t * DM + d] + mod[5 * DM + d] * o) * rstd * A.final_g[d];
            if (!(fabsf(A.out[(size_t)t * DM + d] - ref) <= 0.02f * fabsf(ref) + 0.02f)) bad = true; }
        if (__any(bad) && lane == 0) dbg_flag(ws, 2);
    } else if (bid < 16) {
        const int b = bid - 12, t = b == 0 ? 5 : (b == 1 ? 1234 : (b == 2 ? 4097 : 8191));
        float ss = 0.f; for (int d = lane; d < DM; d += 64) { const float x = X1[(size_t)t * DM + d]; ss += x * x; }
        ss = wave_sum(ss); const float rstd = 1.0f / sqrtf(ss / DM + NORM_EPS); bool bad = false;
        for (int d = lane; d < DM; d += 64) { const float ref = X1[(size_t)t * DM + d] * rstd * A.norm2_g[d] * (1.0f + mod[4 * DM + d]) + mod[3 * DM + d];
            const float got = __uint_as_float(((unsigned)H2[(size_t)t * DM + d]) << 16);
            if (!(fabsf(got - ref) <= 0.01f * fabsf(ref) + 0.01f)) bad = true; }
        if (__any(bad) && lane == 0) dbg_flag(ws, 3);
    } else if (bid < 20) {
        const int b = bid - 16; bool bad = false;
        for (int r = 0; r < 6; ++r) { const int n = r * DM + 37 * lane + 500 * b; float s = 0.f;
            for (int k = 0; k < DM; ++k) { const float cv = A.c[k]; s += cv / (1.0f + __expf(-cv)) * A.w_ada[(size_t)k * NADA + n]; }
            s += A.b_ada[n]; if (!(fabsf(mod[n] - s) <= 1e-3f * fabsf(s) + 1e-3f)) bad = true; }
        if (__any(bad) && lane == 0) dbg_flag(ws, 4);
    } else if (bid < 24) {
        const int b = bid - 20, g = (5 * b + 2) & 15, n = 17 * b + 3; bool bad = false;
        const bf16_t* wsc = (const bf16_t*)(ws + WS_WSC);
        for (int d = lane; d < DM; d += 64) { float s = 0.f;
            for (int k = 0; k < 128; ++k) s += A.peer_subkeys[(size_t)g * 16384 + n * 128 + k] * A.peer_wq[(size_t)d * 2048 + g * 128 + k];
            const float got = __uint_as_float(((unsigned)wsc[(size_t)(g * 128 + n) * DM + d]) << 16);
            if (!(fabsf(got - s) <= 0.01f * fabsf(s) + 2e-4f)) bad = true; }
        if (__any(bad) && lane == 0) dbg_flag(ws, 5);
    }
}
__device__ __forceinline__ void dbg_emit(const Args& A, int bid, int tid, int G) {
    const unsigned mask = *(const unsigned*)(A.ws + WS_CTL + 65536);
    const float cval = sqrtf((float)mask + 1.0f);
    for (size_t i = (size_t)bid * 512 + tid; i < (size_t)S * DM; i += (size_t)G * 512) A.out[i] = cval;
}
#endif
__global__ void __launch_bounds__(512, 2) hymba_fwd(Args A) {
    extern __shared__ __attribute__((aligned(16))) unsigned char lds_raw[];
    LAS unsigned char* lds = (LAS unsigned char*)lds_raw;
    const int tid = threadIdx.x, lane = tid & 63, wave = __builtin_amdgcn_readfirstlane(tid >> 6);
    const int G = gridDim.x, bid = blockIdx.x;
    const int gw = bid * 8 + wave, ngw = G * 8;
    unsigned char* ws = A.ws;
    for (int u = tid; u < (LDS_BYTES - RING_BYTES) / 4; u += 512) ((LAS unsigned*)(lds + RING_BYTES))[u] = 0u;
    __syncthreads();
    XcdBarrier bar; bar.bar = (unsigned*)(ws + WS_CTL) + CW_BAR; bar.x = 0; bar.st = nullptr;
    if (MK_N_LAUNCHES == 1) bar = xcd_barrier_post((unsigned*)(ws + WS_CTL) + CW_BAR, (volatile LAS unsigned*)(lds + MISC_OFF + 32));
    const int lo = A.ph_lo, hi = A.ph_hi;
#ifndef PH_MASK
#define PH_MASK 0xfff
#endif
#define IN(k) (((PH_MASK >> (k)) & 1) && lo <= (k) && (k) < hi)
#define REP(k) (((REP_MASK >> (k)) & 1) ? 2 : 1)
#ifdef DBG_TIME
#define SEAM(k) do { if (IN(k) && IN((k) + 1)) xcd_barrier(bar); if (bid == 0 && tid == 0) ((unsigned long long*)(ws + WS_CTL + 32768))[(k) + 1] = __builtin_amdgcn_s_memrealtime(); } while (0)
#else
#define SEAM(k) do { if (IN(k) && IN((k) + 1)) xcd_barrier(bar); } while (0)
#endif
    float* mod = (float*)(ws + WS_MOD);
#ifdef DBG_TIME
    if (bid == 0 && tid == 0) ((unsigned long long*)(ws + WS_CTL + 32768))[0] = __builtin_amdgcn_s_memrealtime();
#endif

    if (IN(0)) for (int rep_ = 0; rep_ < REP(0); ++rep_) { p0_prologue(A, lds, G, bid, tid); }
    SEAM(0);
    if (IN(1)) for (int rep_ = 0; rep_ < REP(1); ++rep_) { row_modulate<false, true>(A.x, A.norm1_g, mod + 0 * DM, mod + 1 * DM, (bf16_t*)(ws + WS_H1), ws + WS_H1F8, (LAS float*)lds, tid, gw, ngw, lane); }
    SEAM(1);
    if (IN(2)) for (int rep_ = 0; rep_ < REP(2); ++rep_) {
        {
            pg8::Gemm g{(const bf16_t*)(ws + WS_H1), (const bf16_t*)(ws + WS_WIN), S, 8192, DM}; pg8::StaticOrder So; So.init(S, 8192, G, bid);
            EpiQKV E{(bf16_t*)(ws + WS_QKV), (bf16_t*)(ws + WS_QKV2), (const float*)(ws + WS_ROPE), 0};
            pg8::gemm_phase<EpiQKV, pg8::StaticOrder, false>(lds, g, So, E, nullptr);
        }
        __syncthreads();
        {
            pg8::Gemm g{(const bf16_t*)(ws + WS_H1F8), (const bf16_t*)(ws + WS_WIN + WIN8_OFF), S, 4096, DM / 2}; pg8::StaticOrder So; So.init(S, 4096, G, bid);
            EpiSV E{(bf16_t*)(ws + WS_QKV), (bf16_t*)(ws + WS_QKV2)};
            pg8::gemm_phase<EpiSV, pg8::StaticOrder, false, true>(lds, g, So, E, nullptr);
        }
    }
    SEAM(2);
    if (IN(3)) for (int rep_ = 0; rep_ < REP(3); ++rep_) { attn_phase(A, (char*)lds_raw, G, bid); }
    SEAM(3);
    if (IN(4)) for (int rep_ = 0; rep_ < REP(4); ++rep_) { combine_phase(A, gw, ngw, lane); }
    SEAM(4);
    if (IN(5)) for (int rep_ = 0; rep_ < REP(5); ++rep_) {
        pg8::Gemm g{(const bf16_t*)(ws + WS_Y), (const bf16_t*)(ws + WS_WOUT), S, DM, DM / 2}; pg8::StaticOrder So; So.init(S, DM, G, bid);
        EpiResid E{A.x, mod + 2 * DM, (bf16_t*)(ws + WS_X1)};
        pg8::gemm_phase<EpiResid, pg8::StaticOrder, false, true>(lds, g, So, E, nullptr);
    }
    SEAM(5);
    if (IN(6)) for (int rep_ = 0; rep_ < REP(6); ++rep_) { row_modulate<true, false>(ws + WS_X1, A.norm2_g, mod + 3 * DM, mod + 4 * DM, (bf16_t*)(ws + WS_H2), nullptr, (LAS float*)lds, tid, gw, ngw, lane); }
    SEAM(6);
    if (IN(7)) for (int rep_ = 0; rep_ < REP(7); ++rep_) {
        pg8::Gemm g{(const bf16_t*)(ws + WS_H2), (const bf16_t*)(ws + WS_WSC), S, 2048, DM}; pg8::StaticOrder So; So.init(S, 2048, G, bid);
#ifdef PROBE_FLAGS
        if (A.flag & 2) g.K = DM / 2;
        if (A.flag & 4) g.K = 256;
#endif
        pg8::EpiF32 E{(float*)(ws + WS_SC), 2048, nullptr};
        pg8::gemm_phase<pg8::EpiF32, pg8::StaticOrder, false>(lds, g, So, E, nullptr);
    }
    SEAM(7);
    if (IN(9)) for (int rep_ = 0; rep_ < REP(9); ++rep_) { peer_phase(A, lds, G, bid, tid); }
#ifdef DBG_TIME
    xcd_barrier(bar);
    if (bid == 0 && tid == 0) ((unsigned long long*)(ws + WS_CTL + 32768))[10] = __builtin_amdgcn_s_memrealtime();
    xcd_barrier(bar);
    {
        const unsigned long long* ts = (const unsigned long long*)(ws + WS_CTL + 32768);
        const float d1 = (float)(ts[DBG_T1 + 1] - ts[DBG_T1]) * 0.01f, d2 = (float)(ts[DBG_T2 + 1] - ts[DBG_T2]) * 0.01f;
        const float cval = sqrtf(fmaxf(d1 * 0.1f, 0.f));
        for (size_t i = (size_t)bid * 512 + tid; i < (size_t)S * DM; i += (size_t)G * 512) A.out[i] = (i == 0) ? 10.0f * d2 : cval;
    }
#endif
#undef IN
#undef SEAM
}

#ifdef DBG_CHECK
__global__ void __launch_bounds__(512) dbg_kernel(Args A, int which) {
    __shared__ __attribute__((aligned(16))) unsigned char dl[8192];
    if (which == 0) dbg_phase(A, (LAS unsigned char*)dl, blockIdx.x, threadIdx.x);
    else dbg_emit(A, blockIdx.x, threadIdx.x, gridDim.x);
}
#endif
extern "C" void kernel_launch(void* const* d_in, const int* in_sizes, int n_in, void* d_out, int out_size, void* d_ws, size_t ws_size, hipStream_t stream) {
    static int grid = 0;
    if (grid == 0) {
        if (n_in != 20 || out_size != S * DM || ws_size < WS_END) { fprintf(stderr, "kernel_launch: unexpected shapes (n_in %d out %d ws %zu)\n", n_in, out_size, ws_size); grid = -1; return; }
        int dev = 0, cus = 0, per_cu = 0;
        if (hipGetDevice(&dev) != hipSuccess || hipDeviceGetAttribute(&cus, hipDeviceAttributeMultiprocessorCount, dev) != hipSuccess) { grid = -1; return; }
        if (hipFuncSetAttribute((const void*)hymba_fwd, hipFuncAttributeMaxDynamicSharedMemorySize, LDS_BYTES) != hipSuccess) { fprintf(stderr, "kernel_launch: hipFuncSetAttribute failed\n"); grid = -1; return; }
        if (hipOccupancyMaxActiveBlocksPerMultiprocessor(&per_cu, (const void*)hymba_fwd, 512, LDS_BYTES) != hipSuccess || per_cu < 1) fprintf(stderr, "kernel_launch: occupancy query reports %d\n", per_cu);
        (void)hipGetLastError();
        grid = cus;
    }
    if (grid < 0) return;
    (void)hipMemsetAsync((char*)d_ws + WS_CTL, 0, CTL_ZERO_BYTES, stream);
    Args a{};
    a.x = (const float*)d_in[0]; a.c = (const float*)d_in[1]; a.positions = (const int*)d_in[2]; a.norm1_g = (const float*)d_in[3]; a.norm2_g = (const float*)d_in[4];
    a.w_ada = (const float*)d_in[5]; a.b_ada = (const float*)d_in[6]; a.w_in = (const float*)d_in[7]; a.lam_q1 = (const float*)d_in[8]; a.lam_k1 = (const float*)d_in[9];
    a.lam_q2 = (const float*)d_in[10]; a.lam_k2 = (const float*)d_in[11]; a.diff_subln_g = (const float*)d_in[12]; a.dil_out_g = (const float*)d_in[13];
    a.w_out = (const float*)d_in[14]; a.peer_wq = (const float*)d_in[15]; a.peer_subkeys = (const float*)d_in[16]; a.peer_u = (const float*)d_in[17]; a.peer_v = (const float*)d_in[18];
    a.final_g = (const float*)d_in[19];
    a.out = (float*)d_out; a.ws = (unsigned char*)d_ws;
    if (MK_N_LAUNCHES == 1) { a.ph_lo = 0; a.ph_hi = NPHASE; hipLaunchKernelGGL(hymba_fwd, dim3(grid), dim3(512), LDS_BYTES, stream, a); }
    else { for (int p = 0; p < NPHASE; ++p) { a.ph_lo = p; a.ph_hi = p + 1; const int nr = ((REP_MASK >> p) & 1) ? 2 : 1;
            for (int r = 0; r < nr; ++r) { a.flag = (nr == 2 && r == 0) ? PROBE_FLAG_VAL : 0; hipLaunchKernelGGL(hymba_fwd, dim3(grid), dim3(512), LDS_BYTES, stream, a); } } }
#ifdef DBG_CHECK
    hipLaunchKernelGGL(dbg_kernel, dim3(grid), dim3(512), 0, stream, a, 0);
    hipLaunchKernelGGL(dbg_kernel, dim3(grid), dim3(512), 0, stream, a, 1);
#endif
}
```
